# Optimizing an MI355X kernel written in HIP

```python
import math
import jax
import jax.numpy as jnp
from jax import lax
import numpy as np

D_MODEL = 1024
BATCH = 8
SEQ = 2048
DEPTH = 1

N_ATTN_HEADS = 8
HEAD_DIM = 64
D_ATTN = N_ATTN_HEADS * HEAD_DIM
MOBA_BLOCK = 256
MOBA_TOPK = 3
MOBA_QUERY_CHUNK = 32
SSM_GROUP = 16
D_SSM = D_MODEL - D_ATTN
N_SSM_GROUPS = D_SSM // SSM_GROUP
SSM_STATE = 64
DT_MIN = 1e-3
DT_MAX = 1e-1
D_MIX = D_ATTN + D_SSM
D_IN = 3 * D_ATTN + D_SSM
D_FF = 256 * ((8 * D_MODEL // 3 + 255) // 256)
RMS_EPS = 1e-6
NEG_INF = -1e30

kernel_name = 'hymba_moba_s5_macaron_layer'


def rmsnorm(x, g):
    xf = x.astype(jnp.float32)
    y = xf * lax.rsqrt(jnp.mean(xf * xf, axis=-1, keepdims=True) + RMS_EPS)
    return (y * g.astype(jnp.float32)).astype(x.dtype)


def swiglu(x, w_gate, w_up, w_down):
    return (jax.nn.silu(x @ w_gate) * (x @ w_up)) @ w_down


def alibi_slopes(n_heads):
    return jnp.asarray(2.0 ** (-8.0 * np.arange(1, n_heads + 1) / n_heads), dtype=jnp.float32)


def moba_attention(q, k, v):
    bsz, s, nh, dh = q.shape
    L = MOBA_BLOCK
    C = MOBA_QUERY_CHUNK
    nb = -(-s // L)
    sp = nb * L
    nc = sp // C
    topk = min(MOBA_TOPK, nb)
    scale = 1.0 / math.sqrt(dh)
    slopes = alibi_slopes(nh)
    padw = ((0, 0), (0, sp - s), (0, 0), (0, 0))
    q, k, v = (jnp.pad(t, padw).transpose(0, 2, 1, 3) for t in (q, k, v))
    kb = k.reshape(bsz, nh, nb, L, dh)
    vb = v.reshape(bsz, nh, nb, L, dh)

    qblk = jnp.arange(sp) // L
    kmean = jnp.mean(kb.astype(jnp.float32), axis=3)
    gate = jnp.einsum('bhtd,bhnd->bhtn', q.astype(jnp.float32), kmean)
    past = jnp.arange(nb)[None, :] < qblk[:, None]
    gate = jnp.where(past, gate, NEG_INF)
    _, sel = lax.top_k(gate, topk)

    q_c = q.reshape(bsz, nh, nc, C, dh).transpose(2, 0, 1, 3, 4)
    sel_c = sel.reshape(bsz, nh, nc, C, topk).transpose(2, 0, 1, 3, 4)
    b_ix = jnp.arange(bsz)[:, None, None, None]
    h_ix = jnp.arange(nh)[None, :, None, None]
    key_off = jnp.arange(L)

    def chunk(args):
        qc, selc, ci = args
        t = ci * C + jnp.arange(C)
        own = (ci * C) // L
        k_sel = kb[b_ix, h_ix, selc]
        v_sel = vb[b_ix, h_ix, selc]
        k_own = lax.dynamic_index_in_dim(kb, own, axis=2, keepdims=False)
        v_own = lax.dynamic_index_in_dim(vb, own, axis=2, keepdims=False)
        s_sel = jnp.einsum('bhcd,bhckld->bhckl', qc, k_sel).astype(jnp.float32) * scale
        dist_sel = (t[None, None, :, None, None] - (selc[..., None] * L + key_off)).astype(jnp.float32)
        s_sel = s_sel - slopes[None, :, None, None, None] * dist_sel
        slot_ok = jnp.arange(topk)[None, :] < (t // L)[:, None]
        s_sel = jnp.where(slot_ok[None, None, :, :, None], s_sel, NEG_INF)
        s_own = jnp.einsum('bhcd,bhld->bhcl', qc, k_own).astype(jnp.float32) * scale
        dist_own = t[:, None] - (own * L + key_off)[None, :]
        s_own = jnp.where(dist_own >= 0,
                          s_own - slopes[None, :, None, None] * dist_own.astype(jnp.float32),
                          NEG_INF)
        scores = jnp.concatenate([s_sel.reshape(bsz, nh, C, topk * L), s_own], axis=-1)
        p = jax.nn.softmax(scores, axis=-1).astype(v_sel.dtype)
        p_sel = p[..., :topk * L].reshape(bsz, nh, C, topk, L)
        p_own = p[..., topk * L:]
        return (jnp.einsum('bhckl,bhckld->bhcd', p_sel, v_sel)
                + jnp.einsum('bhcl,bhld->bhcd', p_own, v_own))

    out = lax.map(chunk, (q_c, sel_c, jnp.arange(nc)))
    out = out.transpose(1, 2, 0, 3, 4).reshape(bsz, nh, sp, dh)[:, :, :s]
    return out.transpose(0, 2, 1, 3)


def s5_ssm(u, lam_re, lam_im, log_dt, b_re, b_im, c_re, c_im, d_skip, w_glu, b_glu):
    bsz, s, _ = u.shape
    f32 = jnp.float32
    uf = u.astype(f32).reshape(bsz, s, N_SSM_GROUPS, SSM_GROUP)
    lr = lam_re.astype(f32)
    li = lam_im.astype(f32)
    dt = jnp.exp(log_dt.astype(f32))[:, None]
    mag = jnp.exp(lr * dt)
    ang = li * dt
    a_re = mag * jnp.cos(ang)
    a_im = mag * jnp.sin(ang)
    den = lr * lr + li * li
    f_re = ((a_re - 1.0) * lr + a_im * li) / den
    f_im = (a_im * lr - (a_re - 1.0) * li) / den
    br = b_re.astype(f32)
    bi = b_im.astype(f32)
    bb_re = f_re[..., None] * br - f_im[..., None] * bi
    bb_im = f_re[..., None] * bi + f_im[..., None] * br
    x_re = jnp.einsum('bsgh,gph->bsgp', uf, bb_re)
    x_im = jnp.einsum('bsgh,gph->bsgp', uf, bb_im)
    a_re_s = jnp.broadcast_to(a_re, (1, s) + a_re.shape)
    a_im_s = jnp.broadcast_to(a_im, (1, s) + a_im.shape)

    def combine(e1, e2):
        a1r, a1i, x1r, x1i = e1
        a2r, a2i, x2r, x2i = e2
        return (a1r * a2r - a1i * a2i,
                a1r * a2i + a1i * a2r,
                a2r * x1r - a2i * x1i + x2r,
                a2r * x1i + a2i * x1r + x2i)

    _, _, h_re, h_im = lax.associative_scan(combine, (a_re_s, a_im_s, x_re, x_im), axis=1)
    y = (jnp.einsum('bsgp,ghp->bsgh', h_re, c_re.astype(f32))
         - jnp.einsum('bsgp,ghp->bsgh', h_im, c_im.astype(f32))
         + d_skip.astype(f32) * uf)
    y = jax.nn.gelu(y.reshape(bsz, s, D_SSM))
    y = y * jax.nn.sigmoid(y @ w_glu.astype(f32) + b_glu.astype(f32))
    return y.astype(u.dtype)


def setup_inputs(seed: int = 0) -> dict:
    key = jax.random.key(seed)
    ks = jax.random.split(key, 32)
    f32 = jnp.float32
    G, P, Hg = N_SSM_GROUPS, SSM_STATE, SSM_GROUP

    def nrm(k, shape, scale):
        return jax.random.normal(k, shape, f32) * scale

    def gain(k, n):
        return 1.0 + 0.02 * jax.random.normal(k, (DEPTH, n), f32)

    lam_re = -0.5 + 0.01 * jax.random.normal(ks[8], (DEPTH, G, P), f32)
    lam_im = math.pi * jnp.arange(P, dtype=f32)[None, None, :] + 0.01 * jax.random.normal(ks[9], (DEPTH, G, P), f32)
    log_dt = jax.random.uniform(ks[10], (DEPTH, G), f32, math.log(DT_MIN), math.log(DT_MAX))
    return {
        'x': jax.random.normal(ks[0], (BATCH, SEQ, D_MODEL), f32),
        'ffn1_pre_g': gain(ks[1], D_MODEL),
        'ffn1_w_gate': nrm(ks[2], (DEPTH, D_MODEL, D_FF), D_MODEL ** -0.5),
        'ffn1_w_up': nrm(ks[3], (DEPTH, D_MODEL, D_FF), D_MODEL ** -0.5),
        'ffn1_w_down': nrm(ks[4], (DEPTH, D_FF, D_MODEL), D_FF ** -0.5),
        'ffn1_post_g': gain(ks[5], D_MODEL),
        'mix_pre_g': gain(ks[6], D_MODEL),
        'w_in': nrm(ks[7], (DEPTH, D_MODEL, D_IN), D_MODEL ** -0.5),
        'lam_re': lam_re,
        'lam_im': lam_im,
        'log_dt': log_dt,
        'b_re': nrm(ks[11], (DEPTH, G, P, Hg), (2.0 * Hg) ** -0.5),
        'b_im': nrm(ks[12], (DEPTH, G, P, Hg), (2.0 * Hg) ** -0.5),
        'c_re': nrm(ks[13], (DEPTH, G, Hg, P), (2.0 * P) ** -0.5),
        'c_im': nrm(ks[14], (DEPTH, G, Hg, P), (2.0 * P) ** -0.5),
        'd_skip': nrm(ks[15], (DEPTH, G, Hg), 1.0),
        'w_glu': nrm(ks[16], (DEPTH, D_SSM, D_SSM), D_SSM ** -0.5),
        'b_glu': nrm(ks[17], (DEPTH, D_SSM), 0.01),
        'attn_out_g': gain(ks[18], D_ATTN),
        'ssm_out_g': gain(ks[19], D_SSM),
        'w_out': nrm(ks[20], (DEPTH, D_MIX, D_MODEL), D_MIX ** -0.5),
        'mix_post_g': gain(ks[21], D_MODEL),
        'ffn2_pre_g': gain(ks[22], D_MODEL),
        'ffn2_w_gate': nrm(ks[23], (DEPTH, D_MODEL, D_FF), D_MODEL ** -0.5),
        'ffn2_w_up': nrm(ks[24], (DEPTH, D_MODEL, D_FF), D_MODEL ** -0.5),
        'ffn2_w_down': nrm(ks[25], (DEPTH, D_FF, D_MODEL), D_FF ** -0.5),
        'ffn2_post_g': gain(ks[26], D_MODEL),
    }


def reference(x, ffn1_pre_g, ffn1_w_gate, ffn1_w_up, ffn1_w_down, ffn1_post_g,
              mix_pre_g, w_in, lam_re, lam_im, log_dt, b_re, b_im, c_re, c_im, d_skip,
              w_glu, b_glu, attn_out_g, ssm_out_g, w_out, mix_post_g,
              ffn2_pre_g, ffn2_w_gate, ffn2_w_up, ffn2_w_down, ffn2_post_g):
    bsz, s, _ = x.shape
    h = x
    for l in range(DEPTH):
        f = swiglu(rmsnorm(h, ffn1_pre_g[l]), ffn1_w_gate[l], ffn1_w_up[l], ffn1_w_down[l])
        h = h + 0.5 * rmsnorm(f, ffn1_post_g[l])
        u = rmsnorm(h, mix_pre_g[l])
        proj = u @ w_in[l]
        q = proj[..., :D_ATTN].reshape(bsz, s, N_ATTN_HEADS, HEAD_DIM)
        k = proj[..., D_ATTN:2 * D_ATTN].reshape(bsz, s, N_ATTN_HEADS, HEAD_DIM)
        v = proj[..., 2 * D_ATTN:3 * D_ATTN].reshape(bsz, s, N_ATTN_HEADS, HEAD_DIM)
        us = proj[..., 3 * D_ATTN:]
        attn = moba_attention(q, k, v).reshape(bsz, s, D_ATTN)
        ssm = s5_ssm(us, lam_re[l], lam_im[l], log_dt[l], b_re[l], b_im[l], c_re[l], c_im[l],
                     d_skip[l], w_glu[l], b_glu[l])
        merged = jnp.concatenate([rmsnorm(attn, attn_out_g[l]), rmsnorm(ssm, ssm_out_g[l])], axis=-1)
        h = h + rmsnorm(merged @ w_out[l], mix_post_g[l])
        f = swiglu(rmsnorm(h, ffn2_pre_g[l]), ffn2_w_gate[l], ffn2_w_up[l], ffn2_w_down[l])
        h = h + 0.5 * rmsnorm(f, ffn2_post_g[l])
    return h
```

```cpp
#include <hip/hip_runtime.h>
#include <cstdint>
#include <cstdio>

constexpr int D_MODEL = 1024, BATCH = 8, SEQ = 2048, MTOK = BATCH * SEQ;
constexpr int NH = 8, HD = 64, D_ATTN = 512, MOBA_L = 256, NBLK = SEQ / MOBA_L;
constexpr int SSM_GROUP = 16, D_SSM = 512, NG = 32, SSM_P = 64;
constexpr int D_IN = 2048, D_FF = 2816;
constexpr float RMS_EPS = 1e-6f;
constexpr int NTHR = 512;

struct Args {
    const float* in[27];
    float* out;
    unsigned char* ws;
    int stage, pad;
};
enum { I_X = 0, I_F1PRE, I_F1WG, I_F1WU, I_F1WD, I_F1POST, I_MIXPRE, I_WIN, I_LAMRE, I_LAMIM, I_LOGDT, I_BRE, I_BIM, I_CRE, I_CIM, I_DSKIP,
       I_WGLU, I_BGLU, I_ATTNG, I_SSMG, I_WOUT, I_MIXPOST, I_F2PRE, I_F2WG, I_F2WU, I_F2WD, I_F2POST };

__device__ __forceinline__ float wave_sum(float v) {
#pragma unroll
    for (int o = 1; o < 64; o <<= 1) v += __shfl_xor(v, o);
    return v;
}

__device__ void nv_rms(const float* in, int ldin, const float* g, int ncols, int nrows, const float* base, int ldbase, float alpha, float* out, int ldout, int bid, int nblk) {
    const int lane = threadIdx.x & 63, wave = threadIdx.x >> 6, nw = blockDim.x >> 6;
    for (int r = bid * nw + wave; r < nrows; r += nblk * nw) {
        const float* ir = in + (size_t)r * ldin;
        float s = 0.f;
        for (int c = lane * 4; c < ncols; c += 256) { const float4 v = *(const float4*)(ir + c); s += v.x * v.x + v.y * v.y + v.z * v.z + v.w * v.w; }
        s = wave_sum(s);
        const float rs = 1.0f / sqrtf(s / (float)ncols + RMS_EPS);
        for (int c = lane * 4; c < ncols; c += 256) {
            const float4 v = *(const float4*)(ir + c); const float4 gg = *(const float4*)(g + c);
            float4 b = make_float4(0.f, 0.f, 0.f, 0.f); if (base) b = *(const float4*)(base + (size_t)r * ldbase + c);
            float4 o; o.x = b.x + alpha * (v.x * rs * gg.x); o.y = b.y + alpha * (v.y * rs * gg.y); o.z = b.z + alpha * (v.z * rs * gg.z); o.w = b.w + alpha * (v.w * rs * gg.w);
            *(float4*)(out + (size_t)r * ldout + c) = o;
        }
    }
}

template <int MODE>
__device__ void nv_gemm(const float* A, int lda, const float* B, const float* B2, int ldb, float* C, int ldc, int M, int N, int K, const float* bias, float* smem, int bid, int nblk) {
    float* As = smem;
    float* Bs = smem + 16 * 132;
    float* B2s = Bs + 16 * 64;
    const int t = threadIdx.x, ty = t >> 4, tx = t & 15;
    const int ntm = M / 128, ntn = N / 64;
    for (int tile = bid; tile < ntm * ntn; tile += nblk) {
        const int tm = tile / ntn, tn = tile % ntn, m0 = tm * 128, n0 = tn * 64;
        float acc[4][4], acc2[4][4];
#pragma unroll
        for (int i = 0; i < 4; ++i)
#pragma unroll
            for (int j = 0; j < 4; ++j) { acc[i][j] = 0.f; acc2[i][j] = 0.f; }
        for (int k0 = 0; k0 < K; k0 += 16) {
            {
                const int r = t >> 2, kc = (t & 3) * 4;
                const float4 v = *(const float4*)(A + (size_t)(m0 + r) * lda + k0 + kc);
                As[(kc + 0) * 132 + r] = v.x; As[(kc + 1) * 132 + r] = v.y; As[(kc + 2) * 132 + r] = v.z; As[(kc + 3) * 132 + r] = v.w;
            }
            {
                const int kr = t >> 5, c2 = (t & 31) * 2;
                const float2 v = *(const float2*)(B + (size_t)(k0 + kr) * ldb + n0 + c2);
                Bs[kr * 64 + c2] = v.x; Bs[kr * 64 + c2 + 1] = v.y;
                if (MODE == 1) { const float2 w = *(const float2*)(B2 + (size_t)(k0 + kr) * ldb + n0 + c2); B2s[kr * 64 + c2] = w.x; B2s[kr * 64 + c2 + 1] = w.y; }
            }
            __syncthreads();
#pragma unroll
            for (int kk = 0; kk < 16; ++kk) {
                const float4 a = *(const float4*)(As + kk * 132 + ty * 4);
                const float4 b = *(const float4*)(Bs + kk * 64 + tx * 4);
                const float av[4] = {a.x, a.y, a.z, a.w}, bv[4] = {b.x, b.y, b.z, b.w};
#pragma unroll
                for (int i = 0; i < 4; ++i)
#pragma unroll
                    for (int j = 0; j < 4; ++j) acc[i][j] += av[i] * bv[j];
                if (MODE == 1) {
                    const float4 b2 = *(const float4*)(B2s + kk * 64 + tx * 4);
                    const float b2v[4] = {b2.x, b2.y, b2.z, b2.w};
#pragma unroll
                    for (int i = 0; i < 4; ++i)
#pragma unroll
                        for (int j = 0; j < 4; ++j) acc2[i][j] += av[i] * b2v[j];
                }
            }
            __syncthreads();
        }
#pragma unroll
        for (int i = 0; i < 4; ++i) {
            const int r = m0 + ty * 4 + i, c = n0 + tx * 4;
            float o[4];
#pragma unroll
            for (int j = 0; j < 4; ++j) {
                float v = acc[i][j];
                if (MODE == 1) { const float sg = 1.0f / (1.0f + expf(-v)); v = v * sg * acc2[i][j]; }
                if (MODE == 2) { const float zz = v + bias[c + j]; const float sg = 1.0f / (1.0f + expf(-zz)); v = A[(size_t)r * lda + c + j] * sg; }
                o[j] = v;
            }
            *(float4*)(C + (size_t)r * ldc + c) = make_float4(o[0], o[1], o[2], o[3]);
        }
    }
}

__device__ void nv_kmean(const float* k, int ldk, float* kmean, int bid, int nblk) {
    for (int idx = bid * blockDim.x + threadIdx.x; idx < BATCH * NBLK * D_ATTN; idx += nblk * blockDim.x) {
        const int c = idx % D_ATTN, bn = idx / D_ATTN;
        const float* p = k + (size_t)bn * MOBA_L * ldk + c;
        float s = 0.f;
        for (int r = 0; r < MOBA_L; ++r) s += p[(size_t)r * ldk];
        kmean[idx] = s * (1.0f / MOBA_L);
    }
}

__device__ void nv_attn(const float* q, const float* k, const float* v, int ld, const float* kmean, float* out, int ldo, int bid, int nblk) {
    const int lane = threadIdx.x & 63, wave = threadIdx.x >> 6, nw = blockDim.x >> 6;
    const int nwu = BATCH * NH * (SEQ / 64);
    for (int wu = bid * nw + wave; wu < nwu; wu += nblk * nw) {
        const int wuu = __builtin_amdgcn_readfirstlane(wu);
        const int tc = wuu % (SEQ / 64), bh = wuu / (SEQ / 64), h = bh % NH, b = bh / NH;
        const int t = tc * 64 + lane, qb = (tc * 64) / MOBA_L;
        const float slope = exp2f(-(float)(h + 1));
        float qv[HD];
        const float* qp = q + (size_t)(b * SEQ + t) * ld + h * HD;
#pragma unroll
        for (int d = 0; d < HD; d += 4) { const float4 x = *(const float4*)(qp + d); qv[d] = x.x; qv[d + 1] = x.y; qv[d + 2] = x.z; qv[d + 3] = x.w; }
        float gate[NBLK];
#pragma unroll
        for (int n = 0; n < NBLK; ++n) {
            gate[n] = -1e30f;
            if (n < qb) { const float* km = kmean + (size_t)(b * NBLK + n) * D_ATTN + h * HD; float s = 0.f;
#pragma unroll
                for (int d = 0; d < HD; ++d) s += qv[d] * km[d];
                gate[n] = s; }
        }
        unsigned selmask = 0u;
#pragma unroll
        for (int n = 0; n < NBLK; ++n) {
            int rank = 0;
#pragma unroll
            for (int m2 = 0; m2 < NBLK; ++m2) { if (m2 < qb && (gate[m2] > gate[n] || (gate[m2] == gate[n] && m2 < n))) ++rank; }
            if (n < qb && rank < 3) selmask |= (1u << n);
        }
        float mrun = -INFINITY, lrun = 0.f, o[HD];
#pragma unroll
        for (int d = 0; d < HD; ++d) o[d] = 0.f;
        for (int n = 0; n <= qb; ++n) {
            const bool sel = (n == qb) || ((selmask >> n) & 1u);
            if (!__any(sel)) continue;
            for (int j = 0; j < MOBA_L; ++j) {
                const int kp = n * MOBA_L + j;
                const float* kr = k + (size_t)(b * SEQ + kp) * ld + h * HD;
                const float* vr = v + (size_t)(b * SEQ + kp) * ld + h * HD;
                float s = 0.f;
#pragma unroll
                for (int d = 0; d < HD; ++d) s += qv[d] * kr[d];
                s = s * 0.125f - slope * (float)(t - kp);
                const bool valid = sel && (kp <= t);
                if (valid) {
                    const float mn = fmaxf(mrun, s), corr = expf(mrun - mn), p = expf(s - mn);
                    lrun = lrun * corr + p;
#pragma unroll
                    for (int d = 0; d < HD; ++d) o[d] = o[d] * corr + p * vr[d];
                    mrun = mn;
                }
            }
        }
        const float inv = 1.0f / lrun;
        float* op = out + (size_t)(b * SEQ + t) * ldo + h * HD;
#pragma unroll
        for (int d = 0; d < HD; d += 4) *(float4*)(op + d) = make_float4(o[d] * inv, o[d + 1] * inv, o[d + 2] * inv, o[d + 3] * inv);
    }
}

__device__ __forceinline__ float gelu_tanh(float x) { const float u = 0.7978845608028654f * (x + 0.044715f * x * x * x); return 0.5f * x * (1.0f + tanhf(u)); }

__device__ void nv_ssm(const float* us, int ldu, const float* lam_re, const float* lam_im, const float* log_dt, const float* b_re, const float* b_im,
                       const float* c_re, const float* c_im, const float* d_skip, float* yout, int ldy, int bid, int nblk) {
    const int lane = threadIdx.x & 63, wave = threadIdx.x >> 6, nw = blockDim.x >> 6;
    for (int wu = bid * nw + wave; wu < BATCH * NG; wu += nblk * nw) {
        const int wuu = __builtin_amdgcn_readfirstlane(wu);
        const int g = wuu % NG, b = wuu / NG, p = lane;
        const double lr = (double)lam_re[g * SSM_P + p], li = (double)lam_im[g * SSM_P + p], dt = exp((double)log_dt[g]);
        const double mag = exp(lr * dt), ang = li * dt, are = mag * cos(ang), aim = mag * sin(ang), den = lr * lr + li * li;
        const double fre = ((are - 1.0) * lr + aim * li) / den, fim = (aim * lr - (are - 1.0) * li) / den;
        const float a_re = (float)are, a_im = (float)aim;
        float bbr[SSM_GROUP], bbi[SSM_GROUP], cr[SSM_GROUP], ci[SSM_GROUP];
#pragma unroll
        for (int h = 0; h < SSM_GROUP; ++h) {
            const double br = (double)b_re[(g * SSM_P + p) * SSM_GROUP + h], bi = (double)b_im[(g * SSM_P + p) * SSM_GROUP + h];
            bbr[h] = (float)(fre * br - fim * bi); bbi[h] = (float)(fre * bi + fim * br);
            cr[h] = c_re[(g * SSM_GROUP + h) * SSM_P + p]; ci[h] = c_im[(g * SSM_GROUP + h) * SSM_P + p];
        }
        const float dsk = (lane < SSM_GROUP) ? d_skip[g * SSM_GROUP + lane] : 0.f;
        float hre = 0.f, him = 0.f;
        for (int t = 0; t < SEQ; ++t) {
            const float* up = us + (size_t)(b * SEQ + t) * ldu + g * SSM_GROUP;
            float xr = 0.f, xi = 0.f, uu[SSM_GROUP];
#pragma unroll
            for (int h = 0; h < SSM_GROUP; ++h) { uu[h] = up[h]; xr += uu[h] * bbr[h]; xi += uu[h] * bbi[h]; }
            const float nre = a_re * hre - a_im * him + xr, nim = a_re * him + a_im * hre + xi;
            hre = nre; him = nim;
            float mine = 0.f, myu = 0.f;
#pragma unroll
            for (int h = 0; h < SSM_GROUP; ++h) { const float tot = wave_sum(hre * cr[h] - him * ci[h]); if (lane == h) { mine = tot; myu = uu[h]; } }
            if (lane < SSM_GROUP) { const float y = mine + dsk * myu; yout[(size_t)(b * SEQ + t) * ldy + g * SSM_GROUP + lane] = gelu_tanh(y); }
        }
    }
}

constexpr size_t WS_A = 0, WS_B = (size_t)MTOK * 1024 * 4;
constexpr size_t WS_PROJ = WS_B, WS_ATTN = WS_B + (size_t)MTOK * 2048 * 4, WS_KMEAN = WS_ATTN + (size_t)MTOK * 512 * 4;

constexpr int NSTAGES = 20;
__global__ void __launch_bounds__(NTHR) k_stage(Args a) {
    extern __shared__ __attribute__((aligned(16))) unsigned char lds[];
    float* smem = (float*)lds;
    const int bid = blockIdx.x, nblk = gridDim.x;
    float* RA = (float*)(a.ws + WS_A); float* RB = (float*)(a.ws + WS_B);
    float* PROJ = (float*)(a.ws + WS_PROJ); float* ATT = (float*)(a.ws + WS_ATTN); float* KMEAN = (float*)(a.ws + WS_KMEAN);
    float* H = a.out;
    const float* x = a.in[I_X];
    switch (a.stage) {
    case 0:  nv_rms(x, 1024, a.in[I_F1PRE], 1024, MTOK, nullptr, 0, 1.f, RA, 1024, bid, nblk); break;
    case 1:  nv_gemm<1>(RA, 1024, a.in[I_F1WG], a.in[I_F1WU], D_FF, RB, D_FF, MTOK, D_FF, 1024, nullptr, smem, bid, nblk); break;
    case 2:  nv_gemm<0>(RB, D_FF, a.in[I_F1WD], nullptr, 1024, RA, 1024, MTOK, 1024, D_FF, nullptr, smem, bid, nblk); break;
    case 3:  nv_rms(RA, 1024, a.in[I_F1POST], 1024, MTOK, x, 1024, 0.5f, H, 1024, bid, nblk); break;
    case 4:  nv_rms(H, 1024, a.in[I_MIXPRE], 1024, MTOK, nullptr, 0, 1.f, RA, 1024, bid, nblk); break;
    case 5:  nv_gemm<0>(RA, 1024, a.in[I_WIN], nullptr, D_IN, PROJ, D_IN, MTOK, D_IN, 1024, nullptr, smem, bid, nblk); break;
    case 6:  nv_kmean(PROJ + 512, D_IN, KMEAN, bid, nblk); break;
    case 7:  nv_attn(PROJ, PROJ + 512, PROJ + 1024, D_IN, KMEAN, ATT, 512, bid, nblk); break;
    case 8:  nv_ssm(PROJ + 1536, D_IN, a.in[I_LAMRE], a.in[I_LAMIM], a.in[I_LOGDT], a.in[I_BRE], a.in[I_BIM], a.in[I_CRE], a.in[I_CIM], a.in[I_DSKIP],
                    PROJ  , D_IN, bid, nblk); break;
    case 9:  nv_gemm<2>(PROJ, D_IN, a.in[I_WGLU], nullptr, 512, PROJ + 512, D_IN, MTOK, 512, 512, a.in[I_BGLU], smem, bid, nblk); break;
    case 10: nv_rms(ATT, 512, a.in[I_ATTNG], 512, MTOK, nullptr, 0, 1.f, RA, 1024, bid, nblk); break;
    case 11: nv_rms(PROJ + 512, D_IN, a.in[I_SSMG], 512, MTOK, nullptr, 0, 1.f, RA + 512, 1024, bid, nblk); break;
    case 12: nv_gemm<0>(RA, 1024, a.in[I_WOUT], nullptr, 1024, PROJ, 1024, MTOK, 1024, 1024, nullptr, smem, bid, nblk); break;
    case 13: nv_rms(PROJ, 1024, a.in[I_MIXPOST], 1024, MTOK, H, 1024, 1.0f, H, 1024, bid, nblk); break;
    case 14: nv_rms(H, 1024, a.in[I_F2PRE], 1024, MTOK, nullptr, 0, 1.f, RA, 1024, bid, nblk); break;
    case 15: nv_gemm<1>(RA, 1024, a.in[I_F2WG], a.in[I_F2WU], D_FF, RB, D_FF, MTOK, D_FF, 1024, nullptr, smem, bid, nblk); break;
    case 16: nv_gemm<0>(RB, D_FF, a.in[I_F2WD], nullptr, 1024, RA, 1024, MTOK, 1024, D_FF, nullptr, smem, bid, nblk); break;
    case 17: nv_rms(RA, 1024, a.in[I_F2POST], 1024, MTOK, H, 1024, 0.5f, H, 1024, bid, nblk); break;
    default: break;
    }
}

extern "C" void kernel_launch(void* const* d_in, const int* in_sizes, int n_in, void* d_out, int out_size, void* d_ws, size_t ws_size, hipStream_t stream) {
    if (n_in != 27 || out_size != MTOK * D_MODEL || ws_size < WS_KMEAN + (size_t)BATCH * NBLK * D_ATTN * 4) { fprintf(stderr, "kernel_launch: unexpected shapes n_in %d out %d ws %zu\n", n_in, out_size, ws_size); return; }
    Args a{};
    for (int i = 0; i < 27; ++i) a.in[i] = (const float*)d_in[i];
    a.out = (float*)d_out; a.ws = (unsigned char*)d_ws;
    const int lds_bytes = (16 * 132 + 2 * 16 * 64) * 4;
    for (int s = 0; s < 18; ++s) {
        a.stage = s;
        int grid = 2048;
        if (s == 8) grid = 32;
        hipLaunchKernelGGL(k_stage, dim3(grid), dim3(NTHR), lds_bytes, stream, a);
    }
}
```

```cpp
#include <hip/hip_runtime.h>
#include <cstdint>
#include <cstdio>

constexpr int D_MODEL = 1024, BATCH = 8, SEQ = 2048, MTOK = BATCH * SEQ;
constexpr int NH = 8, HD = 64, D_ATTN = 512, MOBA_L = 256, NBLK = SEQ / MOBA_L;
constexpr int SSM_GROUP = 16, D_SSM = 512, NG = 32, SSM_P = 64;
constexpr int D_IN = 2048, D_FF = 2816;
constexpr float RMS_EPS = 1e-6f;
constexpr int NTHR = 512;

struct Args {
    const float* in[27];
    float* out;
    unsigned char* ws;
    int stage, pad;
};
enum { I_X = 0, I_F1PRE, I_F1WG, I_F1WU, I_F1WD, I_F1POST, I_MIXPRE, I_WIN, I_LAMRE, I_LAMIM, I_LOGDT, I_BRE, I_BIM, I_CRE, I_CIM, I_DSKIP,
       I_WGLU, I_BGLU, I_ATTNG, I_SSMG, I_WOUT, I_MIXPOST, I_F2PRE, I_F2WG, I_F2WU, I_F2WD, I_F2POST };

__device__ __forceinline__ float wave_sum(float v) {
#pragma unroll
    for (int o = 1; o < 64; o <<= 1) v += __shfl_xor(v, o);
    return v;
}

__device__ void nv_rms(const float* in, int ldin, const float* g, int ncols, int nrows, const float* base, int ldbase, float alpha, float* out, int ldout, int bid, int nblk) {
    const int lane = threadIdx.x & 63, wave = threadIdx.x >> 6, nw = blockDim.x >> 6;
    for (int r = bid * nw + wave; r < nrows; r += nblk * nw) {
        const float* ir = in + (size_t)r * ldin;
        float s = 0.f;
        for (int c = lane * 4; c < ncols; c += 256) { const float4 v = *(const float4*)(ir + c); s += v.x * v.x + v.y * v.y + v.z * v.z + v.w * v.w; }
        s = wave_sum(s);
        const float rs = 1.0f / sqrtf(s / (float)ncols + RMS_EPS);
        for (int c = lane * 4; c < ncols; c += 256) {
            const float4 v = *(const float4*)(ir + c); const float4 gg = *(const float4*)(g + c);
            float4 b = make_float4(0.f, 0.f, 0.f, 0.f); if (base) b = *(const float4*)(base + (size_t)r * ldbase + c);
            float4 o; o.x = b.x + alpha * (v.x * rs * gg.x); o.y = b.y + alpha * (v.y * rs * gg.y); o.z = b.z + alpha * (v.z * rs * gg.z); o.w = b.w + alpha * (v.w * rs * gg.w);
            *(float4*)(out + (size_t)r * ldout + c) = o;
        }
    }
}

template <int MODE>
__device__ void nv_gemm(const float* A, int lda, const float* B, const float* B2, int ldb, float* C, int ldc, int M, int N, int K, const float* bias, float* smem, int bid, int nblk) {
    float* As = smem;
    float* Bs = smem + 16 * 132;
    float* B2s = Bs + 16 * 64;
    const int t = threadIdx.x, ty = t >> 4, tx = t & 15;
    const int ntm = M / 128, ntn = N / 64;
    for (int tile = bid; tile < ntm * ntn; tile += nblk) {
        const int tm = tile / ntn, tn = tile % ntn, m0 = tm * 128, n0 = tn * 64;
        float acc[4][4], acc2[4][4];
#pragma unroll
        for (int i = 0; i < 4; ++i)
#pragma unroll
            for (int j = 0; j < 4; ++j) { acc[i][j] = 0.f; acc2[i][j] = 0.f; }
        for (int k0 = 0; k0 < K; k0 += 16) {
            {
                const int r = t >> 2, kc = (t & 3) * 4;
                const float4 v = *(const float4*)(A + (size_t)(m0 + r) * lda + k0 + kc);
                As[(kc + 0) * 132 + r] = v.x; As[(kc + 1) * 132 + r] = v.y; As[(kc + 2) * 132 + r] = v.z; As[(kc + 3) * 132 + r] = v.w;
            }
            {
                const int kr = t >> 5, c2 = (t & 31) * 2;
                const float2 v = *(const float2*)(B + (size_t)(k0 + kr) * ldb + n0 + c2);
                Bs[kr * 64 + c2] = v.x; Bs[kr * 64 + c2 + 1] = v.y;
                if (MODE == 1) { const float2 w = *(const float2*)(B2 + (size_t)(k0 + kr) * ldb + n0 + c2); B2s[kr * 64 + c2] = w.x; B2s[kr * 64 + c2 + 1] = w.y; }
            }
            __syncthreads();
#pragma unroll
            for (int kk = 0; kk < 16; ++kk) {
                const float4 a = *(const float4*)(As + kk * 132 + ty * 4);
                const float4 b = *(const float4*)(Bs + kk * 64 + tx * 4);
                const float av[4] = {a.x, a.y, a.z, a.w}, bv[4] = {b.x, b.y, b.z, b.w};
#pragma unroll
                for (int i = 0; i < 4; ++i)
#pragma unroll
                    for (int j = 0; j < 4; ++j) acc[i][j] += av[i] * bv[j];
                if (MODE == 1) {
                    const float4 b2 = *(const float4*)(B2s + kk * 64 + tx * 4);
                    const float b2v[4] = {b2.x, b2.y, b2.z, b2.w};
#pragma unroll
                    for (int i = 0; i < 4; ++i)
#pragma unroll
                        for (int j = 0; j < 4; ++j) acc2[i][j] += av[i] * b2v[j];
                }
            }
            __syncthreads();
        }
#pragma unroll
        for (int i = 0; i < 4; ++i) {
            const int r = m0 + ty * 4 + i, c = n0 + tx * 4;
            float o[4];
#pragma unroll
            for (int j = 0; j < 4; ++j) {
                float v = acc[i][j];
                if (MODE == 1) { const float sg = 1.0f / (1.0f + expf(-v)); v = v * sg * acc2[i][j]; }
                if (MODE == 2) { const float zz = v + bias[c + j]; const float sg = 1.0f / (1.0f + expf(-zz)); v = A[(size_t)r * lda + c + j] * sg; }
                o[j] = v;
            }
            *(float4*)(C + (size_t)r * ldc + c) = make_float4(o[0], o[1], o[2], o[3]);
        }
    }
}

__device__ void nv_kmean(const float* k, int ldk, float* kmean, int bid, int nblk) {
    for (int idx = bid * blockDim.x + threadIdx.x; idx < BATCH * NBLK * D_ATTN; idx += nblk * blockDim.x) {
        const int c = idx % D_ATTN, bn = idx / D_ATTN;
        const float* p = k + (size_t)bn * MOBA_L * ldk + c;
        float s = 0.f;
        for (int r = 0; r < MOBA_L; ++r) s += p[(size_t)r * ldk];
        kmean[idx] = s * (1.0f / MOBA_L);
    }
}

__device__ void nv_attn(const float* q, const float* k, const float* v, int ld, const float* kmean, float* out, int ldo, int bid, int nblk) {
    const int lane = threadIdx.x & 63, wave = threadIdx.x >> 6, nw = blockDim.x >> 6;
    const int nwu = BATCH * NH * (SEQ / 64);
    for (int wu = bid * nw + wave; wu < nwu; wu += nblk * nw) {
        const int wuu = __builtin_amdgcn_readfirstlane(wu);
        const int tc = wuu % (SEQ / 64), bh = wuu / (SEQ / 64), h = bh % NH, b = bh / NH;
        const int t = tc * 64 + lane, qb = (tc * 64) / MOBA_L;
        const float slope = exp2f(-(float)(h + 1));
        float qv[HD];
        const float* qp = q + (size_t)(b * SEQ + t) * ld + h * HD;
#pragma unroll
        for (int d = 0; d < HD; d += 4) { const float4 x = *(const float4*)(qp + d); qv[d] = x.x; qv[d + 1] = x.y; qv[d + 2] = x.z; qv[d + 3] = x.w; }
        float gate[NBLK];
#pragma unroll
        for (int n = 0; n < NBLK; ++n) {
            gate[n] = -1e30f;
            if (n < qb) { const float* km = kmean + (size_t)(b * NBLK + n) * D_ATTN + h * HD; float s = 0.f;
#pragma unroll
                for (int d = 0; d < HD; ++d) s += qv[d] * km[d];
                gate[n] = s; }
        }
        unsigned selmask = 0u;
#pragma unroll
        for (int n = 0; n < NBLK; ++n) {
            int rank = 0;
#pragma unroll
            for (int m2 = 0; m2 < NBLK; ++m2) { if (m2 < qb && (gate[m2] > gate[n] || (gate[m2] == gate[n] && m2 < n))) ++rank; }
            if (n < qb && rank < 3) selmask |= (1u << n);
        }
        float mrun = -INFINITY, lrun = 0.f, o[HD];
#pragma unroll
        for (int d = 0; d < HD; ++d) o[d] = 0.f;
        for (int n = 0; n <= qb; ++n) {
            const bool sel = (n == qb) || ((selmask >> n) & 1u);
            if (!__any(sel)) continue;
            for (int j = 0; j < MOBA_L; ++j) {
                const int kp = n * MOBA_L + j;
                const float* kr = k + (size_t)(b * SEQ + kp) * ld + h * HD;
                const float* vr = v + (size_t)(b * SEQ + kp) * ld + h * HD;
                float s = 0.f;
#pragma unroll
                for (int d = 0; d < HD; ++d) s += qv[d] * kr[d];
                s = s * 0.125f - slope * (float)(t - kp);
                const bool valid = sel && (kp <= t);
                if (valid) {
                    const float mn = fmaxf(mrun, s), corr = expf(mrun - mn), p = expf(s - mn);
                    lrun = lrun * corr + p;
#pragma unroll
                    for (int d = 0; d < HD; ++d) o[d] = o[d] * corr + p * vr[d];
                    mrun = mn;
                }
            }
        }
        const float inv = 1.0f / lrun;
        float* op = out + (size_t)(b * SEQ + t) * ldo + h * HD;
#pragma unroll
        for (int d = 0; d < HD; d += 4) *(float4*)(op + d) = make_float4(o[d] * inv, o[d + 1] * inv, o[d + 2] * inv, o[d + 3] * inv);
    }
}

__device__ __forceinline__ float gelu_tanh(float x) { const float u = 0.7978845608028654f * (x + 0.044715f * x * x * x); return 0.5f * x * (1.0f + tanhf(u)); }

__device__ void nv_ssm(const float* us, int ldu, const float* lam_re, const float* lam_im, const float* log_dt, const float* b_re, const float* b_im,
                       const float* c_re, const float* c_im, const float* d_skip, float* yout, int ldy, int bid, int nblk) {
    const int lane = threadIdx.x & 63, wave = threadIdx.x >> 6, nw = blockDim.x >> 6;
    for (int wu = bid * nw + wave; wu < BATCH * NG; wu += nblk * nw) {
        const int wuu = __builtin_amdgcn_readfirstlane(wu);
        const int g = wuu % NG, b = wuu / NG, p = lane;
        const double lr = (double)lam_re[g * SSM_P + p], li = (double)lam_im[g * SSM_P + p], dt = exp((double)log_dt[g]);
        const double mag = exp(lr * dt), ang = li * dt, are = mag * cos(ang), aim = mag * sin(ang), den = lr * lr + li * li;
        const double fre = ((are - 1.0) * lr + aim * li) / den, fim = (aim * lr - (are - 1.0) * li) / den;
        const float a_re = (float)are, a_im = (float)aim;
        float bbr[SSM_GROUP], bbi[SSM_GROUP], cr[SSM_GROUP], ci[SSM_GROUP];
#pragma unroll
        for (int h = 0; h < SSM_GROUP; ++h) {
            const double br = (double)b_re[(g * SSM_P + p) * SSM_GROUP + h], bi = (double)b_im[(g * SSM_P + p) * SSM_GROUP + h];
            bbr[h] = (float)(fre * br - fim * bi); bbi[h] = (float)(fre * bi + fim * br);
            cr[h] = c_re[(g * SSM_GROUP + h) * SSM_P + p]; ci[h] = c_im[(g * SSM_GROUP + h) * SSM_P + p];
        }
        const float dsk = (lane < SSM_GROUP) ? d_skip[g * SSM_GROUP + lane] : 0.f;
        float hre = 0.f, him = 0.f;
        for (int t = 0; t < SEQ; ++t) {
            const float* up = us + (size_t)(b * SEQ + t) * ldu + g * SSM_GROUP;
            float xr = 0.f, xi = 0.f, uu[SSM_GROUP];
#pragma unroll
            for (int h = 0; h < SSM_GROUP; ++h) { uu[h] = up[h]; xr += uu[h] * bbr[h]; xi += uu[h] * bbi[h]; }
            const float nre = a_re * hre - a_im * him + xr, nim = a_re * him + a_im * hre + xi;
            hre = nre; him = nim;
            float mine = 0.f, myu = 0.f;
#pragma unroll
            for (int h = 0; h < SSM_GROUP; ++h) { const float tot = wave_sum(hre * cr[h] - him * ci[h]); if (lane == h) { mine = tot; myu = uu[h]; } }
            if (lane < SSM_GROUP) { const float y = mine + dsk * myu; yout[(size_t)(b * SEQ + t) * ldy + g * SSM_GROUP + lane] = gelu_tanh(y); }
        }
    }
}

constexpr size_t WS_A = 0, WS_B = (size_t)MTOK * 1024 * 4;
constexpr size_t WS_PROJ = WS_B, WS_ATTN = WS_B + (size_t)MTOK * 2048 * 4, WS_KMEAN = WS_ATTN + (size_t)MTOK * 512 * 4;


#define GAS __attribute__((address_space(1)))
#define LAS __attribute__((address_space(3)))
#define XB_TMO      128
#define XB_XCNT(j)  (256  + 64 * (j))
#define XB_XSUB(j)  (1280 + 64 * (j))
#define XB_XGEN(j)  (2304 + 64 * (j))
#define XB_TOP      3328
#define XB_TOPGEN   3392
#define XCD_BAR_WORDS 3456
#define XB_SPIN_CAP (1u << 22)
__device__ __forceinline__ unsigned xb_ld(unsigned* p)              { return __hip_atomic_load(p, __ATOMIC_RELAXED, __HIP_MEMORY_SCOPE_AGENT); }
__device__ __forceinline__ unsigned xb_add(unsigned* p, unsigned v) { return __hip_atomic_fetch_add(p, v, __ATOMIC_RELAXED, __HIP_MEMORY_SCOPE_AGENT); }
__device__ __forceinline__ unsigned xb_xcc_id() { return (unsigned)__builtin_amdgcn_s_getreg((3 << 11) | 20) & 0xFu; }
#define XB_SPIN(cond, bar) do { unsigned _sp = 0; while (cond) { __builtin_amdgcn_s_sleep(1); \
    if ((++_sp & 255u) == 0u) { if (xb_ld(&(bar)[XB_TMO])) break; if (_sp > XB_SPIN_CAP) { atomicAdd(&(bar)[XB_TMO], 1u); break; } } } } while (0)
struct XcdBarrier { unsigned* bar; unsigned x; volatile LAS unsigned* st; };
__device__ __forceinline__ XcdBarrier xcd_barrier_post(unsigned* bar, volatile LAS unsigned* st) {
    XcdBarrier b; b.bar = bar; b.x = xb_xcc_id(); b.st = st;
    if (threadIdx.x == 0) (void)xb_add(&bar[XB_XCNT(b.x)], 1u);
    return b;
}
__device__ __forceinline__ void xcd_barrier_complete(unsigned* bar, unsigned x, unsigned& nloc, unsigned& nx) {
    const unsigned G = gridDim.x * gridDim.y * gridDim.z;
    unsigned sum, cnt, mine, sp = 0u;
    for (;;) {
        sum = 0u; cnt = 0u; mine = 0u;
#pragma unroll
        for (unsigned j = 0; j < 16; ++j) { const unsigned c = xb_ld(&bar[XB_XCNT(j)]); sum += c; cnt += (c > 0u) ? 1u : 0u; mine = (j == x) ? c : mine; }
        if (sum == G) break;
        __builtin_amdgcn_s_sleep(1);
        if ((++sp & 255u) == 0u) { if (xb_ld(&bar[XB_TMO])) break; if (sp > XB_SPIN_CAP) { atomicAdd(&bar[XB_TMO], 1u); break; } }
    }
    nloc = mine > 0u ? mine : 1u; nx = cnt > 0u ? cnt : 1u;
}
__device__ __forceinline__ void xcd_barrier(const XcdBarrier& b) {
    asm volatile("s_waitcnt vmcnt(0)" ::: "memory");
    __syncthreads();
    if (threadIdx.x == 0) {
        unsigned* bar = b.bar;
        __builtin_amdgcn_s_waitcnt(0);
        unsigned nloc = b.st[0], nx = b.st[1];
        if (nloc == 0u) { xcd_barrier_complete(bar, b.x, nloc, nx); b.st[0] = nloc; b.st[1] = nx; }
        const unsigned old = xb_add(&bar[XB_XSUB(b.x)], 1u);
        const unsigned gen = old / nloc;
        if (old + 1u == (gen + 1u) * nloc) {
            __builtin_amdgcn_fence(__ATOMIC_RELEASE, "agent");
            asm volatile("s_waitcnt vmcnt(0)" ::: "memory");
            const unsigned og = xb_add(&bar[XB_TOP], 1u);
            const unsigned tg = og / nx;
            if (og + 1u == (tg + 1u) * nx) xb_add(&bar[XB_TOPGEN], 1u);
            else XB_SPIN(xb_ld(&bar[XB_TOPGEN]) == tg, bar);
            __builtin_amdgcn_fence(__ATOMIC_ACQUIRE, "agent");
            xb_add(&bar[XB_XGEN(b.x)], 1u);
            asm volatile("s_waitcnt vmcnt(0)" ::: "memory");
        } else {
            XB_SPIN(xb_ld(&bar[XB_XGEN(b.x)]) == gen, bar);
            __builtin_amdgcn_fence(__ATOMIC_ACQUIRE, "agent");
            asm volatile("s_waitcnt vmcnt(0)" ::: "memory");
        }
    }
    __syncthreads();
}
constexpr size_t WS_CTL = 255u * 1048576u, CTL_BYTES = 65536;
constexpr int LDS_BYTES = 147456, MISC_OFF = 131072 + 320;

__global__ void __launch_bounds__(NTHR, 2) k_mega(Args a) {
    extern __shared__ __attribute__((aligned(16))) unsigned char lds[];
    float* smem = (float*)lds;
    const int bid = blockIdx.x, nblk = gridDim.x;
    volatile LAS unsigned* MISC = (volatile LAS unsigned*)((LAS unsigned char*)lds + MISC_OFF);
    if (threadIdx.x < 32) MISC[threadIdx.x] = 0u;
    __syncthreads();
    XcdBarrier bar = xcd_barrier_post((unsigned*)(a.ws + WS_CTL), MISC + 8);
    float* RA = (float*)(a.ws + WS_A); float* RB = (float*)(a.ws + WS_B);
    float* PROJ = (float*)(a.ws + WS_PROJ); float* ATT = (float*)(a.ws + WS_ATTN); float* KMEAN = (float*)(a.ws + WS_KMEAN);
    float* H = a.out;
    const float* x = a.in[I_X];
    for (int stage = 0; stage < 18; ++stage) {
    if (stage) xcd_barrier(bar);
    switch (stage) {
    case 0:  nv_rms(x, 1024, a.in[I_F1PRE], 1024, MTOK, nullptr, 0, 1.f, RA, 1024, bid, nblk); break;
    case 1:  nv_gemm<1>(RA, 1024, a.in[I_F1WG], a.in[I_F1WU], D_FF, RB, D_FF, MTOK, D_FF, 1024, nullptr, smem, bid, nblk); break;
    case 2:  nv_gemm<0>(RB, D_FF, a.in[I_F1WD], nullptr, 1024, RA, 1024, MTOK, 1024, D_FF, nullptr, smem, bid, nblk); break;
    case 3:  nv_rms(RA, 1024, a.in[I_F1POST], 1024, MTOK, x, 1024, 0.5f, H, 1024, bid, nblk); break;
    case 4:  nv_rms(H, 1024, a.in[I_MIXPRE], 1024, MTOK, nullptr, 0, 1.f, RA, 1024, bid, nblk); break;
    case 5:  nv_gemm<0>(RA, 1024, a.in[I_WIN], nullptr, D_IN, PROJ, D_IN, MTOK, D_IN, 1024, nullptr, smem, bid, nblk); break;
    case 6:  nv_kmean(PROJ + 512, D_IN, KMEAN, bid, nblk); break;
    case 7:  nv_attn(PROJ, PROJ + 512, PROJ + 1024, D_IN, KMEAN, ATT, 512, bid, nblk); break;
    case 8:  nv_ssm(PROJ + 1536, D_IN, a.in[I_LAMRE], a.in[I_LAMIM], a.in[I_LOGDT], a.in[I_BRE], a.in[I_BIM], a.in[I_CRE], a.in[I_CIM], a.in[I_DSKIP],
                    PROJ  , D_IN, bid, nblk); break;
    case 9:  nv_gemm<2>(PROJ, D_IN, a.in[I_WGLU], nullptr, 512, PROJ + 512, D_IN, MTOK, 512, 512, a.in[I_BGLU], smem, bid, nblk); break;
    case 10: nv_rms(ATT, 512, a.in[I_ATTNG], 512, MTOK, nullptr, 0, 1.f, RA, 1024, bid, nblk); break;
    case 11: nv_rms(PROJ + 512, D_IN, a.in[I_SSMG], 512, MTOK, nullptr, 0, 1.f, RA + 512, 1024, bid, nblk); break;
    case 12: nv_gemm<0>(RA, 1024, a.in[I_WOUT], nullptr, 1024, PROJ, 1024, MTOK, 1024, 1024, nullptr, smem, bid, nblk); break;
    case 13: nv_rms(PROJ, 1024, a.in[I_MIXPOST], 1024, MTOK, H, 1024, 1.0f, H, 1024, bid, nblk); break;
    case 14: nv_rms(H, 1024, a.in[I_F2PRE], 1024, MTOK, nullptr, 0, 1.f, RA, 1024, bid, nblk); break;
    case 15: nv_gemm<1>(RA, 1024, a.in[I_F2WG], a.in[I_F2WU], D_FF, RB, D_FF, MTOK, D_FF, 1024, nullptr, smem, bid, nblk); break;
    case 16: nv_gemm<0>(RB, D_FF, a.in[I_F2WD], nullptr, 1024, RA, 1024, MTOK, 1024, D_FF, nullptr, smem, bid, nblk); break;
    case 17: nv_rms(RA, 1024, a.in[I_F2POST], 1024, MTOK, H, 1024, 0.5f, H, 1024, bid, nblk); break;
    default: break;
    }
    }
}

extern "C" void kernel_launch(void* const* d_in, const int* in_sizes, int n_in, void* d_out, int out_size, void* d_ws, size_t ws_size, hipStream_t stream) {
    static int grid = 0;
    if (grid == 0) {
        if (n_in != 27 || out_size != MTOK * D_MODEL || ws_size < 256u * 1048576u) { fprintf(stderr, "kernel_launch: unexpected shapes n_in %d out %d ws %zu\n", n_in, out_size, ws_size); grid = -1; return; }
        int dev = 0, cus = 0, per_cu = 0;
        if (hipGetDevice(&dev) != hipSuccess || hipDeviceGetAttribute(&cus, hipDeviceAttributeMultiprocessorCount, dev) != hipSuccess) { grid = -1; return; }
        if (hipFuncSetAttribute((const void*)k_mega, hipFuncAttributeMaxDynamicSharedMemorySize, LDS_BYTES) != hipSuccess) { fprintf(stderr, "hipFuncSetAttribute failed\n"); grid = -1; return; }
        if (hipOccupancyMaxActiveBlocksPerMultiprocessor(&per_cu, (const void*)k_mega, NTHR, LDS_BYTES) != hipSuccess || per_cu < 1) { fprintf(stderr, "occupancy query: %d blocks per CU\n", per_cu); grid = -1; (void)hipGetLastError(); return; }
        grid = cus;
    }
    if (grid < 0) return;
    if (hipMemsetAsync((char*)d_ws + WS_CTL, 0, CTL_BYTES, stream) != hipSuccess) return;
    Args a{};
    for (int i = 0; i < 27; ++i) a.in[i] = (const float*)d_in[i];
    a.out = (float*)d_out; a.ws = (unsigned char*)d_ws;
    hipLaunchKernelGGL(k_mega, dim3(grid), dim3(NTHR), LDS_BYTES, stream, a);
}
```

```cpp
#include <hip/hip_runtime.h>
#include <cstdint>
#include <cstdio>

constexpr int D_MODEL = 1024, BATCH = 8, SEQ = 2048, MTOK = BATCH * SEQ;
constexpr int NH = 8, HD = 64, D_ATTN = 512, MOBA_L = 256, NBLK = SEQ / MOBA_L;
constexpr int SSM_GROUP = 16, D_SSM = 512, NG = 32, SSM_P = 64;
constexpr int D_IN = 2048, D_FF = 2816;
constexpr float RMS_EPS = 1e-6f;
constexpr int NTHR = 512, NWAVES = 8;

struct Args {
    const float* in[27];
    float* out;
    unsigned char* ws;
    int stage, pad;
};
enum { I_X = 0, I_F1PRE, I_F1WG, I_F1WU, I_F1WD, I_F1POST, I_MIXPRE, I_WIN, I_LAMRE, I_LAMIM, I_LOGDT, I_BRE, I_BIM, I_CRE, I_CIM, I_DSKIP,
       I_WGLU, I_BGLU, I_ATTNG, I_SSMG, I_WOUT, I_MIXPOST, I_F2PRE, I_F2WG, I_F2WU, I_F2WD, I_F2POST };

namespace pg8 {
#define PG8_LAS __attribute__((address_space(3)))
typedef unsigned short bf16_t;
typedef short bf16x8 __attribute__((ext_vector_type(8)));
typedef float f32x4 __attribute__((ext_vector_type(4)));
typedef unsigned u32x4 __attribute__((ext_vector_type(4)));
constexpr int BM = 256, BK = 64, HALF = 128, HTB = HALF * BK * 2  , STAGE_BYTES = 8 * HTB, NXCD = 8, WGM = 8;

__host__ __device__ __forceinline__ int lds_byte(int r, int c) { const int st = (r >> 4) * 2 + (c >> 5), rr = r & 15, cc = c & 31, ob = rr * 64 + cc * 2; return st * 1024 + (ob ^ (((ob >> 9) & 1) << 5)); }
__host__ __device__ __forceinline__ void stage_rc(int b, int& R, int& C) { const int st = b / 1024, sb = b % 1024, swz = sb ^ (((sb >> 9) & 1) << 5); R = (st >> 1) * 16 + swz / 64; C = (st & 1) * 32 + (swz % 64) / 2; }
__host__ __device__ __forceinline__ int perm32(int rho) { const int n = rho >> 4, i = rho & 15; return 8 * (i >> 2) + 4 * n + (i & 3); }

struct Unit { int pm, pn; };
struct Gemm { const bf16_t* A; const bf16_t* Bt; int M, N, K; };

struct StaticOrder {
    int nM, nN, nwg, G, c;
    __host__ __device__ void init(int M, int N, int G_, int c_) { nM = M / BM; nN = N / BM; nwg = nM * nN; G = G_; c = c_; }
    __host__ __device__ bool next(int i, Unit& u) const {
        const long L = (long)i * G + c; if (L >= nwg) return false;
        int wgid = (int)L; { const int q = nwg / NXCD, r = nwg % NXCD, xcd = wgid % NXCD, off = wgid / NXCD; wgid = (xcd < r ? xcd * (q + 1) : r * (q + 1) + (xcd - r) * q) + off; }
        const int nig = WGM * nN, gid = wgid / nig, fm = gid * WGM, gsz = (nM - fm) < WGM ? (nM - fm) : WGM;
        u.pm = fm + ((wgid % nig) % gsz); u.pn = (wgid % nig) / gsz; return true;
    }
    __device__ __forceinline__ void a_ready(const Unit&) const {}
    __device__ __forceinline__ void done(const Unit&) const {}
};

__device__ __forceinline__ unsigned cvt_pk_bf16(float lo, float hi) { unsigned r; asm volatile("v_cvt_pk_bf16_f32 %0, %1, %2" : "=v"(r) : "v"(lo), "v"(hi)); return r; }

struct EpiF32 {
    static constexpr bool PERM = false, AFTER_DRAIN = false;
    float* C; int ldc;
    __device__ __forceinline__ void operator()(const f32x4 (&acc)[2][2][4][2], const Unit& u, int wr, int wc, int fr, int fq) const {
        const int row0 = u.pm * BM + wr * 64 + fr, col0 = u.pn * BM + wc * 32 + 4 * fq;
#pragma unroll
        for (int ai = 0; ai < 2; ++ai)
#pragma unroll
            for (int m = 0; m < 4; ++m) { float* rowp = C + (size_t)(row0 + ai * HALF + m * 16) * ldc + col0;
#pragma unroll
                for (int bj = 0; bj < 2; ++bj)
#pragma unroll
                    for (int n = 0; n < 2; ++n) *(f32x4*)(rowp + bj * HALF + n * 16) = acc[ai][bj][m][n]; }
    }
};
struct EpiSwiGLU {
    static constexpr bool PERM = true, AFTER_DRAIN = false;
    bf16_t* O; int ldc;
    __device__ __forceinline__ void operator()(const f32x4 (&acc)[2][2][4][2], const Unit& u, int wr, int wc, int fr, int fq) const {
        const int row0 = u.pm * BM + wr * 64 + fr, col0 = u.pn * HALF + wc * 32 + 8 * fq;
#pragma unroll
        for (int ai = 0; ai < 2; ++ai)
#pragma unroll
            for (int m = 0; m < 4; ++m) { bf16_t* rowp = O + (size_t)(row0 + ai * HALF + m * 16) * ldc + col0;
                float o[8];
#pragma unroll
                for (int n = 0; n < 2; ++n)
#pragma unroll
                    for (int e = 0; e < 4; ++e) { const float g = acc[ai][0][m][n][e], up = acc[ai][1][m][n][e];
                        const float sg = __builtin_amdgcn_rcpf(1.0f + __builtin_amdgcn_exp2f(-1.4426950408889634f * g)); o[n * 4 + e] = g * sg * up; }
                u32x4 w; w.x = cvt_pk_bf16(o[0], o[1]); w.y = cvt_pk_bf16(o[2], o[3]); w.z = cvt_pk_bf16(o[4], o[5]); w.w = cvt_pk_bf16(o[6], o[7]);
                *(u32x4*)rowp = w; }
    }
};

template <class Epi, class Sched, bool ALIGN_EPI = false, bool SP2 = false>
__device__ __forceinline__ void gemm_phase(PG8_LAS unsigned char* lds, const Gemm g, const Sched& S, const Epi& E) {
    const int tid = threadIdx.x, wid = __builtin_amdgcn_readfirstlane(tid >> 6), lane = tid & 63, wr = wid >> 2, wc = wid & 3, fr = lane & 15, fq = lane >> 4;
    const int K = g.K, nt = K / BK;
    unsigned voffA[2], voffB[2];
#pragma unroll
    for (int i = 0; i < 2; ++i) { int R, C; stage_rc(tid * 16 + i * 8192, R, C); const int Rb = Epi::PERM ? ((R & ~31) + perm32(R & 31)) : R;
        voffA[i] = (unsigned)(R * K + C) * 2u; voffB[i] = (unsigned)(Rb * K + C) * 2u; }
    const size_t kstep = (size_t)(BK * 2);
    const size_t hstep = (size_t)HALF * K * 2;
    const size_t tstep = 2 * hstep;
    const unsigned ldsw = (unsigned)wid * 1024u;
    const int aoff = lds_byte(wr * 64 + fr, fq * 8), boff = lds_byte(wc * 32 + fr, fq * 8);
#define PG8_SA(b, h) (((b) * 2 + (h)) * HTB)
#define PG8_SB(b, h) ((4 + (b) * 2 + (h)) * HTB)
#define PG8_STAGE(bufoff, gbase, voff) do { _Pragma("unroll") for (int _i = 0; _i < 2; ++_i) \
        __builtin_amdgcn_global_load_lds((const unsigned*)((const char*)(gbase) + (voff)[_i]), (PG8_LAS unsigned*)(lds + (bufoff) + ldsw + _i * 8192), 16, 0, 0); } while (0)
#define PG8_LDA(dst, b, h) do { _Pragma("unroll") for (int m = 0; m < 4; ++m) _Pragma("unroll") for (int k = 0; k < 2; ++k) dst[m][k] = *(const PG8_LAS bf16x8*)(lds + PG8_SA(b, h) + aoff + m * 2048 + k * 1024); } while (0)
#define PG8_LDB(dst, b, h) do { _Pragma("unroll") for (int n = 0; n < 2; ++n) _Pragma("unroll") for (int k = 0; k < 2; ++k) dst[n][k] = *(const PG8_LAS bf16x8*)(lds + PG8_SB(b, h) + boff + n * 2048 + k * 1024); } while (0)
#define PG8_MMA(ai, bj, At, Bt) do { __builtin_amdgcn_s_setprio(1); _Pragma("unroll") for (int m = 0; m < 4; ++m) _Pragma("unroll") for (int n = 0; n < 2; ++n) _Pragma("unroll") for (int k = 0; k < 2; ++k) \
        acc[ai][bj][m][n] = __builtin_amdgcn_mfma_f32_16x16x32_bf16(Bt[n][k], At[m][k], acc[ai][bj][m][n], 0, 0, 0); __builtin_amdgcn_s_setprio(0); } while (0)
#define PG8_WAIT_V(n) asm volatile("s_waitcnt vmcnt(" #n ")" ::: "memory")
#define PG8_WAIT_L(n) asm volatile("s_waitcnt lgkmcnt(" #n ")" ::: "memory")
#define PG8_BAR __builtin_amdgcn_s_barrier()
#define PG8_SCHED __builtin_amdgcn_sched_barrier(0)
    Unit cur, nxt; int ui = 0;
    if (!S.next(0, cur)) return;
    f32x4 acc[2][2][4][2];
#pragma unroll
    for (int a = 0; a < 2; ++a)
#pragma unroll
        for (int b = 0; b < 2; ++b)
#pragma unroll
            for (int m = 0; m < 4; ++m)
#pragma unroll
                for (int n = 0; n < 2; ++n) acc[a][b][m][n] = (f32x4){0.f, 0.f, 0.f, 0.f};
    bf16x8 At[4][2], B0[2][2], B1[2][2];
    const char* cA = (const char*)g.A + (size_t)cur.pm * tstep; const char* cB = (const char*)g.Bt + (size_t)cur.pn * tstep;
    S.a_ready(cur);
    if constexpr (SP2) {
        PG8_STAGE(PG8_SB(0, 0), cB, voffB); PG8_STAGE(PG8_SB(0, 1), cB + hstep, voffB); PG8_STAGE(PG8_SA(0, 0), cA, voffA); PG8_STAGE(PG8_SA(0, 1), cA + hstep, voffA);
        if (wr == 1) PG8_BAR;
        PG8_WAIT_V(2); PG8_BAR;
        PG8_STAGE(PG8_SB(1, 0), cB + kstep, voffB); PG8_STAGE(PG8_SA(1, 0), cA + kstep, voffA); PG8_STAGE(PG8_SB(1, 1), cB + hstep + kstep, voffB);
        PG8_WAIT_V(6); PG8_BAR;
    } else {
        PG8_STAGE(PG8_SB(0, 0), cB, voffB); PG8_STAGE(PG8_SA(0, 0), cA, voffA); PG8_STAGE(PG8_SB(0, 1), cB + hstep, voffB); PG8_STAGE(PG8_SA(0, 1), cA + hstep, voffA);
        if (wr == 1) PG8_BAR;
        PG8_WAIT_V(4); PG8_BAR;
        PG8_STAGE(PG8_SB(1, 0), cB + kstep, voffB); PG8_STAGE(PG8_SA(1, 0), cA + kstep, voffA); PG8_STAGE(PG8_SB(1, 1), cB + hstep + kstep, voffB);
        PG8_WAIT_V(6); PG8_BAR;
    }
    for (;;) {
        const bool has_next = S.next(ui + 1, nxt);
        const char* nA = has_next ? (const char*)g.A + (size_t)nxt.pm * tstep : cA; const char* nB = has_next ? (const char*)g.Bt + (size_t)nxt.pn * tstep : cB;
        for (int t = 0; t < nt; t += 2) {
            const bool last = (t == nt - 2);
            const char* a1 = cA + (size_t)(t + 1) * kstep;
            const char* a2 = last ? nA : cA + (size_t)(t + 2) * kstep; const char* b2 = last ? nB : cB + (size_t)(t + 2) * kstep;
            const char* a3 = a2 + kstep; const char* b3 = b2 + kstep;
            if (last && has_next) S.a_ready(nxt);
            if constexpr (SP2) {
            PG8_LDB(B0, 0, 0); PG8_LDB(B1, 0, 1); PG8_SCHED; PG8_LDA(At, 0, 0); PG8_STAGE(PG8_SA(1, 1), a1 + hstep, voffA);
            PG8_WAIT_V(8); PG8_WAIT_L(0); PG8_BAR; PG8_MMA(0, 0, At, B0); PG8_MMA(0, 1, At, B1); PG8_BAR; PG8_SCHED;
            PG8_LDA(At, 0, 1); PG8_STAGE(PG8_SB(0, 0), b2, voffB); PG8_STAGE(PG8_SB(0, 1), b2 + hstep, voffB); PG8_STAGE(PG8_SA(0, 0), a2, voffA);
            PG8_WAIT_V(8); PG8_WAIT_L(0); PG8_BAR; PG8_MMA(1, 0, At, B0); PG8_MMA(1, 1, At, B1); PG8_BAR; PG8_SCHED;
            PG8_LDB(B0, 1, 0); PG8_LDB(B1, 1, 1); PG8_SCHED; PG8_LDA(At, 1, 0); PG8_STAGE(PG8_SA(0, 1), a2 + hstep, voffA);
            PG8_WAIT_V(8); PG8_WAIT_L(0); PG8_BAR; PG8_MMA(0, 0, At, B0); PG8_MMA(0, 1, At, B1); PG8_BAR; PG8_SCHED;
            PG8_LDA(At, 1, 1); PG8_STAGE(PG8_SB(1, 0), b3, voffB); PG8_STAGE(PG8_SB(1, 1), b3 + hstep, voffB); PG8_STAGE(PG8_SA(1, 0), a3, voffA);
            PG8_WAIT_V(8); PG8_WAIT_L(0); PG8_BAR; PG8_MMA(1, 0, At, B0); PG8_MMA(1, 1, At, B1); PG8_BAR; PG8_SCHED;
            } else {
            PG8_LDB(B0, 0, 0); PG8_SCHED; PG8_LDA(At, 0, 0); PG8_STAGE(PG8_SA(1, 1), a1 + hstep, voffA);
            PG8_WAIT_L(8); PG8_BAR; PG8_WAIT_L(0); PG8_MMA(0, 0, At, B0); PG8_BAR; PG8_SCHED;
            PG8_LDB(B1, 0, 1); PG8_STAGE(PG8_SB(0, 0), b2, voffB);
            PG8_BAR; PG8_WAIT_L(0); PG8_MMA(0, 1, At, B1); PG8_BAR;
            PG8_LDA(At, 0, 1); PG8_STAGE(PG8_SA(0, 0), a2, voffA);
            PG8_BAR; PG8_WAIT_L(0); PG8_MMA(1, 0, At, B0); PG8_BAR; PG8_SCHED;
            PG8_STAGE(PG8_SB(0, 1), b2 + hstep, voffB);
            PG8_WAIT_V(6); PG8_BAR; PG8_MMA(1, 1, At, B1); PG8_BAR;
            PG8_LDB(B0, 1, 0); PG8_SCHED; PG8_LDA(At, 1, 0); PG8_STAGE(PG8_SA(0, 1), a2 + hstep, voffA);
            PG8_WAIT_L(8); PG8_BAR; PG8_WAIT_L(0); PG8_MMA(0, 0, At, B0); PG8_BAR; PG8_SCHED;
            PG8_LDB(B1, 1, 1); PG8_STAGE(PG8_SB(1, 0), b3, voffB);
            PG8_BAR; PG8_WAIT_L(0); PG8_MMA(0, 1, At, B1); PG8_BAR;
            PG8_LDA(At, 1, 1); PG8_STAGE(PG8_SA(1, 0), a3, voffA);
            PG8_BAR; PG8_WAIT_L(0); PG8_MMA(1, 0, At, B0); PG8_BAR; PG8_SCHED;
            PG8_STAGE(PG8_SB(1, 1), b3 + hstep, voffB);
            PG8_WAIT_V(6); PG8_BAR; PG8_MMA(1, 1, At, B1); PG8_BAR;
            }
        }
        if constexpr (ALIGN_EPI) { if (wr == 0) PG8_BAR; }
        if constexpr (!Epi::AFTER_DRAIN) { E(acc, cur, wr, wc, fr, fq); S.done(cur); }
        if (!has_next) break;
#pragma unroll
        for (int a = 0; a < 2; ++a)
#pragma unroll
            for (int b = 0; b < 2; ++b)
#pragma unroll
                for (int m = 0; m < 4; ++m)
#pragma unroll
                    for (int n = 0; n < 2; ++n) acc[a][b][m][n] = (f32x4){0.f, 0.f, 0.f, 0.f};
        cur = nxt; cA = nA; cB = nB; ++ui;
        if constexpr (ALIGN_EPI) { if (wr == 1) PG8_BAR; }
    }
    PG8_WAIT_V(0);
    if constexpr (!ALIGN_EPI) { if (wr == 0) PG8_BAR; }
    PG8_BAR;
    if constexpr (Epi::AFTER_DRAIN) { E.fused(acc, cur, wr, wc, fr, fq, lds, wid, lane); S.done(cur); }
#undef PG8_SA
#undef PG8_SB
#undef PG8_STAGE
#undef PG8_LDA
#undef PG8_LDB
#undef PG8_MMA
#undef PG8_WAIT_V
#undef PG8_WAIT_L
#undef PG8_BAR
#undef PG8_SCHED
}
}

constexpr bool PG8_SP2 = true, PG8_ALIGN = true;

#define GAS __attribute__((address_space(1)))
#define LAS __attribute__((address_space(3)))
#define XB_TMO      128
#define XB_XCNT(j)  (256  + 64 * (j))
#define XB_XSUB(j)  (1280 + 64 * (j))
#define XB_XGEN(j)  (2304 + 64 * (j))
#define XB_TOP      3328
#define XB_TOPGEN   3392
#define XCD_BAR_WORDS 3456
#define XB_SPIN_CAP (1u << 22)
__device__ __forceinline__ unsigned xb_ld(unsigned* p)              { return __hip_atomic_load(p, __ATOMIC_RELAXED, __HIP_MEMORY_SCOPE_AGENT); }
__device__ __forceinline__ unsigned xb_add(unsigned* p, unsigned v) { return __hip_atomic_fetch_add(p, v, __ATOMIC_RELAXED, __HIP_MEMORY_SCOPE_AGENT); }
__device__ __forceinline__ unsigned xb_xcc_id() { return (unsigned)__builtin_amdgcn_s_getreg((3 << 11) | 20) & 0xFu; }
#define XB_SPIN(cond, bar) do { unsigned _sp = 0; while (cond) { __builtin_amdgcn_s_sleep(1); \
    if ((++_sp & 255u) == 0u) { if (xb_ld(&(bar)[XB_TMO])) break; if (_sp > XB_SPIN_CAP) { atomicAdd(&(bar)[XB_TMO], 1u); break; } } } } while (0)
struct XcdBarrier { unsigned* bar; unsigned x; volatile LAS unsigned* st; };
__device__ __forceinline__ XcdBarrier xcd_barrier_post(unsigned* bar, volatile LAS unsigned* st) {
    XcdBarrier b; b.bar = bar; b.x = xb_xcc_id(); b.st = st;
    if (threadIdx.x == 0) (void)xb_add(&bar[XB_XCNT(b.x)], 1u);
    return b;
}
__device__ __forceinline__ void xcd_barrier_complete(unsigned* bar, unsigned x, unsigned& nloc, unsigned& nx) {
    const unsigned G = gridDim.x * gridDim.y * gridDim.z;
    unsigned sum, cnt, mine, sp = 0u;
    for (;;) {
        sum = 0u; cnt = 0u; mine = 0u;
#pragma unroll
        for (unsigned j = 0; j < 16; ++j) { const unsigned c = xb_ld(&bar[XB_XCNT(j)]); sum += c; cnt += (c > 0u) ? 1u : 0u; mine = (j == x) ? c : mine; }
        if (sum == G) break;
        __builtin_amdgcn_s_sleep(1);
        if ((++sp & 255u) == 0u) { if (xb_ld(&bar[XB_TMO])) break; if (sp > XB_SPIN_CAP) { atomicAdd(&bar[XB_TMO], 1u); break; } }
    }
    nloc = mine > 0u ? mine : 1u; nx = cnt > 0u ? cnt : 1u;
}
__device__ __forceinline__ void xcd_barrier(const XcdBarrier& b) {
    asm volatile("s_waitcnt vmcnt(0)" ::: "memory");
    __syncthreads();
    if (threadIdx.x == 0) {
        unsigned* bar = b.bar;
        __builtin_amdgcn_s_waitcnt(0);
        unsigned nloc = b.st[0], nx = b.st[1];
        if (nloc == 0u) { xcd_barrier_complete(bar, b.x, nloc, nx); b.st[0] = nloc; b.st[1] = nx; }
        const unsigned old = xb_add(&bar[XB_XSUB(b.x)], 1u);
        const unsigned gen = old / nloc;
        if (old + 1u == (gen + 1u) * nloc) {
            __builtin_amdgcn_fence(__ATOMIC_RELEASE, "agent");
            asm volatile("s_waitcnt vmcnt(0)" ::: "memory");
            const unsigned og = xb_add(&bar[XB_TOP], 1u);
            const unsigned tg = og / nx;
            if (og + 1u == (tg + 1u) * nx) xb_add(&bar[XB_TOPGEN], 1u);
            else XB_SPIN(xb_ld(&bar[XB_TOPGEN]) == tg, bar);
            __builtin_amdgcn_fence(__ATOMIC_ACQUIRE, "agent");
            xb_add(&bar[XB_XGEN(b.x)], 1u);
            asm volatile("s_waitcnt vmcnt(0)" ::: "memory");
        } else {
            XB_SPIN(xb_ld(&bar[XB_XGEN(b.x)]) == gen, bar);
            __builtin_amdgcn_fence(__ATOMIC_ACQUIRE, "agent");
            asm volatile("s_waitcnt vmcnt(0)" ::: "memory");
        }
    }
    __syncthreads();
}
__device__ __forceinline__ float wave_sum(float v) {
#pragma unroll
    for (int o = 1; o < 64; o <<= 1) v += __shfl_xor(v, o);
    return v;
}

__device__ void nv_rms(const float* in, int ldin, const float* g, int ncols, int nrows, const float* base, int ldbase, float alpha, float* out, int ldout, int bid, int nblk) {
    const int lane = threadIdx.x & 63, wave = threadIdx.x >> 6, nw = blockDim.x >> 6;
    for (int r = bid * nw + wave; r < nrows; r += nblk * nw) {
        const float* ir = in + (size_t)r * ldin;
        float s = 0.f;
        for (int c = lane * 4; c < ncols; c += 256) { const float4 v = *(const float4*)(ir + c); s += v.x * v.x + v.y * v.y + v.z * v.z + v.w * v.w; }
        s = wave_sum(s);
        const float rs = 1.0f / sqrtf(s / (float)ncols + RMS_EPS);
        for (int c = lane * 4; c < ncols; c += 256) {
            const float4 v = *(const float4*)(ir + c); const float4 gg = *(const float4*)(g + c);
            float4 b = make_float4(0.f, 0.f, 0.f, 0.f); if (base) b = *(const float4*)(base + (size_t)r * ldbase + c);
            float4 o; o.x = b.x + alpha * (v.x * rs * gg.x); o.y = b.y + alpha * (v.y * rs * gg.y); o.z = b.z + alpha * (v.z * rs * gg.z); o.w = b.w + alpha * (v.w * rs * gg.w);
            *(float4*)(out + (size_t)r * ldout + c) = o;
        }
    }
}

template <int MODE>
__device__ void nv_gemm(const float* A, int lda, const float* B, const float* B2, int ldb, float* C, int ldc, int M, int N, int K, const float* bias, float* smem, int bid, int nblk) {
    float* As = smem;
    float* Bs = smem + 16 * 132;
    float* B2s = Bs + 16 * 64;
    const int t = threadIdx.x, ty = t >> 4, tx = t & 15;
    const int ntm = M / 128, ntn = N / 64;
    for (int tile = bid; tile < ntm * ntn; tile += nblk) {
        const int tm = tile / ntn, tn = tile % ntn, m0 = tm * 128, n0 = tn * 64;
        float acc[4][4], acc2[4][4];
#pragma unroll
        for (int i = 0; i < 4; ++i)
#pragma unroll
            for (int j = 0; j < 4; ++j) { acc[i][j] = 0.f; acc2[i][j] = 0.f; }
        for (int k0 = 0; k0 < K; k0 += 16) {
            {
                const int r = t >> 2, kc = (t & 3) * 4;
                const float4 v = *(const float4*)(A + (size_t)(m0 + r) * lda + k0 + kc);
                As[(kc + 0) * 132 + r] = v.x; As[(kc + 1) * 132 + r] = v.y; As[(kc + 2) * 132 + r] = v.z; As[(kc + 3) * 132 + r] = v.w;
            }
            {
                const int kr = t >> 5, c2 = (t & 31) * 2;
                const float2 v = *(const float2*)(B + (size_t)(k0 + kr) * ldb + n0 + c2);
                Bs[kr * 64 + c2] = v.x; Bs[kr * 64 + c2 + 1] = v.y;
                if (MODE == 1) { const float2 w = *(const float2*)(B2 + (size_t)(k0 + kr) * ldb + n0 + c2); B2s[kr * 64 + c2] = w.x; B2s[kr * 64 + c2 + 1] = w.y; }
            }
            __syncthreads();
#pragma unroll
            for (int kk = 0; kk < 16; ++kk) {
                const float4 a = *(const float4*)(As + kk * 132 + ty * 4);
                const float4 b = *(const float4*)(Bs + kk * 64 + tx * 4);
                const float av[4] = {a.x, a.y, a.z, a.w}, bv[4] = {b.x, b.y, b.z, b.w};
#pragma unroll
                for (int i = 0; i < 4; ++i)
#pragma unroll
                    for (int j = 0; j < 4; ++j) acc[i][j] += av[i] * bv[j];
                if (MODE == 1) {
                    const float4 b2 = *(const float4*)(B2s + kk * 64 + tx * 4);
                    const float b2v[4] = {b2.x, b2.y, b2.z, b2.w};
#pragma unroll
                    for (int i = 0; i < 4; ++i)
#pragma unroll
                        for (int j = 0; j < 4; ++j) acc2[i][j] += av[i] * b2v[j];
                }
            }
            __syncthreads();
        }
#pragma unroll
        for (int i = 0; i < 4; ++i) {
            const int r = m0 + ty * 4 + i, c = n0 + tx * 4;
            float o[4];
#pragma unroll
            for (int j = 0; j < 4; ++j) {
                float v = acc[i][j];
                if (MODE == 1) { const float sg = 1.0f / (1.0f + expf(-v)); v = v * sg * acc2[i][j]; }
                if (MODE == 2) { const float zz = v + bias[c + j]; const float sg = 1.0f / (1.0f + expf(-zz)); v = A[(size_t)r * lda + c + j] * sg; }
                o[j] = v;
            }
            *(float4*)(C + (size_t)r * ldc + c) = make_float4(o[0], o[1], o[2], o[3]);
        }
    }
}

__device__ void nv_kmean(const float* k, int ldk, float* kmean, int bid, int nblk) {
    for (int idx = bid * blockDim.x + threadIdx.x; idx < BATCH * NBLK * D_ATTN; idx += nblk * blockDim.x) {
        const int c = idx % D_ATTN, bn = idx / D_ATTN;
        const float* p = k + (size_t)bn * MOBA_L * ldk + c;
        float s = 0.f;
        for (int r = 0; r < MOBA_L; ++r) s += p[(size_t)r * ldk];
        kmean[idx] = s * (1.0f / MOBA_L);
    }
}

__device__ void nv_attn(const float* q, const float* k, const float* v, int ld, const float* kmean, float* out, int ldo, int bid, int nblk) {
    const int lane = threadIdx.x & 63, wave = threadIdx.x >> 6, nw = blockDim.x >> 6;
    const int nwu = BATCH * NH * (SEQ / 64);
    for (int wu = bid * nw + wave; wu < nwu; wu += nblk * nw) {
        const int wuu = __builtin_amdgcn_readfirstlane(wu);
        const int tc = wuu % (SEQ / 64), bh = wuu / (SEQ / 64), h = bh % NH, b = bh / NH;
        const int t = tc * 64 + lane, qb = (tc * 64) / MOBA_L;
        const float slope = exp2f(-(float)(h + 1));
        float qv[HD];
        const float* qp = q + (size_t)(b * SEQ + t) * ld + h * HD;
#pragma unroll
        for (int d = 0; d < HD; d += 4) { const float4 x = *(const float4*)(qp + d); qv[d] = x.x; qv[d + 1] = x.y; qv[d + 2] = x.z; qv[d + 3] = x.w; }
        float gate[NBLK];
#pragma unroll
        for (int n = 0; n < NBLK; ++n) {
            gate[n] = -1e30f;
            if (n < qb) { const float* km = kmean + (size_t)(b * NBLK + n) * D_ATTN + h * HD; float s = 0.f;
#pragma unroll
                for (int d = 0; d < HD; ++d) s += qv[d] * km[d];
                gate[n] = s; }
        }
        unsigned selmask = 0u;
#pragma unroll
        for (int n = 0; n < NBLK; ++n) {
            int rank = 0;
#pragma unroll
            for (int m2 = 0; m2 < NBLK; ++m2) { if (m2 < qb && (gate[m2] > gate[n] || (gate[m2] == gate[n] && m2 < n))) ++rank; }
            if (n < qb && rank < 3) selmask |= (1u << n);
        }
        float mrun = -INFINITY, lrun = 0.f, o[HD];
#pragma unroll
        for (int d = 0; d < HD; ++d) o[d] = 0.f;
        for (int n = 0; n <= qb; ++n) {
            const bool sel = (n == qb) || ((selmask >> n) & 1u);
            if (!__any(sel)) continue;
            for (int j = 0; j < MOBA_L; ++j) {
                const int kp = n * MOBA_L + j;
                const float* kr = k + (size_t)(b * SEQ + kp) * ld + h * HD;
                const float* vr = v + (size_t)(b * SEQ + kp) * ld + h * HD;
                float s = 0.f;
#pragma unroll
                for (int d = 0; d < HD; ++d) s += qv[d] * kr[d];
                s = s * 0.125f - slope * (float)(t - kp);
                const bool valid = sel && (kp <= t);
                if (valid) {
                    const float mn = fmaxf(mrun, s), corr = expf(mrun - mn), p = expf(s - mn);
                    lrun = lrun * corr + p;
#pragma unroll
                    for (int d = 0; d < HD; ++d) o[d] = o[d] * corr + p * vr[d];
                    mrun = mn;
                }
            }
        }
        const float inv = 1.0f / lrun;
        float* op = out + (size_t)(b * SEQ + t) * ldo + h * HD;
#pragma unroll
        for (int d = 0; d < HD; d += 4) *(float4*)(op + d) = make_float4(o[d] * inv, o[d + 1] * inv, o[d + 2] * inv, o[d + 3] * inv);
    }
}

__device__ __forceinline__ float gelu_tanh(float x) { const float u = 0.7978845608028654f * (x + 0.044715f * x * x * x); return 0.5f * x * (1.0f + tanhf(u)); }

__device__ void nv_ssm(const float* us, int ldu, const float* lam_re, const float* lam_im, const float* log_dt, const float* b_re, const float* b_im,
                       const float* c_re, const float* c_im, const float* d_skip, float* yout, int ldy, int bid, int nblk) {
    const int lane = threadIdx.x & 63, wave = threadIdx.x >> 6, nw = blockDim.x >> 6;
    for (int wu = bid * nw + wave; wu < BATCH * NG; wu += nblk * nw) {
        const int wuu = __builtin_amdgcn_readfirstlane(wu);
        const int g = wuu % NG, b = wuu / NG, p = lane;
        const double lr = (double)lam_re[g * SSM_P + p], li = (double)lam_im[g * SSM_P + p], dt = exp((double)log_dt[g]);
        const double mag = exp(lr * dt), ang = li * dt, are = mag * cos(ang), aim = mag * sin(ang), den = lr * lr + li * li;
        const double fre = ((are - 1.0) * lr + aim * li) / den, fim = (aim * lr - (are - 1.0) * li) / den;
        const float a_re = (float)are, a_im = (float)aim;
        float bbr[SSM_GROUP], bbi[SSM_GROUP], cr[SSM_GROUP], ci[SSM_GROUP];
#pragma unroll
        for (int h = 0; h < SSM_GROUP; ++h) {
            const double br = (double)b_re[(g * SSM_P + p) * SSM_GROUP + h], bi = (double)b_im[(g * SSM_P + p) * SSM_GROUP + h];
            bbr[h] = (float)(fre * br - fim * bi); bbi[h] = (float)(fre * bi + fim * br);
            cr[h] = c_re[(g * SSM_GROUP + h) * SSM_P + p]; ci[h] = c_im[(g * SSM_GROUP + h) * SSM_P + p];
        }
        const float dsk = (lane < SSM_GROUP) ? d_skip[g * SSM_GROUP + lane] : 0.f;
        float hre = 0.f, him = 0.f;
        for (int t = 0; t < SEQ; ++t) {
            const float* up = us + (size_t)(b * SEQ + t) * ldu + g * SSM_GROUP;
            float xr = 0.f, xi = 0.f, uu[SSM_GROUP];
#pragma unroll
            for (int h = 0; h < SSM_GROUP; ++h) { uu[h] = up[h]; xr += uu[h] * bbr[h]; xi += uu[h] * bbi[h]; }
            const float nre = a_re * hre - a_im * him + xr, nim = a_re * him + a_im * hre + xi;
            hre = nre; him = nim;
            float mine = 0.f, myu = 0.f;
#pragma unroll
            for (int h = 0; h < SSM_GROUP; ++h) { const float tot = wave_sum(hre * cr[h] - him * ci[h]); if (lane == h) { mine = tot; myu = uu[h]; } }
            if (lane < SSM_GROUP) { const float y = mine + dsk * myu; yout[(size_t)(b * SEQ + t) * ldy + g * SSM_GROUP + lane] = gelu_tanh(y); }
        }
    }
}


constexpr size_t MiB = 1048576;
constexpr size_t WS_WUP = 0, WS_WDN = 12 * MiB;
constexpr size_t WS_XNB = 18 * MiB, WS_HACT = 50 * MiB, WS_F = 138 * MiB;
constexpr size_t WS_A = 18 * MiB, WS_B = 82 * MiB;
constexpr size_t WS_PROJ = WS_B, WS_ATTN = 210 * MiB, WS_KMEAN = 242 * MiB;
constexpr size_t WS_CTL = 255 * MiB, CTL_BYTES = 65536;
constexpr int LDS_BYTES = 147456, MISC_OFF = 131072 + 320;
typedef unsigned short bf16;
__device__ __forceinline__ unsigned f2bf(float f) { unsigned u = __builtin_bit_cast(unsigned, f); return (u + 0x7fffu + ((u >> 16) & 1u)) >> 16; }
__device__ __forceinline__ unsigned pk2(float lo, float hi) { return f2bf(lo) | (f2bf(hi) << 16); }

__device__ __forceinline__ void p0_transpose_item(const float* W, int K, int N, bf16* WT, int mode, LAS float* scr, int item, int lane) {
    const int nblk = N / 32, kb = item / nblk, nb = item % nblk, k0 = 64 * kb, n0 = 32 * nb;
    const int r0 = (mode == 0) ? n0 : (256 * (n0 / 128) + (n0 % 128) + (mode == 2 ? 128 : 0));
#pragma unroll 8
    for (int i = 0; i < 32; ++i) { const int kk = 2 * i + (lane >> 5); scr[kk * 33 + (lane & 31)] = W[(size_t)(k0 + kk) * N + n0 + (lane & 31)]; }
    asm volatile("s_waitcnt lgkmcnt(0)" ::: "memory");
    const int c = lane & 7;
#pragma unroll
    for (int j = 0; j < 4; ++j) { const int n = (lane >> 3) + 8 * j; const LAS float* s = scr + (8 * c) * 33 + n;
        uint4 o; o.x = pk2(s[0 * 33], s[1 * 33]); o.y = pk2(s[2 * 33], s[3 * 33]); o.z = pk2(s[4 * 33], s[5 * 33]); o.w = pk2(s[6 * 33], s[7 * 33]);
        *(uint4*)(WT + (size_t)(r0 + n) * K + k0 + 8 * c) = o; }
    asm volatile("s_waitcnt lgkmcnt(0)" ::: "memory");
}
__device__ __forceinline__ void conv_ffn_weights(const float* wg, const float* wu, const float* wd, bf16* WUP, bf16* WDN, LAS unsigned char* lds, int bid, int nblk) {
    const int lane = threadIdx.x & 63, wave = threadIdx.x >> 6;
    LAS float* scr = (LAS float*)(lds + wave * 16384);
    const int gw = bid * NWAVES + wave, NGW = nblk * NWAVES;
    constexpr int I_G = (D_MODEL / 64) * (D_FF / 32), I_D = (D_FF / 64) * (D_MODEL / 32);
    for (int it = gw; it < 2 * I_G + I_D; it += NGW) {
        int r = it;
        if (r < I_G) { p0_transpose_item(wg, D_MODEL, D_FF, WUP, 1, scr, r, lane); continue; } r -= I_G;
        if (r < I_G) { p0_transpose_item(wu, D_MODEL, D_FF, WUP, 2, scr, r, lane); continue; } r -= I_G;
        p0_transpose_item(wd, D_FF, D_MODEL, WDN, 0, scr, r, lane);
    }
}
__device__ __forceinline__ void rms_rows_bf16(const float* in, const float* g, bf16* out, int bid, int nblk) {
    const int lane = threadIdx.x & 63, wave = threadIdx.x >> 6;
    for (int r = bid * NWAVES + wave; r < MTOK; r += nblk * NWAVES) {
        const float4* ir = (const float4*)(in + (size_t)r * D_MODEL) + lane;
        float4 v[4]; float s = 0.f;
#pragma unroll
        for (int j = 0; j < 4; ++j) { v[j] = ir[64 * j]; s += v[j].x * v[j].x + v[j].y * v[j].y + v[j].z * v[j].z + v[j].w * v[j].w; }
        s = wave_sum(s);
        const float rs = 1.0f / sqrtf(s * (1.0f / D_MODEL) + RMS_EPS);
        uint2* o8 = (uint2*)(out + (size_t)r * D_MODEL) + lane;
#pragma unroll
        for (int j = 0; j < 4; ++j) { const float4 gg = ((const float4*)g)[lane + 64 * j];
            uint2 o; o.x = pk2(v[j].x * rs * gg.x, v[j].y * rs * gg.y); o.y = pk2(v[j].z * rs * gg.z, v[j].w * rs * gg.w); o8[64 * j] = o; }
    }
}

__global__ void __launch_bounds__(NTHR, 2) k_mega(Args a) {
    extern __shared__ __attribute__((aligned(16))) unsigned char lds[];
    float* smem = (float*)lds;
    LAS unsigned char* ldsl = (LAS unsigned char*)lds;
    const int bid = blockIdx.x, nblk = gridDim.x;
    volatile LAS unsigned* MISC = (volatile LAS unsigned*)(ldsl + MISC_OFF);
    if (threadIdx.x < 32) MISC[threadIdx.x] = 0u;
    __syncthreads();
    XcdBarrier bar = xcd_barrier_post((unsigned*)(a.ws + WS_CTL), MISC + 8);
    float* RA = (float*)(a.ws + WS_A);
    float* PROJ = (float*)(a.ws + WS_PROJ); float* ATT = (float*)(a.ws + WS_ATTN); float* KMEAN = (float*)(a.ws + WS_KMEAN);
    bf16* WUP = (bf16*)(a.ws + WS_WUP); bf16* WDN = (bf16*)(a.ws + WS_WDN); bf16* XNB = (bf16*)(a.ws + WS_XNB); bf16* HACT = (bf16*)(a.ws + WS_HACT); float* FB = (float*)(a.ws + WS_F);
    float* H = a.out;
    const float* x = a.in[I_X];
    conv_ffn_weights(a.in[I_F1WG], a.in[I_F1WU], a.in[I_F1WD], WUP, WDN, ldsl, bid, nblk); rms_rows_bf16(x, a.in[I_F1PRE], XNB, bid, nblk);
    xcd_barrier(bar);
    { pg8::Gemm g{XNB, WUP, MTOK, 2 * D_FF, D_MODEL}; pg8::StaticOrder S; S.init(MTOK, 2 * D_FF, nblk, bid); pg8::EpiSwiGLU E{HACT, D_FF};
               pg8::gemm_phase<pg8::EpiSwiGLU, pg8::StaticOrder, PG8_ALIGN, PG8_SP2>(ldsl, g, S, E); }
    xcd_barrier(bar);
    { pg8::Gemm g{HACT, WDN, MTOK, D_MODEL, D_FF}; pg8::StaticOrder S; S.init(MTOK, D_MODEL, nblk, bid); pg8::EpiF32 E{FB, D_MODEL};
               pg8::gemm_phase<pg8::EpiF32, pg8::StaticOrder, PG8_ALIGN, PG8_SP2>(ldsl, g, S, E); }
    xcd_barrier(bar);
    nv_rms(FB, 1024, a.in[I_F1POST], 1024, MTOK, x, 1024, 0.5f, H, 1024, bid, nblk);
    xcd_barrier(bar);
    nv_rms(H, 1024, a.in[I_MIXPRE], 1024, MTOK, nullptr, 0, 1.f, RA, 1024, bid, nblk);
    xcd_barrier(bar);
    nv_gemm<0>(RA, 1024, a.in[I_WIN], nullptr, D_IN, PROJ, D_IN, MTOK, D_IN, 1024, nullptr, smem, bid, nblk);
    xcd_barrier(bar);
    nv_kmean(PROJ + 512, D_IN, KMEAN, bid, nblk);
    xcd_barrier(bar);
    nv_attn(PROJ, PROJ + 512, PROJ + 1024, D_IN, KMEAN, ATT, 512, bid, nblk);
    xcd_barrier(bar);
    nv_ssm(PROJ + 1536, D_IN, a.in[I_LAMRE], a.in[I_LAMIM], a.in[I_LOGDT], a.in[I_BRE], a.in[I_BIM], a.in[I_CRE], a.in[I_CIM], a.in[I_DSKIP],
                    PROJ  , D_IN, bid, nblk);
    xcd_barrier(bar);
    nv_gemm<2>(PROJ, D_IN, a.in[I_WGLU], nullptr, 512, PROJ + 512, D_IN, MTOK, 512, 512, a.in[I_BGLU], smem, bid, nblk);
    xcd_barrier(bar);
    nv_rms(ATT, 512, a.in[I_ATTNG], 512, MTOK, nullptr, 0, 1.f, RA, 1024, bid, nblk);
    xcd_barrier(bar);
    nv_rms(PROJ + 512, D_IN, a.in[I_SSMG], 512, MTOK, nullptr, 0, 1.f, RA + 512, 1024, bid, nblk);
    xcd_barrier(bar);
    nv_gemm<0>(RA, 1024, a.in[I_WOUT], nullptr, 1024, PROJ, 1024, MTOK, 1024, 1024, nullptr, smem, bid, nblk);
    xcd_barrier(bar);
    nv_rms(PROJ, 1024, a.in[I_MIXPOST], 1024, MTOK, H, 1024, 1.0f, H, 1024, bid, nblk);
    xcd_barrier(bar);
    conv_ffn_weights(a.in[I_F2WG], a.in[I_F2WU], a.in[I_F2WD], WUP, WDN, ldsl, bid, nblk); rms_rows_bf16(H, a.in[I_F2PRE], XNB, bid, nblk);
    xcd_barrier(bar);
    { pg8::Gemm g{XNB, WUP, MTOK, 2 * D_FF, D_MODEL}; pg8::StaticOrder S; S.init(MTOK, 2 * D_FF, nblk, bid); pg8::EpiSwiGLU E{HACT, D_FF};
               pg8::gemm_phase<pg8::EpiSwiGLU, pg8::StaticOrder, PG8_ALIGN, PG8_SP2>(ldsl, g, S, E); }
    xcd_barrier(bar);
    { pg8::Gemm g{HACT, WDN, MTOK, D_MODEL, D_FF}; pg8::StaticOrder S; S.init(MTOK, D_MODEL, nblk, bid); pg8::EpiF32 E{FB, D_MODEL};
               pg8::gemm_phase<pg8::EpiF32, pg8::StaticOrder, PG8_ALIGN, PG8_SP2>(ldsl, g, S, E); }
    xcd_barrier(bar);
    nv_rms(FB, 1024, a.in[I_F2POST], 1024, MTOK, H, 1024, 0.5f, H, 1024, bid, nblk);
}

extern "C" void kernel_launch(void* const* d_in, const int* in_sizes, int n_in, void* d_out, int out_size, void* d_ws, size_t ws_size, hipStream_t stream) {
    static int grid = 0;
    if (grid == 0) {
        if (n_in != 27 || out_size != MTOK * D_MODEL || ws_size < 256u * 1048576u) { fprintf(stderr, "kernel_launch: unexpected shapes n_in %d out %d ws %zu\n", n_in, out_size, ws_size); grid = -1; return; }
        int dev = 0, cus = 0, per_cu = 0;
        if (hipGetDevice(&dev) != hipSuccess || hipDeviceGetAttribute(&cus, hipDeviceAttributeMultiprocessorCount, dev) != hipSuccess) { grid = -1; return; }
        if (hipFuncSetAttribute((const void*)k_mega, hipFuncAttributeMaxDynamicSharedMemorySize, LDS_BYTES) != hipSuccess) { fprintf(stderr, "hipFuncSetAttribute failed\n"); grid = -1; return; }
        if (hipOccupancyMaxActiveBlocksPerMultiprocessor(&per_cu, (const void*)k_mega, NTHR, LDS_BYTES) != hipSuccess || per_cu < 1) { fprintf(stderr, "occupancy query: %d blocks per CU\n", per_cu); grid = -1; (void)hipGetLastError(); return; }
        grid = cus;
    }
    if (grid < 0) return;
    if (hipMemsetAsync((char*)d_ws + WS_CTL, 0, CTL_BYTES, stream) != hipSuccess) return;
    Args a{};
    for (int i = 0; i < 27; ++i) a.in[i] = (const float*)d_in[i];
    a.out = (float*)d_out; a.ws = (unsigned char*)d_ws;
    hipLaunchKernelGGL(k_mega, dim3(grid), dim3(NTHR), LDS_BYTES, stream, a);
}
```

```cpp
#include <hip/hip_runtime.h>
#include <cstdint>
#include <cstdio>

constexpr int D_MODEL = 1024, BATCH = 8, SEQ = 2048, MTOK = BATCH * SEQ;
constexpr int NH = 8, HD = 64, D_ATTN = 512, MOBA_L = 256, NBLK = SEQ / MOBA_L;
constexpr int SSM_GROUP = 16, D_SSM = 512, NG = 32, SSM_P = 64;
constexpr int D_IN = 2048, D_FF = 2816;
constexpr float RMS_EPS = 1e-6f;
constexpr int NTHR = 512, NWAVES = 8;

struct Args {
    const float* in[27];
    float* out;
    unsigned char* ws;
    int stage, pad;
};
enum { I_X = 0, I_F1PRE, I_F1WG, I_F1WU, I_F1WD, I_F1POST, I_MIXPRE, I_WIN, I_LAMRE, I_LAMIM, I_LOGDT, I_BRE, I_BIM, I_CRE, I_CIM, I_DSKIP,
       I_WGLU, I_BGLU, I_ATTNG, I_SSMG, I_WOUT, I_MIXPOST, I_F2PRE, I_F2WG, I_F2WU, I_F2WD, I_F2POST };

namespace pg8 {
#define PG8_LAS __attribute__((address_space(3)))
typedef unsigned short bf16_t;
typedef short bf16x8 __attribute__((ext_vector_type(8)));
typedef float f32x4 __attribute__((ext_vector_type(4)));
typedef unsigned u32x4 __attribute__((ext_vector_type(4)));
constexpr int BM = 256, BK = 64, HALF = 128, HTB = HALF * BK * 2  , STAGE_BYTES = 8 * HTB, NXCD = 8, WGM = 8;

__host__ __device__ __forceinline__ int lds_byte(int r, int c) { const int st = (r >> 4) * 2 + (c >> 5), rr = r & 15, cc = c & 31, ob = rr * 64 + cc * 2; return st * 1024 + (ob ^ (((ob >> 9) & 1) << 5)); }
__host__ __device__ __forceinline__ void stage_rc(int b, int& R, int& C) { const int st = b / 1024, sb = b % 1024, swz = sb ^ (((sb >> 9) & 1) << 5); R = (st >> 1) * 16 + swz / 64; C = (st & 1) * 32 + (swz % 64) / 2; }
__host__ __device__ __forceinline__ int perm32(int rho) { const int n = rho >> 4, i = rho & 15; return 8 * (i >> 2) + 4 * n + (i & 3); }

struct Unit { int pm, pn; };
struct Gemm { const bf16_t* A; const bf16_t* Bt; int M, N, K; };

struct StaticOrder {
    int nM, nN, nwg, G, c;
    __host__ __device__ void init(int M, int N, int G_, int c_) { nM = M / BM; nN = N / BM; nwg = nM * nN; G = G_; c = c_; }
    __host__ __device__ bool next(int i, Unit& u) const {
        const long L = (long)i * G + c; if (L >= nwg) return false;
        int wgid = (int)L; { const int q = nwg / NXCD, r = nwg % NXCD, xcd = wgid % NXCD, off = wgid / NXCD; wgid = (xcd < r ? xcd * (q + 1) : r * (q + 1) + (xcd - r) * q) + off; }
        const int nig = WGM * nN, gid = wgid / nig, fm = gid * WGM, gsz = (nM - fm) < WGM ? (nM - fm) : WGM;
        u.pm = fm + ((wgid % nig) % gsz); u.pn = (wgid % nig) / gsz; return true;
    }
    __device__ __forceinline__ void a_ready(const Unit&) const {}
    __device__ __forceinline__ void done(const Unit&) const {}
};

__device__ __forceinline__ unsigned cvt_pk_bf16(float lo, float hi) { unsigned r; asm volatile("v_cvt_pk_bf16_f32 %0, %1, %2" : "=v"(r) : "v"(lo), "v"(hi)); return r; }

struct EpiF32 {
    static constexpr bool PERM = false, AFTER_DRAIN = false;
    float* C; int ldc;
    __device__ __forceinline__ void operator()(const f32x4 (&acc)[2][2][4][2], const Unit& u, int wr, int wc, int fr, int fq) const {
        const int row0 = u.pm * BM + wr * 64 + fr, col0 = u.pn * BM + wc * 32 + 4 * fq;
#pragma unroll
        for (int ai = 0; ai < 2; ++ai)
#pragma unroll
            for (int m = 0; m < 4; ++m) { float* rowp = C + (size_t)(row0 + ai * HALF + m * 16) * ldc + col0;
#pragma unroll
                for (int bj = 0; bj < 2; ++bj)
#pragma unroll
                    for (int n = 0; n < 2; ++n) *(f32x4*)(rowp + bj * HALF + n * 16) = acc[ai][bj][m][n]; }
    }
};
struct EpiSwiGLU {
    static constexpr bool PERM = true, AFTER_DRAIN = false;
    bf16_t* O; int ldc;
    __device__ __forceinline__ void operator()(const f32x4 (&acc)[2][2][4][2], const Unit& u, int wr, int wc, int fr, int fq) const {
        const int row0 = u.pm * BM + wr * 64 + fr, col0 = u.pn * HALF + wc * 32 + 8 * fq;
#pragma unroll
        for (int ai = 0; ai < 2; ++ai)
#pragma unroll
            for (int m = 0; m < 4; ++m) { bf16_t* rowp = O + (size_t)(row0 + ai * HALF + m * 16) * ldc + col0;
                float o[8];
#pragma unroll
                for (int n = 0; n < 2; ++n)
#pragma unroll
                    for (int e = 0; e < 4; ++e) { const float g = acc[ai][0][m][n][e], up = acc[ai][1][m][n][e];
                        const float sg = __builtin_amdgcn_rcpf(1.0f + __builtin_amdgcn_exp2f(-1.4426950408889634f * g)); o[n * 4 + e] = g * sg * up; }
                u32x4 w; w.x = cvt_pk_bf16(o[0], o[1]); w.y = cvt_pk_bf16(o[2], o[3]); w.z = cvt_pk_bf16(o[4], o[5]); w.w = cvt_pk_bf16(o[6], o[7]);
                *(u32x4*)rowp = w; }
    }
};


struct EpiBf16Split {
    static constexpr bool PERM = true, AFTER_DRAIN = false;
    bf16_t* O; size_t split_stride;
    __device__ __forceinline__ void operator()(const f32x4 (&acc)[2][2][4][2], const Unit& u, int wr, int wc, int fr, int fq) const {
        const int row0 = u.pm * BM + wr * 64 + fr; const int t = (u.pn * BM) / 512; const int colt = u.pn * BM - t * 512;
        bf16_t* base = O + (size_t)t * split_stride; const int col0 = colt + wc * 32 + 8 * fq;
#pragma unroll
        for (int ai = 0; ai < 2; ++ai)
#pragma unroll
            for (int m = 0; m < 4; ++m) { bf16_t* rowp = base + (size_t)(row0 + ai * HALF + m * 16) * 512 + col0;
#pragma unroll
                for (int bj = 0; bj < 2; ++bj) { const f32x4 v0 = acc[ai][bj][m][0], v1 = acc[ai][bj][m][1];
                    u32x4 w; w.x = cvt_pk_bf16(v0[0], v0[1]); w.y = cvt_pk_bf16(v0[2], v0[3]); w.z = cvt_pk_bf16(v1[0], v1[1]); w.w = cvt_pk_bf16(v1[2], v1[3]);
                    *(u32x4*)(rowp + bj * HALF) = w; } }
    }
};
struct EpiGLU {
    static constexpr bool PERM = true, AFTER_DRAIN = false;
    const bf16_t* Y; bf16_t* Z; const float* bias;
    __device__ __forceinline__ void operator()(const f32x4 (&acc)[2][2][4][2], const Unit& u, int wr, int wc, int fr, int fq) const {
        const int row0 = u.pm * BM + wr * 64 + fr, col0 = u.pn * BM + wc * 32 + 8 * fq;
#pragma unroll
        for (int ai = 0; ai < 2; ++ai)
#pragma unroll
            for (int m = 0; m < 4; ++m) { const size_t ro = (size_t)(row0 + ai * HALF + m * 16) * 512 + col0;
#pragma unroll
                for (int bj = 0; bj < 2; ++bj) { const u32x4 yw = *(const u32x4*)(Y + ro + bj * HALF);
                    const f32x4 b0 = *(const f32x4*)(bias + col0 + bj * HALF), b1 = *(const f32x4*)(bias + col0 + bj * HALF + 4);
                    float o[8];
#pragma unroll
                    for (int e = 0; e < 8; ++e) { const float a = (e < 4 ? acc[ai][bj][m][0][e & 3] : acc[ai][bj][m][1][e & 3]) + (e < 4 ? b0[e & 3] : b1[e & 3]);
                        const unsigned yy = yw[e >> 1]; const float y = __uint_as_float((e & 1) ? (yy & 0xffff0000u) : (yy << 16));
                        o[e] = y * __builtin_amdgcn_rcpf(1.0f + __builtin_amdgcn_exp2f(-1.4426950408889634f * a)); }
                    u32x4 w; w.x = cvt_pk_bf16(o[0], o[1]); w.y = cvt_pk_bf16(o[2], o[3]); w.z = cvt_pk_bf16(o[4], o[5]); w.w = cvt_pk_bf16(o[6], o[7]);
                    *(u32x4*)(Z + ro + bj * HALF) = w; } }
    }
};

template <class Epi, class Sched, bool ALIGN_EPI = false, bool SP2 = false>
__device__ __forceinline__ void gemm_phase(PG8_LAS unsigned char* lds, const Gemm g, const Sched& S, const Epi& E) {
    const int tid = threadIdx.x, wid = __builtin_amdgcn_readfirstlane(tid >> 6), lane = tid & 63, wr = wid >> 2, wc = wid & 3, fr = lane & 15, fq = lane >> 4;
    const int K = g.K, nt = K / BK;
    unsigned voffA[2], voffB[2];
#pragma unroll
    for (int i = 0; i < 2; ++i) { int R, C; stage_rc(tid * 16 + i * 8192, R, C); const int Rb = Epi::PERM ? ((R & ~31) + perm32(R & 31)) : R;
        voffA[i] = (unsigned)(R * K + C) * 2u; voffB[i] = (unsigned)(Rb * K + C) * 2u; }
    const size_t kstep = (size_t)(BK * 2);
    const size_t hstep = (size_t)HALF * K * 2;
    const size_t tstep = 2 * hstep;
    const unsigned ldsw = (unsigned)wid * 1024u;
    const int aoff = lds_byte(wr * 64 + fr, fq * 8), boff = lds_byte(wc * 32 + fr, fq * 8);
#define PG8_SA(b, h) (((b) * 2 + (h)) * HTB)
#define PG8_SB(b, h) ((4 + (b) * 2 + (h)) * HTB)
#define PG8_STAGE(bufoff, gbase, voff) do { _Pragma("unroll") for (int _i = 0; _i < 2; ++_i) \
        __builtin_amdgcn_global_load_lds((const unsigned*)((const char*)(gbase) + (voff)[_i]), (PG8_LAS unsigned*)(lds + (bufoff) + ldsw + _i * 8192), 16, 0, 0); } while (0)
#define PG8_LDA(dst, b, h) do { _Pragma("unroll") for (int m = 0; m < 4; ++m) _Pragma("unroll") for (int k = 0; k < 2; ++k) dst[m][k] = *(const PG8_LAS bf16x8*)(lds + PG8_SA(b, h) + aoff + m * 2048 + k * 1024); } while (0)
#define PG8_LDB(dst, b, h) do { _Pragma("unroll") for (int n = 0; n < 2; ++n) _Pragma("unroll") for (int k = 0; k < 2; ++k) dst[n][k] = *(const PG8_LAS bf16x8*)(lds + PG8_SB(b, h) + boff + n * 2048 + k * 1024); } while (0)
#define PG8_MMA(ai, bj, At, Bt) do { __builtin_amdgcn_s_setprio(1); _Pragma("unroll") for (int m = 0; m < 4; ++m) _Pragma("unroll") for (int n = 0; n < 2; ++n) _Pragma("unroll") for (int k = 0; k < 2; ++k) \
        acc[ai][bj][m][n] = __builtin_amdgcn_mfma_f32_16x16x32_bf16(Bt[n][k], At[m][k], acc[ai][bj][m][n], 0, 0, 0); __builtin_amdgcn_s_setprio(0); } while (0)
#define PG8_WAIT_V(n) asm volatile("s_waitcnt vmcnt(" #n ")" ::: "memory")
#define PG8_WAIT_L(n) asm volatile("s_waitcnt lgkmcnt(" #n ")" ::: "memory")
#define PG8_BAR __builtin_amdgcn_s_barrier()
#define PG8_SCHED __builtin_amdgcn_sched_barrier(0)
    Unit cur, nxt; int ui = 0;
    if (!S.next(0, cur)) return;
    f32x4 acc[2][2][4][2];
#pragma unroll
    for (int a = 0; a < 2; ++a)
#pragma unroll
        for (int b = 0; b < 2; ++b)
#pragma unroll
            for (int m = 0; m < 4; ++m)
#pragma unroll
                for (int n = 0; n < 2; ++n) acc[a][b][m][n] = (f32x4){0.f, 0.f, 0.f, 0.f};
    bf16x8 At[4][2], B0[2][2], B1[2][2];
    const char* cA = (const char*)g.A + (size_t)cur.pm * tstep; const char* cB = (const char*)g.Bt + (size_t)cur.pn * tstep;
    S.a_ready(cur);
    if constexpr (SP2) {
        PG8_STAGE(PG8_SB(0, 0), cB, voffB); PG8_STAGE(PG8_SB(0, 1), cB + hstep, voffB); PG8_STAGE(PG8_SA(0, 0), cA, voffA); PG8_STAGE(PG8_SA(0, 1), cA + hstep, voffA);
        if (wr == 1) PG8_BAR;
        PG8_WAIT_V(2); PG8_BAR;
        PG8_STAGE(PG8_SB(1, 0), cB + kstep, voffB); PG8_STAGE(PG8_SA(1, 0), cA + kstep, voffA); PG8_STAGE(PG8_SB(1, 1), cB + hstep + kstep, voffB);
        PG8_WAIT_V(6); PG8_BAR;
    } else {
        PG8_STAGE(PG8_SB(0, 0), cB, voffB); PG8_STAGE(PG8_SA(0, 0), cA, voffA); PG8_STAGE(PG8_SB(0, 1), cB + hstep, voffB); PG8_STAGE(PG8_SA(0, 1), cA + hstep, voffA);
        if (wr == 1) PG8_BAR;
        PG8_WAIT_V(4); PG8_BAR;
        PG8_STAGE(PG8_SB(1, 0), cB + kstep, voffB); PG8_STAGE(PG8_SA(1, 0), cA + kstep, voffA); PG8_STAGE(PG8_SB(1, 1), cB + hstep + kstep, voffB);
        PG8_WAIT_V(6); PG8_BAR;
    }
    for (;;) {
        const bool has_next = S.next(ui + 1, nxt);
        const char* nA = has_next ? (const char*)g.A + (size_t)nxt.pm * tstep : cA; const char* nB = has_next ? (const char*)g.Bt + (size_t)nxt.pn * tstep : cB;
        for (int t = 0; t < nt; t += 2) {
            const bool last = (t == nt - 2);
            const char* a1 = cA + (size_t)(t + 1) * kstep;
            const char* a2 = last ? nA : cA + (size_t)(t + 2) * kstep; const char* b2 = last ? nB : cB + (size_t)(t + 2) * kstep;
            const char* a3 = a2 + kstep; const char* b3 = b2 + kstep;
            if (last && has_next) S.a_ready(nxt);
            if constexpr (SP2) {
            PG8_LDB(B0, 0, 0); PG8_LDB(B1, 0, 1); PG8_SCHED; PG8_LDA(At, 0, 0); PG8_STAGE(PG8_SA(1, 1), a1 + hstep, voffA);
            PG8_WAIT_V(8); PG8_WAIT_L(0); PG8_BAR; PG8_MMA(0, 0, At, B0); PG8_MMA(0, 1, At, B1); PG8_BAR; PG8_SCHED;
            PG8_LDA(At, 0, 1); PG8_STAGE(PG8_SB(0, 0), b2, voffB); PG8_STAGE(PG8_SB(0, 1), b2 + hstep, voffB); PG8_STAGE(PG8_SA(0, 0), a2, voffA);
            PG8_WAIT_V(8); PG8_WAIT_L(0); PG8_BAR; PG8_MMA(1, 0, At, B0); PG8_MMA(1, 1, At, B1); PG8_BAR; PG8_SCHED;
            PG8_LDB(B0, 1, 0); PG8_LDB(B1, 1, 1); PG8_SCHED; PG8_LDA(At, 1, 0); PG8_STAGE(PG8_SA(0, 1), a2 + hstep, voffA);
            PG8_WAIT_V(8); PG8_WAIT_L(0); PG8_BAR; PG8_MMA(0, 0, At, B0); PG8_MMA(0, 1, At, B1); PG8_BAR; PG8_SCHED;
            PG8_LDA(At, 1, 1); PG8_STAGE(PG8_SB(1, 0), b3, voffB); PG8_STAGE(PG8_SB(1, 1), b3 + hstep, voffB); PG8_STAGE(PG8_SA(1, 0), a3, voffA);
            PG8_WAIT_V(8); PG8_WAIT_L(0); PG8_BAR; PG8_MMA(1, 0, At, B0); PG8_MMA(1, 1, At, B1); PG8_BAR; PG8_SCHED;
            } else {
            PG8_LDB(B0, 0, 0); PG8_SCHED; PG8_LDA(At, 0, 0); PG8_STAGE(PG8_SA(1, 1), a1 + hstep, voffA);
            PG8_WAIT_L(8); PG8_BAR; PG8_WAIT_L(0); PG8_MMA(0, 0, At, B0); PG8_BAR; PG8_SCHED;
            PG8_LDB(B1, 0, 1); PG8_STAGE(PG8_SB(0, 0), b2, voffB);
            PG8_BAR; PG8_WAIT_L(0); PG8_MMA(0, 1, At, B1); PG8_BAR;
            PG8_LDA(At, 0, 1); PG8_STAGE(PG8_SA(0, 0), a2, voffA);
            PG8_BAR; PG8_WAIT_L(0); PG8_MMA(1, 0, At, B0); PG8_BAR; PG8_SCHED;
            PG8_STAGE(PG8_SB(0, 1), b2 + hstep, voffB);
            PG8_WAIT_V(6); PG8_BAR; PG8_MMA(1, 1, At, B1); PG8_BAR;
            PG8_LDB(B0, 1, 0); PG8_SCHED; PG8_LDA(At, 1, 0); PG8_STAGE(PG8_SA(0, 1), a2 + hstep, voffA);
            PG8_WAIT_L(8); PG8_BAR; PG8_WAIT_L(0); PG8_MMA(0, 0, At, B0); PG8_BAR; PG8_SCHED;
            PG8_LDB(B1, 1, 1); PG8_STAGE(PG8_SB(1, 0), b3, voffB);
            PG8_BAR; PG8_WAIT_L(0); PG8_MMA(0, 1, At, B1); PG8_BAR;
            PG8_LDA(At, 1, 1); PG8_STAGE(PG8_SA(1, 0), a3, voffA);
            PG8_BAR; PG8_WAIT_L(0); PG8_MMA(1, 0, At, B0); PG8_BAR; PG8_SCHED;
            PG8_STAGE(PG8_SB(1, 1), b3 + hstep, voffB);
            PG8_WAIT_V(6); PG8_BAR; PG8_MMA(1, 1, At, B1); PG8_BAR;
            }
        }
        if constexpr (ALIGN_EPI) { if (wr == 0) PG8_BAR; }
        if constexpr (!Epi::AFTER_DRAIN) { E(acc, cur, wr, wc, fr, fq); S.done(cur); }
        if (!has_next) break;
#pragma unroll
        for (int a = 0; a < 2; ++a)
#pragma unroll
            for (int b = 0; b < 2; ++b)
#pragma unroll
                for (int m = 0; m < 4; ++m)
#pragma unroll
                    for (int n = 0; n < 2; ++n) acc[a][b][m][n] = (f32x4){0.f, 0.f, 0.f, 0.f};
        cur = nxt; cA = nA; cB = nB; ++ui;
        if constexpr (ALIGN_EPI) { if (wr == 1) PG8_BAR; }
    }
    PG8_WAIT_V(0);
    if constexpr (!ALIGN_EPI) { if (wr == 0) PG8_BAR; }
    PG8_BAR;
    if constexpr (Epi::AFTER_DRAIN) { E.fused(acc, cur, wr, wc, fr, fq, lds, wid, lane); S.done(cur); }
#undef PG8_SA
#undef PG8_SB
#undef PG8_STAGE
#undef PG8_LDA
#undef PG8_LDB
#undef PG8_MMA
#undef PG8_WAIT_V
#undef PG8_WAIT_L
#undef PG8_BAR
#undef PG8_SCHED
}
}

constexpr bool PG8_SP2 = true, PG8_ALIGN = true;

#define GAS __attribute__((address_space(1)))
#define LAS __attribute__((address_space(3)))
#define XB_TMO      128
#define XB_XCNT(j)  (256  + 64 * (j))
#define XB_XSUB(j)  (1280 + 64 * (j))
#define XB_XGEN(j)  (2304 + 64 * (j))
#define XB_TOP      3328
#define XB_TOPGEN   3392
#define XCD_BAR_WORDS 3456
#define XB_SPIN_CAP (1u << 22)
__device__ __forceinline__ unsigned xb_ld(unsigned* p)              { return __hip_atomic_load(p, __ATOMIC_RELAXED, __HIP_MEMORY_SCOPE_AGENT); }
__device__ __forceinline__ unsigned xb_add(unsigned* p, unsigned v) { return __hip_atomic_fetch_add(p, v, __ATOMIC_RELAXED, __HIP_MEMORY_SCOPE_AGENT); }
__device__ __forceinline__ unsigned xb_xcc_id() { return (unsigned)__builtin_amdgcn_s_getreg((3 << 11) | 20) & 0xFu; }
#define XB_SPIN(cond, bar) do { unsigned _sp = 0; while (cond) { __builtin_amdgcn_s_sleep(1); \
    if ((++_sp & 255u) == 0u) { if (xb_ld(&(bar)[XB_TMO])) break; if (_sp > XB_SPIN_CAP) { atomicAdd(&(bar)[XB_TMO], 1u); break; } } } } while (0)
struct XcdBarrier { unsigned* bar; unsigned x; volatile LAS unsigned* st; };
__device__ __forceinline__ XcdBarrier xcd_barrier_post(unsigned* bar, volatile LAS unsigned* st) {
    XcdBarrier b; b.bar = bar; b.x = xb_xcc_id(); b.st = st;
    if (threadIdx.x == 0) (void)xb_add(&bar[XB_XCNT(b.x)], 1u);
    return b;
}
__device__ __forceinline__ void xcd_barrier_complete(unsigned* bar, unsigned x, unsigned& nloc, unsigned& nx) {
    const unsigned G = gridDim.x * gridDim.y * gridDim.z;
    unsigned sum, cnt, mine, sp = 0u;
    for (;;) {
        sum = 0u; cnt = 0u; mine = 0u;
#pragma unroll
        for (unsigned j = 0; j < 16; ++j) { const unsigned c = xb_ld(&bar[XB_XCNT(j)]); sum += c; cnt += (c > 0u) ? 1u : 0u; mine = (j == x) ? c : mine; }
        if (sum == G) break;
        __builtin_amdgcn_s_sleep(1);
        if ((++sp & 255u) == 0u) { if (xb_ld(&bar[XB_TMO])) break; if (sp > XB_SPIN_CAP) { atomicAdd(&bar[XB_TMO], 1u); break; } }
    }
    nloc = mine > 0u ? mine : 1u; nx = cnt > 0u ? cnt : 1u;
}
__device__ __forceinline__ void xcd_barrier(const XcdBarrier& b) {
    asm volatile("s_waitcnt vmcnt(0)" ::: "memory");
    __syncthreads();
    if (threadIdx.x == 0) {
        unsigned* bar = b.bar;
        __builtin_amdgcn_s_waitcnt(0);
        unsigned nloc = b.st[0], nx = b.st[1];
        if (nloc == 0u) { xcd_barrier_complete(bar, b.x, nloc, nx); b.st[0] = nloc; b.st[1] = nx; }
        const unsigned old = xb_add(&bar[XB_XSUB(b.x)], 1u);
        const unsigned gen = old / nloc;
        if (old + 1u == (gen + 1u) * nloc) {
            __builtin_amdgcn_fence(__ATOMIC_RELEASE, "agent");
            asm volatile("s_waitcnt vmcnt(0)" ::: "memory");
            const unsigned og = xb_add(&bar[XB_TOP], 1u);
            const unsigned tg = og / nx;
            if (og + 1u == (tg + 1u) * nx) xb_add(&bar[XB_TOPGEN], 1u);
            else XB_SPIN(xb_ld(&bar[XB_TOPGEN]) == tg, bar);
            __builtin_amdgcn_fence(__ATOMIC_ACQUIRE, "agent");
            xb_add(&bar[XB_XGEN(b.x)], 1u);
            asm volatile("s_waitcnt vmcnt(0)" ::: "memory");
        } else {
            XB_SPIN(xb_ld(&bar[XB_XGEN(b.x)]) == gen, bar);
            __builtin_amdgcn_fence(__ATOMIC_ACQUIRE, "agent");
            asm volatile("s_waitcnt vmcnt(0)" ::: "memory");
        }
    }
    __syncthreads();
}
__device__ __forceinline__ unsigned f2bf(float f) { unsigned u = __builtin_bit_cast(unsigned, f); return (u + 0x7fffu + ((u >> 16) & 1u)) >> 16; }
__device__ __forceinline__ unsigned pk2(float lo, float hi) { return f2bf(lo) | (f2bf(hi) << 16); }
__device__ __forceinline__ float wave_sum(float v) {
#pragma unroll
    for (int o = 1; o < 64; o <<= 1) v += __shfl_xor(v, o);
    return v;
}

__device__ void nv_rms(const float* in, int ldin, const float* g, int ncols, int nrows, const float* base, int ldbase, float alpha, float* out, int ldout, int bid, int nblk) {
    const int lane = threadIdx.x & 63, wave = threadIdx.x >> 6, nw = blockDim.x >> 6;
    for (int r = bid * nw + wave; r < nrows; r += nblk * nw) {
        const float* ir = in + (size_t)r * ldin;
        float s = 0.f;
        for (int c = lane * 4; c < ncols; c += 256) { const float4 v = *(const float4*)(ir + c); s += v.x * v.x + v.y * v.y + v.z * v.z + v.w * v.w; }
        s = wave_sum(s);
        const float rs = 1.0f / sqrtf(s / (float)ncols + RMS_EPS);
        for (int c = lane * 4; c < ncols; c += 256) {
            const float4 v = *(const float4*)(ir + c); const float4 gg = *(const float4*)(g + c);
            float4 b = make_float4(0.f, 0.f, 0.f, 0.f); if (base) b = *(const float4*)(base + (size_t)r * ldbase + c);
            float4 o; o.x = b.x + alpha * (v.x * rs * gg.x); o.y = b.y + alpha * (v.y * rs * gg.y); o.z = b.z + alpha * (v.z * rs * gg.z); o.w = b.w + alpha * (v.w * rs * gg.w);
            *(float4*)(out + (size_t)r * ldout + c) = o;
        }
    }
}

template <int MODE>
__device__ void nv_gemm(const float* A, int lda, const float* B, const float* B2, int ldb, float* C, int ldc, int M, int N, int K, const float* bias, float* smem, int bid, int nblk) {
    float* As = smem;
    float* Bs = smem + 16 * 132;
    float* B2s = Bs + 16 * 64;
    const int t = threadIdx.x, ty = t >> 4, tx = t & 15;
    const int ntm = M / 128, ntn = N / 64;
    for (int tile = bid; tile < ntm * ntn; tile += nblk) {
        const int tm = tile / ntn, tn = tile % ntn, m0 = tm * 128, n0 = tn * 64;
        float acc[4][4], acc2[4][4];
#pragma unroll
        for (int i = 0; i < 4; ++i)
#pragma unroll
            for (int j = 0; j < 4; ++j) { acc[i][j] = 0.f; acc2[i][j] = 0.f; }
        for (int k0 = 0; k0 < K; k0 += 16) {
            {
                const int r = t >> 2, kc = (t & 3) * 4;
                const float4 v = *(const float4*)(A + (size_t)(m0 + r) * lda + k0 + kc);
                As[(kc + 0) * 132 + r] = v.x; As[(kc + 1) * 132 + r] = v.y; As[(kc + 2) * 132 + r] = v.z; As[(kc + 3) * 132 + r] = v.w;
            }
            {
                const int kr = t >> 5, c2 = (t & 31) * 2;
                const float2 v = *(const float2*)(B + (size_t)(k0 + kr) * ldb + n0 + c2);
                Bs[kr * 64 + c2] = v.x; Bs[kr * 64 + c2 + 1] = v.y;
                if (MODE == 1) { const float2 w = *(const float2*)(B2 + (size_t)(k0 + kr) * ldb + n0 + c2); B2s[kr * 64 + c2] = w.x; B2s[kr * 64 + c2 + 1] = w.y; }
            }
            __syncthreads();
#pragma unroll
            for (int kk = 0; kk < 16; ++kk) {
                const float4 a = *(const float4*)(As + kk * 132 + ty * 4);
                const float4 b = *(const float4*)(Bs + kk * 64 + tx * 4);
                const float av[4] = {a.x, a.y, a.z, a.w}, bv[4] = {b.x, b.y, b.z, b.w};
#pragma unroll
                for (int i = 0; i < 4; ++i)
#pragma unroll
                    for (int j = 0; j < 4; ++j) acc[i][j] += av[i] * bv[j];
                if (MODE == 1) {
                    const float4 b2 = *(const float4*)(B2s + kk * 64 + tx * 4);
                    const float b2v[4] = {b2.x, b2.y, b2.z, b2.w};
#pragma unroll
                    for (int i = 0; i < 4; ++i)
#pragma unroll
                        for (int j = 0; j < 4; ++j) acc2[i][j] += av[i] * b2v[j];
                }
            }
            __syncthreads();
        }
#pragma unroll
        for (int i = 0; i < 4; ++i) {
            const int r = m0 + ty * 4 + i, c = n0 + tx * 4;
            float o[4];
#pragma unroll
            for (int j = 0; j < 4; ++j) {
                float v = acc[i][j];
                if (MODE == 1) { const float sg = 1.0f / (1.0f + expf(-v)); v = v * sg * acc2[i][j]; }
                if (MODE == 2) { const float zz = v + bias[c + j]; const float sg = 1.0f / (1.0f + expf(-zz)); v = A[(size_t)r * lda + c + j] * sg; }
                o[j] = v;
            }
            *(float4*)(C + (size_t)r * ldc + c) = make_float4(o[0], o[1], o[2], o[3]);
        }
    }
}

__device__ __forceinline__ float bf2f(unsigned short b) { return __uint_as_float((unsigned)b << 16); }
__device__ void nv_kmean(const unsigned short* k, int ldk, float* kmean, int bid, int nblk) {
    for (int idx = bid * blockDim.x + threadIdx.x; idx < BATCH * NBLK * D_ATTN; idx += nblk * blockDim.x) {
        const int c = idx % D_ATTN, bn = idx / D_ATTN;
        const unsigned short* p = k + (size_t)bn * MOBA_L * ldk + c;
        float s = 0.f;
        for (int r = 0; r < MOBA_L; ++r) s += bf2f(p[(size_t)r * ldk]);
        kmean[idx] = s * (1.0f / MOBA_L);
    }
}

__device__ void nv_attn(const unsigned short* q, const unsigned short* k, const unsigned short* v, int ld, const float* kmean, unsigned short* out, int ldo, int bid, int nblk) {
    const int lane = threadIdx.x & 63, wave = threadIdx.x >> 6, nw = blockDim.x >> 6;
    const int nwu = BATCH * NH * (SEQ / 64);
    for (int wu = bid * nw + wave; wu < nwu; wu += nblk * nw) {
        const int wuu = __builtin_amdgcn_readfirstlane(wu);
        const int tc = wuu % (SEQ / 64), bh = wuu / (SEQ / 64), h = bh % NH, b = bh / NH;
        const int t = tc * 64 + lane, qb = (tc * 64) / MOBA_L;
        const float slope = exp2f(-(float)(h + 1));
        float qv[HD];
        const unsigned short* qp = q + (size_t)(b * SEQ + t) * ld + h * HD;
#pragma unroll
        for (int d = 0; d < HD; ++d) qv[d] = bf2f(qp[d]);
        float gate[NBLK];
#pragma unroll
        for (int n = 0; n < NBLK; ++n) {
            gate[n] = -1e30f;
            if (n < qb) { const float* km = kmean + (size_t)(b * NBLK + n) * D_ATTN + h * HD; float s = 0.f;
#pragma unroll
                for (int d = 0; d < HD; ++d) s += qv[d] * km[d];
                gate[n] = s; }
        }
        unsigned selmask = 0u;
#pragma unroll
        for (int n = 0; n < NBLK; ++n) {
            int rank = 0;
#pragma unroll
            for (int m2 = 0; m2 < NBLK; ++m2) { if (m2 < qb && (gate[m2] > gate[n] || (gate[m2] == gate[n] && m2 < n))) ++rank; }
            if (n < qb && rank < 3) selmask |= (1u << n);
        }
        float mrun = -INFINITY, lrun = 0.f, o[HD];
#pragma unroll
        for (int d = 0; d < HD; ++d) o[d] = 0.f;
        for (int n = 0; n <= qb; ++n) {
            const bool sel = (n == qb) || ((selmask >> n) & 1u);
            if (!__any(sel)) continue;
            for (int j = 0; j < MOBA_L; ++j) {
                const int kp = n * MOBA_L + j;
                const unsigned short* kr = k + (size_t)(b * SEQ + kp) * ld + h * HD;
                const unsigned short* vr = v + (size_t)(b * SEQ + kp) * ld + h * HD;
                float s = 0.f;
#pragma unroll
                for (int d = 0; d < HD; ++d) s += qv[d] * bf2f(kr[d]);
                s = s * 0.125f - slope * (float)(t - kp);
                const bool valid = sel && (kp <= t);
                if (valid) {
                    const float mn = fmaxf(mrun, s), corr = expf(mrun - mn), p = expf(s - mn);
                    lrun = lrun * corr + p;
#pragma unroll
                    for (int d = 0; d < HD; ++d) o[d] = o[d] * corr + p * bf2f(vr[d]);
                    mrun = mn;
                }
            }
        }
        const float inv = 1.0f / lrun;
        unsigned short* op = out + (size_t)(b * SEQ + t) * ldo + h * HD;
#pragma unroll
        for (int d = 0; d < HD; d += 2) *(unsigned*)(op + d) = pk2(o[d] * inv, o[d + 1] * inv);
    }
}

__device__ __forceinline__ float gelu_tanh(float x) { const float u = 0.7978845608028654f * (x + 0.044715f * x * x * x); return 0.5f * x * (1.0f + tanhf(u)); }

__device__ void nv_ssm(const unsigned short* us, int ldu, const float* lam_re, const float* lam_im, const float* log_dt, const float* b_re, const float* b_im,
                       const float* c_re, const float* c_im, const float* d_skip, unsigned short* yout, int ldy, int bid, int nblk) {
    const int lane = threadIdx.x & 63, wave = threadIdx.x >> 6, nw = blockDim.x >> 6;
    for (int wu = bid * nw + wave; wu < BATCH * NG; wu += nblk * nw) {
        const int wuu = __builtin_amdgcn_readfirstlane(wu);
        const int g = wuu % NG, b = wuu / NG, p = lane;
        const double lr = (double)lam_re[g * SSM_P + p], li = (double)lam_im[g * SSM_P + p], dt = exp((double)log_dt[g]);
        const double mag = exp(lr * dt), ang = li * dt, are = mag * cos(ang), aim = mag * sin(ang), den = lr * lr + li * li;
        const double fre = ((are - 1.0) * lr + aim * li) / den, fim = (aim * lr - (are - 1.0) * li) / den;
        const float a_re = (float)are, a_im = (float)aim;
        float bbr[SSM_GROUP], bbi[SSM_GROUP], cr[SSM_GROUP], ci[SSM_GROUP];
#pragma unroll
        for (int h = 0; h < SSM_GROUP; ++h) {
            const double br = (double)b_re[(g * SSM_P + p) * SSM_GROUP + h], bi = (double)b_im[(g * SSM_P + p) * SSM_GROUP + h];
            bbr[h] = (float)(fre * br - fim * bi); bbi[h] = (float)(fre * bi + fim * br);
            cr[h] = c_re[(g * SSM_GROUP + h) * SSM_P + p]; ci[h] = c_im[(g * SSM_GROUP + h) * SSM_P + p];
        }
        const float dsk = (lane < SSM_GROUP) ? d_skip[g * SSM_GROUP + lane] : 0.f;
        float hre = 0.f, him = 0.f;
        for (int t = 0; t < SEQ; ++t) {
            const unsigned short* up = us + (size_t)(b * SEQ + t) * ldu + g * SSM_GROUP;
            float xr = 0.f, xi = 0.f, uu[SSM_GROUP];
#pragma unroll
            for (int h = 0; h < SSM_GROUP; ++h) { uu[h] = bf2f(up[h]); xr += uu[h] * bbr[h]; xi += uu[h] * bbi[h]; }
            const float nre = a_re * hre - a_im * him + xr, nim = a_re * him + a_im * hre + xi;
            hre = nre; him = nim;
            float mine = 0.f, myu = 0.f;
#pragma unroll
            for (int h = 0; h < SSM_GROUP; ++h) { const float tot = wave_sum(hre * cr[h] - him * ci[h]); if (lane == h) { mine = tot; myu = uu[h]; } }
            if (lane < SSM_GROUP) { const float y = mine + dsk * myu; yout[(size_t)(b * SEQ + t) * ldy + g * SSM_GROUP + lane] = (unsigned short)f2bf(gelu_tanh(y)); }
        }
    }
}


constexpr size_t MiB = 1048576;
constexpr size_t WS_WUP1 = 0, WS_WDN1 = 11 * MiB, WS_WUP2 = 17 * MiB, WS_WDN2 = 28 * MiB, WS_WIN = 34 * MiB, WS_WGLU = 38 * MiB, WS_WOUT = 39 * MiB;
constexpr size_t WS_XNB = 42 * MiB, WS_F = 74 * MiB, WS_HACT = 138 * MiB;
constexpr size_t WS_Q = 138 * MiB, WS_ATT = 202 * MiB, WS_YG = 218 * MiB, WS_Z = 234 * MiB, WS_KMEAN = 250 * MiB;
constexpr size_t QKVU_STRIDE = (size_t)MTOK * 512;
constexpr size_t WS_CTL = 255 * MiB, CTL_BYTES = 65536;
constexpr int LDS_BYTES = 147456, MISC_OFF = 131072 + 320;
typedef unsigned short bf16;

__device__ __forceinline__ void p0_transpose_item(const float* W, int K, int N, bf16* WT, int mode, LAS float* scr, int item, int lane) {
    const int nblk = N / 32, kb = item / nblk, nb = item % nblk, k0 = 64 * kb, n0 = 32 * nb;
    const int r0 = (mode == 0) ? n0 : (256 * (n0 / 128) + (n0 % 128) + (mode == 2 ? 128 : 0));
#pragma unroll 8
    for (int i = 0; i < 32; ++i) { const int kk = 2 * i + (lane >> 5); scr[kk * 33 + (lane & 31)] = W[(size_t)(k0 + kk) * N + n0 + (lane & 31)]; }
    asm volatile("s_waitcnt lgkmcnt(0)" ::: "memory");
    const int c = lane & 7;
#pragma unroll
    for (int j = 0; j < 4; ++j) { const int n = (lane >> 3) + 8 * j; const LAS float* s = scr + (8 * c) * 33 + n;
        uint4 o; o.x = pk2(s[0 * 33], s[1 * 33]); o.y = pk2(s[2 * 33], s[3 * 33]); o.z = pk2(s[4 * 33], s[5 * 33]); o.w = pk2(s[6 * 33], s[7 * 33]);
        *(uint4*)(WT + (size_t)(r0 + n) * K + k0 + 8 * c) = o; }
    asm volatile("s_waitcnt lgkmcnt(0)" ::: "memory");
}
struct ConvJob { const float* W; bf16* WT; int K, N, mode, items; };
__device__ __forceinline__ void conv_weights(const Args& a, LAS unsigned char* lds, int bid, int nblk) {
    const int lane = threadIdx.x & 63, wave = threadIdx.x >> 6;
    LAS float* scr = (LAS float*)(lds + wave * 16384);
    const int gw = bid * NWAVES + wave, NGW = nblk * NWAVES;
    constexpr int I_G = (D_MODEL / 64) * (D_FF / 32), I_D = (D_FF / 64) * (D_MODEL / 32), I_IN = (D_MODEL / 64) * (D_IN / 32), I_GL = (D_SSM / 64) * (D_SSM / 32), I_O = (D_MODEL / 64) * (D_MODEL / 32);
    constexpr int NITEMS = 4 * I_G + 2 * I_D + I_IN + I_GL + I_O;
    for (int it = gw; it < NITEMS; it += NGW) {
        int r = it;
        if (r < I_G) { p0_transpose_item(a.in[I_F1WG], D_MODEL, D_FF, (bf16*)(a.ws + WS_WUP1), 1, scr, r, lane); continue; } r -= I_G;
        if (r < I_G) { p0_transpose_item(a.in[I_F1WU], D_MODEL, D_FF, (bf16*)(a.ws + WS_WUP1), 2, scr, r, lane); continue; } r -= I_G;
        if (r < I_D) { p0_transpose_item(a.in[I_F1WD], D_FF, D_MODEL, (bf16*)(a.ws + WS_WDN1), 0, scr, r, lane); continue; } r -= I_D;
        if (r < I_G) { p0_transpose_item(a.in[I_F2WG], D_MODEL, D_FF, (bf16*)(a.ws + WS_WUP2), 1, scr, r, lane); continue; } r -= I_G;
        if (r < I_G) { p0_transpose_item(a.in[I_F2WU], D_MODEL, D_FF, (bf16*)(a.ws + WS_WUP2), 2, scr, r, lane); continue; } r -= I_G;
        if (r < I_D) { p0_transpose_item(a.in[I_F2WD], D_FF, D_MODEL, (bf16*)(a.ws + WS_WDN2), 0, scr, r, lane); continue; } r -= I_D;
        if (r < I_IN) { p0_transpose_item(a.in[I_WIN], D_MODEL, D_IN, (bf16*)(a.ws + WS_WIN), 0, scr, r, lane); continue; } r -= I_IN;
        if (r < I_GL) { p0_transpose_item(a.in[I_WGLU], D_SSM, D_SSM, (bf16*)(a.ws + WS_WGLU), 0, scr, r, lane); continue; } r -= I_GL;
        p0_transpose_item(a.in[I_WOUT], D_MODEL, D_MODEL, (bf16*)(a.ws + WS_WOUT), 0, scr, r, lane);
    }
}
__device__ __forceinline__ void rms_rows_bf16(const float* in, const float* g, bf16* out, int bid, int nblk) {
    const int lane = threadIdx.x & 63, wave = threadIdx.x >> 6;
    for (int r = bid * NWAVES + wave; r < MTOK; r += nblk * NWAVES) {
        const float4* ir = (const float4*)(in + (size_t)r * D_MODEL) + lane;
        float4 v[4]; float s = 0.f;
#pragma unroll
        for (int j = 0; j < 4; ++j) { v[j] = ir[64 * j]; s += v[j].x * v[j].x + v[j].y * v[j].y + v[j].z * v[j].z + v[j].w * v[j].w; }
        s = wave_sum(s);
        const float rs = 1.0f / sqrtf(s * (1.0f / D_MODEL) + RMS_EPS);
        uint2* o8 = (uint2*)(out + (size_t)r * D_MODEL) + lane;
#pragma unroll
        for (int j = 0; j < 4; ++j) { const float4 gg = ((const float4*)g)[lane + 64 * j];
            uint2 o; o.x = pk2(v[j].x * rs * gg.x, v[j].y * rs * gg.y); o.y = pk2(v[j].z * rs * gg.z, v[j].w * rs * gg.w); o8[64 * j] = o; }
    }
}
__device__ __forceinline__ void rms512_bf16(const bf16* in, const float* g, bf16* out, int coff, int bid, int nblk) {
    const int lane = threadIdx.x & 63, wave = threadIdx.x >> 6;
    for (int r = bid * NWAVES + wave; r < MTOK; r += nblk * NWAVES) {
        const uint4 w = *((const uint4*)(in + (size_t)r * 512) + lane);
        float v[8]; v[0] = __uint_as_float(w.x << 16); v[1] = __uint_as_float(w.x & 0xffff0000u); v[2] = __uint_as_float(w.y << 16); v[3] = __uint_as_float(w.y & 0xffff0000u);
        v[4] = __uint_as_float(w.z << 16); v[5] = __uint_as_float(w.z & 0xffff0000u); v[6] = __uint_as_float(w.w << 16); v[7] = __uint_as_float(w.w & 0xffff0000u);
        float s = 0.f;
#pragma unroll
        for (int e = 0; e < 8; ++e) s += v[e] * v[e];
        s = wave_sum(s);
        const float rs = 1.0f / sqrtf(s * (1.0f / 512.0f) + RMS_EPS);
        const float4 g0 = ((const float4*)g)[2 * lane], g1 = ((const float4*)g)[2 * lane + 1];
        uint4 o; o.x = pk2(v[0] * rs * g0.x, v[1] * rs * g0.y); o.y = pk2(v[2] * rs * g0.z, v[3] * rs * g0.w); o.z = pk2(v[4] * rs * g1.x, v[5] * rs * g1.y); o.w = pk2(v[6] * rs * g1.z, v[7] * rs * g1.w);
        *((uint4*)(out + (size_t)r * 1024 + coff) + lane) = o;
    }
}

__global__ void __launch_bounds__(NTHR, 2) k_mega(Args a) {
    extern __shared__ __attribute__((aligned(16))) unsigned char lds[];
    LAS unsigned char* ldsl = (LAS unsigned char*)lds;
    const int bid = blockIdx.x, nblk = gridDim.x;
    volatile LAS unsigned* MISC = (volatile LAS unsigned*)(ldsl + MISC_OFF);
    if (threadIdx.x < 32) MISC[threadIdx.x] = 0u;
    __syncthreads();
    XcdBarrier bar = xcd_barrier_post((unsigned*)(a.ws + WS_CTL), MISC + 8);
    bf16* WUP1 = (bf16*)(a.ws + WS_WUP1); bf16* WDN1 = (bf16*)(a.ws + WS_WDN1); bf16* WUP2 = (bf16*)(a.ws + WS_WUP2); bf16* WDN2 = (bf16*)(a.ws + WS_WDN2);
    bf16* WINT = (bf16*)(a.ws + WS_WIN); bf16* WGLUT = (bf16*)(a.ws + WS_WGLU); bf16* WOUTT = (bf16*)(a.ws + WS_WOUT);
    bf16* XNB = (bf16*)(a.ws + WS_XNB); bf16* HACT = (bf16*)(a.ws + WS_HACT); float* FB = (float*)(a.ws + WS_F);
    bf16* QB = (bf16*)(a.ws + WS_Q); bf16* KB = QB + QKVU_STRIDE; bf16* VB = KB + QKVU_STRIDE; bf16* USB = VB + QKVU_STRIDE;
    bf16* ATT = (bf16*)(a.ws + WS_ATT); bf16* YG = (bf16*)(a.ws + WS_YG); bf16* ZB = (bf16*)(a.ws + WS_Z); float* KMEAN = (float*)(a.ws + WS_KMEAN);
    float* H = a.out;
    const float* x = a.in[I_X];
    conv_weights(a, ldsl, bid, nblk); rms_rows_bf16(x, a.in[I_F1PRE], XNB, bid, nblk);
    xcd_barrier(bar);
    { pg8::Gemm g{XNB, WUP1, MTOK, 2 * D_FF, D_MODEL}; pg8::StaticOrder S; S.init(MTOK, 2 * D_FF, nblk, bid); pg8::EpiSwiGLU E{HACT, D_FF};
      pg8::gemm_phase<pg8::EpiSwiGLU, pg8::StaticOrder, PG8_ALIGN, PG8_SP2>(ldsl, g, S, E); }
    xcd_barrier(bar);
    { pg8::Gemm g{HACT, WDN1, MTOK, D_MODEL, D_FF}; pg8::StaticOrder S; S.init(MTOK, D_MODEL, nblk, bid); pg8::EpiF32 E{FB, D_MODEL};
      pg8::gemm_phase<pg8::EpiF32, pg8::StaticOrder, PG8_ALIGN, PG8_SP2>(ldsl, g, S, E); }
    xcd_barrier(bar);
    nv_rms(FB, 1024, a.in[I_F1POST], 1024, MTOK, x, 1024, 0.5f, H, 1024, bid, nblk);
    xcd_barrier(bar);
    rms_rows_bf16(H, a.in[I_MIXPRE], XNB, bid, nblk);
    xcd_barrier(bar);
    { pg8::Gemm g{XNB, WINT, MTOK, D_IN, D_MODEL}; pg8::StaticOrder S; S.init(MTOK, D_IN, nblk, bid); pg8::EpiBf16Split E{QB, QKVU_STRIDE};
      pg8::gemm_phase<pg8::EpiBf16Split, pg8::StaticOrder, PG8_ALIGN, PG8_SP2>(ldsl, g, S, E); }
    xcd_barrier(bar);
    nv_kmean(KB, 512, KMEAN, bid, nblk);
    xcd_barrier(bar);
    nv_attn(QB, KB, VB, 512, KMEAN, ATT, 512, bid, nblk);
    xcd_barrier(bar);
    nv_ssm(USB, 512, a.in[I_LAMRE], a.in[I_LAMIM], a.in[I_LOGDT], a.in[I_BRE], a.in[I_BIM], a.in[I_CRE], a.in[I_CIM], a.in[I_DSKIP], YG, 512, bid, nblk);
    xcd_barrier(bar);
    { pg8::Gemm g{YG, WGLUT, MTOK, D_SSM, D_SSM}; pg8::StaticOrder S; S.init(MTOK, D_SSM, nblk, bid); pg8::EpiGLU E{YG, ZB, a.in[I_BGLU]};
      pg8::gemm_phase<pg8::EpiGLU, pg8::StaticOrder, PG8_ALIGN, PG8_SP2>(ldsl, g, S, E); }
    xcd_barrier(bar);
    rms512_bf16(ATT, a.in[I_ATTNG], XNB, 0, bid, nblk); rms512_bf16(ZB, a.in[I_SSMG], XNB, 512, bid, nblk);
    xcd_barrier(bar);
    { pg8::Gemm g{XNB, WOUTT, MTOK, D_MODEL, D_MODEL}; pg8::StaticOrder S; S.init(MTOK, D_MODEL, nblk, bid); pg8::EpiF32 E{FB, D_MODEL};
      pg8::gemm_phase<pg8::EpiF32, pg8::StaticOrder, PG8_ALIGN, PG8_SP2>(ldsl, g, S, E); }
    xcd_barrier(bar);
    nv_rms(FB, 1024, a.in[I_MIXPOST], 1024, MTOK, H, 1024, 1.0f, H, 1024, bid, nblk);
    xcd_barrier(bar);
    rms_rows_bf16(H, a.in[I_F2PRE], XNB, bid, nblk);
    xcd_barrier(bar);
    { pg8::Gemm g{XNB, WUP2, MTOK, 2 * D_FF, D_MODEL}; pg8::StaticOrder S; S.init(MTOK, 2 * D_FF, nblk, bid); pg8::EpiSwiGLU E{HACT, D_FF};
      pg8::gemm_phase<pg8::EpiSwiGLU, pg8::StaticOrder, PG8_ALIGN, PG8_SP2>(ldsl, g, S, E); }
    xcd_barrier(bar);
    { pg8::Gemm g{HACT, WDN2, MTOK, D_MODEL, D_FF}; pg8::StaticOrder S; S.init(MTOK, D_MODEL, nblk, bid); pg8::EpiF32 E{FB, D_MODEL};
      pg8::gemm_phase<pg8::EpiF32, pg8::StaticOrder, PG8_ALIGN, PG8_SP2>(ldsl, g, S, E); }
    xcd_barrier(bar);
    nv_rms(FB, 1024, a.in[I_F2POST], 1024, MTOK, H, 1024, 0.5f, H, 1024, bid, nblk);
}

extern "C" void kernel_launch(void* const* d_in, const int* in_sizes, int n_in, void* d_out, int out_size, void* d_ws, size_t ws_size, hipStream_t stream) {
    static int grid = 0;
    if (grid == 0) {
        if (n_in != 27 || out_size != MTOK * D_MODEL || ws_size < 256u * 1048576u) { fprintf(stderr, "kernel_launch: unexpected shapes n_in %d out %d ws %zu\n", n_in, out_size, ws_size); grid = -1; return; }
        int dev = 0, cus = 0, per_cu = 0;
        if (hipGetDevice(&dev) != hipSuccess || hipDeviceGetAttribute(&cus, hipDeviceAttributeMultiprocessorCount, dev) != hipSuccess) { grid = -1; return; }
        if (hipFuncSetAttribute((const void*)k_mega, hipFuncAttributeMaxDynamicSharedMemorySize, LDS_BYTES) != hipSuccess) { fprintf(stderr, "hipFuncSetAttribute failed\n"); grid = -1; return; }
        if (hipOccupancyMaxActiveBlocksPerMultiprocessor(&per_cu, (const void*)k_mega, NTHR, LDS_BYTES) != hipSuccess || per_cu < 1) { fprintf(stderr, "occupancy query: %d blocks per CU\n", per_cu); grid = -1; (void)hipGetLastError(); return; }
        grid = cus;
    }
    if (grid < 0) return;
    if (hipMemsetAsync((char*)d_ws + WS_CTL, 0, CTL_BYTES, stream) != hipSuccess) return;
    Args a{};
    for (int i = 0; i < 27; ++i) a.in[i] = (const float*)d_in[i];
    a.out = (float*)d_out; a.ws = (unsigned char*)d_ws;
    hipLaunchKernelGGL(k_mega, dim3(grid), dim3(NTHR), LDS_BYTES, stream, a);
}
```

```cpp
#include <hip/hip_runtime.h>
#include <cstdint>
#include <cstdio>

constexpr int D_MODEL = 1024, BATCH = 8, SEQ = 2048, MTOK = BATCH * SEQ;
constexpr int NH = 8, HD = 64, D_ATTN = 512, MOBA_L = 256, NBLK = SEQ / MOBA_L;
constexpr int SSM_GROUP = 16, D_SSM = 512, NG = 32, SSM_P = 64;
constexpr int D_IN = 2048, D_FF = 2816;
constexpr float RMS_EPS = 1e-6f;
constexpr int NTHR = 512, NWAVES = 8;

struct Args {
    const float* in[27];
    float* out;
    unsigned char* ws;
    int stage, pad;
};
enum { I_X = 0, I_F1PRE, I_F1WG, I_F1WU, I_F1WD, I_F1POST, I_MIXPRE, I_WIN, I_LAMRE, I_LAMIM, I_LOGDT, I_BRE, I_BIM, I_CRE, I_CIM, I_DSKIP,
       I_WGLU, I_BGLU, I_ATTNG, I_SSMG, I_WOUT, I_MIXPOST, I_F2PRE, I_F2WG, I_F2WU, I_F2WD, I_F2POST };

namespace pg8 {
#define PG8_LAS __attribute__((address_space(3)))
typedef unsigned short bf16_t;
typedef short bf16x8 __attribute__((ext_vector_type(8)));
typedef float f32x4 __attribute__((ext_vector_type(4)));
typedef unsigned u32x4 __attribute__((ext_vector_type(4)));
constexpr int BM = 256, BK = 64, HALF = 128, HTB = HALF * BK * 2  , STAGE_BYTES = 8 * HTB, NXCD = 8, WGM = 8;

__host__ __device__ __forceinline__ int lds_byte(int r, int c) { const int st = (r >> 4) * 2 + (c >> 5), rr = r & 15, cc = c & 31, ob = rr * 64 + cc * 2; return st * 1024 + (ob ^ (((ob >> 9) & 1) << 5)); }
__host__ __device__ __forceinline__ void stage_rc(int b, int& R, int& C) { const int st = b / 1024, sb = b % 1024, swz = sb ^ (((sb >> 9) & 1) << 5); R = (st >> 1) * 16 + swz / 64; C = (st & 1) * 32 + (swz % 64) / 2; }
__host__ __device__ __forceinline__ int perm32(int rho) { const int n = rho >> 4, i = rho & 15; return 8 * (i >> 2) + 4 * n + (i & 3); }

struct Unit { int pm, pn; };
struct Gemm { const bf16_t* A; const bf16_t* Bt; int M, N, K; };

struct StaticOrder {
    int nM, nN, nwg, G, c;
    __host__ __device__ void init(int M, int N, int G_, int c_) { nM = M / BM; nN = N / BM; nwg = nM * nN; G = G_; c = c_; }
    __host__ __device__ bool next(int i, Unit& u) const {
        const long L = (long)i * G + c; if (L >= nwg) return false;
        int wgid = (int)L; { const int q = nwg / NXCD, r = nwg % NXCD, xcd = wgid % NXCD, off = wgid / NXCD; wgid = (xcd < r ? xcd * (q + 1) : r * (q + 1) + (xcd - r) * q) + off; }
        const int nig = WGM * nN, gid = wgid / nig, fm = gid * WGM, gsz = (nM - fm) < WGM ? (nM - fm) : WGM;
        u.pm = fm + ((wgid % nig) % gsz); u.pn = (wgid % nig) / gsz; return true;
    }
    __device__ __forceinline__ void a_ready(const Unit&) const {}
    __device__ __forceinline__ void done(const Unit&) const {}
};

__device__ __forceinline__ unsigned cvt_pk_bf16(float lo, float hi) { unsigned r; asm volatile("v_cvt_pk_bf16_f32 %0, %1, %2" : "=v"(r) : "v"(lo), "v"(hi)); return r; }

struct EpiF32 {
    static constexpr bool PERM = false, AFTER_DRAIN = false;
    float* C; int ldc;
    __device__ __forceinline__ void operator()(const f32x4 (&acc)[2][2][4][2], const Unit& u, int wr, int wc, int fr, int fq) const {
        const int row0 = u.pm * BM + wr * 64 + fr, col0 = u.pn * BM + wc * 32 + 4 * fq;
#pragma unroll
        for (int ai = 0; ai < 2; ++ai)
#pragma unroll
            for (int m = 0; m < 4; ++m) { float* rowp = C + (size_t)(row0 + ai * HALF + m * 16) * ldc + col0;
#pragma unroll
                for (int bj = 0; bj < 2; ++bj)
#pragma unroll
                    for (int n = 0; n < 2; ++n) *(f32x4*)(rowp + bj * HALF + n * 16) = acc[ai][bj][m][n]; }
    }
};
struct EpiSwiGLU {
    static constexpr bool PERM = true, AFTER_DRAIN = false;
    bf16_t* O; int ldc;
    __device__ __forceinline__ void operator()(const f32x4 (&acc)[2][2][4][2], const Unit& u, int wr, int wc, int fr, int fq) const {
        const int row0 = u.pm * BM + wr * 64 + fr, col0 = u.pn * HALF + wc * 32 + 8 * fq;
#pragma unroll
        for (int ai = 0; ai < 2; ++ai)
#pragma unroll
            for (int m = 0; m < 4; ++m) { bf16_t* rowp = O + (size_t)(row0 + ai * HALF + m * 16) * ldc + col0;
                float o[8];
#pragma unroll
                for (int n = 0; n < 2; ++n)
#pragma unroll
                    for (int e = 0; e < 4; ++e) { const float g = acc[ai][0][m][n][e], up = acc[ai][1][m][n][e];
                        const float sg = __builtin_amdgcn_rcpf(1.0f + __builtin_amdgcn_exp2f(-1.4426950408889634f * g)); o[n * 4 + e] = g * sg * up; }
                u32x4 w; w.x = cvt_pk_bf16(o[0], o[1]); w.y = cvt_pk_bf16(o[2], o[3]); w.z = cvt_pk_bf16(o[4], o[5]); w.w = cvt_pk_bf16(o[6], o[7]);
                *(u32x4*)rowp = w; }
    }
};


struct EpiBf16Split {
    static constexpr bool PERM = true, AFTER_DRAIN = false;
    bf16_t* O; size_t split_stride; float scale0;
    __device__ __forceinline__ void operator()(const f32x4 (&acc)[2][2][4][2], const Unit& u, int wr, int wc, int fr, int fq) const {
        const int row0 = u.pm * BM + wr * 64 + fr; const int t = (u.pn * BM) / 512; const int colt = u.pn * BM - t * 512;
        bf16_t* base = O + (size_t)t * split_stride; const int col0 = colt + wc * 32 + 8 * fq; const float sc = (t == 0) ? scale0 : 1.0f;
#pragma unroll
        for (int ai = 0; ai < 2; ++ai)
#pragma unroll
            for (int m = 0; m < 4; ++m) { bf16_t* rowp = base + (size_t)(row0 + ai * HALF + m * 16) * 512 + col0;
#pragma unroll
                for (int bj = 0; bj < 2; ++bj) { const f32x4 v0 = acc[ai][bj][m][0] * sc, v1 = acc[ai][bj][m][1] * sc;
                    u32x4 w; w.x = cvt_pk_bf16(v0[0], v0[1]); w.y = cvt_pk_bf16(v0[2], v0[3]); w.z = cvt_pk_bf16(v1[0], v1[1]); w.w = cvt_pk_bf16(v1[2], v1[3]);
                    *(u32x4*)(rowp + bj * HALF) = w; } }
    }
};
struct EpiGLU {
    static constexpr bool PERM = true, AFTER_DRAIN = false;
    const bf16_t* Y; bf16_t* Z; const float* bias;
    __device__ __forceinline__ void operator()(const f32x4 (&acc)[2][2][4][2], const Unit& u, int wr, int wc, int fr, int fq) const {
        const int row0 = u.pm * BM + wr * 64 + fr, col0 = u.pn * BM + wc * 32 + 8 * fq;
#pragma unroll
        for (int ai = 0; ai < 2; ++ai)
#pragma unroll
            for (int m = 0; m < 4; ++m) { const size_t ro = (size_t)(row0 + ai * HALF + m * 16) * 512 + col0;
#pragma unroll
                for (int bj = 0; bj < 2; ++bj) { const u32x4 yw = *(const u32x4*)(Y + ro + bj * HALF);
                    const f32x4 b0 = *(const f32x4*)(bias + col0 + bj * HALF), b1 = *(const f32x4*)(bias + col0 + bj * HALF + 4);
                    float o[8];
#pragma unroll
                    for (int e = 0; e < 8; ++e) { const float a = (e < 4 ? acc[ai][bj][m][0][e & 3] : acc[ai][bj][m][1][e & 3]) + (e < 4 ? b0[e & 3] : b1[e & 3]);
                        const unsigned yy = yw[e >> 1]; const float y = __uint_as_float((e & 1) ? (yy & 0xffff0000u) : (yy << 16));
                        o[e] = y * __builtin_amdgcn_rcpf(1.0f + __builtin_amdgcn_exp2f(-1.4426950408889634f * a)); }
                    u32x4 w; w.x = cvt_pk_bf16(o[0], o[1]); w.y = cvt_pk_bf16(o[2], o[3]); w.z = cvt_pk_bf16(o[4], o[5]); w.w = cvt_pk_bf16(o[6], o[7]);
                    *(u32x4*)(Z + ro + bj * HALF) = w; } }
    }
};

template <class Epi, class Sched, bool ALIGN_EPI = false, bool SP2 = false>
__device__ __forceinline__ void gemm_phase(PG8_LAS unsigned char* lds, const Gemm g, const Sched& S, const Epi& E) {
    int tid_ = threadIdx.x; asm volatile("" : "+v"(tid_));
    const int tid = tid_, wid = __builtin_amdgcn_readfirstlane(tid >> 6), lane = tid & 63, wr = wid >> 2, wc = wid & 3, fr = lane & 15, fq = lane >> 4;
    const int K = g.K, nt = K / BK;
    unsigned voffA[2], voffB[2];
#pragma unroll
    for (int i = 0; i < 2; ++i) { int R, C; stage_rc(tid * 16 + i * 8192, R, C); const int Rb = Epi::PERM ? ((R & ~31) + perm32(R & 31)) : R;
        voffA[i] = (unsigned)(R * K + C) * 2u; voffB[i] = (unsigned)(Rb * K + C) * 2u; }
    const size_t kstep = (size_t)(BK * 2);
    const size_t hstep = (size_t)HALF * K * 2;
    const size_t tstep = 2 * hstep;
    const unsigned ldsw = (unsigned)wid * 1024u;
    const int aoff = lds_byte(wr * 64 + fr, fq * 8), boff = lds_byte(wc * 32 + fr, fq * 8);
#define PG8_SA(b, h) (((b) * 2 + (h)) * HTB)
#define PG8_SB(b, h) ((4 + (b) * 2 + (h)) * HTB)
#define PG8_STAGE(bufoff, gbase, voff) do { _Pragma("unroll") for (int _i = 0; _i < 2; ++_i) \
        __builtin_amdgcn_global_load_lds((const unsigned*)((const char*)(gbase) + (voff)[_i]), (PG8_LAS unsigned*)(lds + (bufoff) + ldsw + _i * 8192), 16, 0, 0); } while (0)
#define PG8_LDA(dst, b, h) do { _Pragma("unroll") for (int m = 0; m < 4; ++m) _Pragma("unroll") for (int k = 0; k < 2; ++k) dst[m][k] = *(const PG8_LAS bf16x8*)(lds + PG8_SA(b, h) + aoff + m * 2048 + k * 1024); } while (0)
#define PG8_LDB(dst, b, h) do { _Pragma("unroll") for (int n = 0; n < 2; ++n) _Pragma("unroll") for (int k = 0; k < 2; ++k) dst[n][k] = *(const PG8_LAS bf16x8*)(lds + PG8_SB(b, h) + boff + n * 2048 + k * 1024); } while (0)
#define PG8_MMA(ai, bj, At, Bt) do { __builtin_amdgcn_s_setprio(1); _Pragma("unroll") for (int m = 0; m < 4; ++m) _Pragma("unroll") for (int n = 0; n < 2; ++n) _Pragma("unroll") for (int k = 0; k < 2; ++k) \
        acc[ai][bj][m][n] = __builtin_amdgcn_mfma_f32_16x16x32_bf16(Bt[n][k], At[m][k], acc[ai][bj][m][n], 0, 0, 0); __builtin_amdgcn_s_setprio(0); } while (0)
#define PG8_WAIT_V(n) asm volatile("s_waitcnt vmcnt(" #n ")" ::: "memory")
#define PG8_WAIT_L(n) asm volatile("s_waitcnt lgkmcnt(" #n ")" ::: "memory")
#define PG8_BAR __builtin_amdgcn_s_barrier()
#define PG8_SCHED __builtin_amdgcn_sched_barrier(0)
    Unit cur, nxt; int ui = 0;
    if (!S.next(0, cur)) return;
    f32x4 acc[2][2][4][2];
#pragma unroll
    for (int a = 0; a < 2; ++a)
#pragma unroll
        for (int b = 0; b < 2; ++b)
#pragma unroll
            for (int m = 0; m < 4; ++m)
#pragma unroll
                for (int n = 0; n < 2; ++n) acc[a][b][m][n] = (f32x4){0.f, 0.f, 0.f, 0.f};
    bf16x8 At[4][2], B0[2][2], B1[2][2];
    const char* cA = (const char*)g.A + (size_t)cur.pm * tstep; const char* cB = (const char*)g.Bt + (size_t)cur.pn * tstep;
    S.a_ready(cur);
    if constexpr (SP2) {
        PG8_STAGE(PG8_SB(0, 0), cB, voffB); PG8_STAGE(PG8_SB(0, 1), cB + hstep, voffB); PG8_STAGE(PG8_SA(0, 0), cA, voffA); PG8_STAGE(PG8_SA(0, 1), cA + hstep, voffA);
        if (wr == 1) PG8_BAR;
        PG8_WAIT_V(2); PG8_BAR;
        PG8_STAGE(PG8_SB(1, 0), cB + kstep, voffB); PG8_STAGE(PG8_SA(1, 0), cA + kstep, voffA); PG8_STAGE(PG8_SB(1, 1), cB + hstep + kstep, voffB);
        PG8_WAIT_V(6); PG8_BAR;
    } else {
        PG8_STAGE(PG8_SB(0, 0), cB, voffB); PG8_STAGE(PG8_SA(0, 0), cA, voffA); PG8_STAGE(PG8_SB(0, 1), cB + hstep, voffB); PG8_STAGE(PG8_SA(0, 1), cA + hstep, voffA);
        if (wr == 1) PG8_BAR;
        PG8_WAIT_V(4); PG8_BAR;
        PG8_STAGE(PG8_SB(1, 0), cB + kstep, voffB); PG8_STAGE(PG8_SA(1, 0), cA + kstep, voffA); PG8_STAGE(PG8_SB(1, 1), cB + hstep + kstep, voffB);
        PG8_WAIT_V(6); PG8_BAR;
    }
    for (;;) {
        const bool has_next = S.next(ui + 1, nxt);
        const char* nA = has_next ? (const char*)g.A + (size_t)nxt.pm * tstep : cA; const char* nB = has_next ? (const char*)g.Bt + (size_t)nxt.pn * tstep : cB;
        for (int t = 0; t < nt; t += 2) {
            const bool last = (t == nt - 2);
            const char* a1 = cA + (size_t)(t + 1) * kstep;
            const char* a2 = last ? nA : cA + (size_t)(t + 2) * kstep; const char* b2 = last ? nB : cB + (size_t)(t + 2) * kstep;
            const char* a3 = a2 + kstep; const char* b3 = b2 + kstep;
            if (last && has_next) S.a_ready(nxt);
            if constexpr (SP2) {
            PG8_LDB(B0, 0, 0); PG8_LDB(B1, 0, 1); PG8_SCHED; PG8_LDA(At, 0, 0); PG8_STAGE(PG8_SA(1, 1), a1 + hstep, voffA);
            PG8_WAIT_V(8); PG8_WAIT_L(0); PG8_BAR; PG8_MMA(0, 0, At, B0); PG8_MMA(0, 1, At, B1); PG8_BAR; PG8_SCHED;
            PG8_LDA(At, 0, 1); PG8_STAGE(PG8_SB(0, 0), b2, voffB); PG8_STAGE(PG8_SB(0, 1), b2 + hstep, voffB); PG8_STAGE(PG8_SA(0, 0), a2, voffA);
            PG8_WAIT_V(8); PG8_WAIT_L(0); PG8_BAR; PG8_MMA(1, 0, At, B0); PG8_MMA(1, 1, At, B1); PG8_BAR; PG8_SCHED;
            PG8_LDB(B0, 1, 0); PG8_LDB(B1, 1, 1); PG8_SCHED; PG8_LDA(At, 1, 0); PG8_STAGE(PG8_SA(0, 1), a2 + hstep, voffA);
            PG8_WAIT_V(8); PG8_WAIT_L(0); PG8_BAR; PG8_MMA(0, 0, At, B0); PG8_MMA(0, 1, At, B1); PG8_BAR; PG8_SCHED;
            PG8_LDA(At, 1, 1); PG8_STAGE(PG8_SB(1, 0), b3, voffB); PG8_STAGE(PG8_SB(1, 1), b3 + hstep, voffB); PG8_STAGE(PG8_SA(1, 0), a3, voffA);
            PG8_WAIT_V(8); PG8_WAIT_L(0); PG8_BAR; PG8_MMA(1, 0, At, B0); PG8_MMA(1, 1, At, B1); PG8_BAR; PG8_SCHED;
            } else {
            PG8_LDB(B0, 0, 0); PG8_SCHED; PG8_LDA(At, 0, 0); PG8_STAGE(PG8_SA(1, 1), a1 + hstep, voffA);
            PG8_WAIT_L(8); PG8_BAR; PG8_WAIT_L(0); PG8_MMA(0, 0, At, B0); PG8_BAR; PG8_SCHED;
            PG8_LDB(B1, 0, 1); PG8_STAGE(PG8_SB(0, 0), b2, voffB);
            PG8_BAR; PG8_WAIT_L(0); PG8_MMA(0, 1, At, B1); PG8_BAR;
            PG8_LDA(At, 0, 1); PG8_STAGE(PG8_SA(0, 0), a2, voffA);
            PG8_BAR; PG8_WAIT_L(0); PG8_MMA(1, 0, At, B0); PG8_BAR; PG8_SCHED;
            PG8_STAGE(PG8_SB(0, 1), b2 + hstep, voffB);
            PG8_WAIT_V(6); PG8_BAR; PG8_MMA(1, 1, At, B1); PG8_BAR;
            PG8_LDB(B0, 1, 0); PG8_SCHED; PG8_LDA(At, 1, 0); PG8_STAGE(PG8_SA(0, 1), a2 + hstep, voffA);
            PG8_WAIT_L(8); PG8_BAR; PG8_WAIT_L(0); PG8_MMA(0, 0, At, B0); PG8_BAR; PG8_SCHED;
            PG8_LDB(B1, 1, 1); PG8_STAGE(PG8_SB(1, 0), b3, voffB);
            PG8_BAR; PG8_WAIT_L(0); PG8_MMA(0, 1, At, B1); PG8_BAR;
            PG8_LDA(At, 1, 1); PG8_STAGE(PG8_SA(1, 0), a3, voffA);
            PG8_BAR; PG8_WAIT_L(0); PG8_MMA(1, 0, At, B0); PG8_BAR; PG8_SCHED;
            PG8_STAGE(PG8_SB(1, 1), b3 + hstep, voffB);
            PG8_WAIT_V(6); PG8_BAR; PG8_MMA(1, 1, At, B1); PG8_BAR;
            }
        }
        if constexpr (ALIGN_EPI) { if (wr == 0) PG8_BAR; }
        if constexpr (!Epi::AFTER_DRAIN) { E(acc, cur, wr, wc, fr, fq); S.done(cur); }
        if (!has_next) break;
#pragma unroll
        for (int a = 0; a < 2; ++a)
#pragma unroll
            for (int b = 0; b < 2; ++b)
#pragma unroll
                for (int m = 0; m < 4; ++m)
#pragma unroll
                    for (int n = 0; n < 2; ++n) acc[a][b][m][n] = (f32x4){0.f, 0.f, 0.f, 0.f};
        cur = nxt; cA = nA; cB = nB; ++ui;
        if constexpr (ALIGN_EPI) { if (wr == 1) PG8_BAR; }
    }
    PG8_WAIT_V(0);
    if constexpr (!ALIGN_EPI) { if (wr == 0) PG8_BAR; }
    PG8_BAR;
    if constexpr (Epi::AFTER_DRAIN) { E.fused(acc, cur, wr, wc, fr, fq, lds, wid, lane); S.done(cur); }
#undef PG8_SA
#undef PG8_SB
#undef PG8_STAGE
#undef PG8_LDA
#undef PG8_LDB
#undef PG8_MMA
#undef PG8_WAIT_V
#undef PG8_WAIT_L
#undef PG8_BAR
#undef PG8_SCHED
}
}

constexpr bool PG8_SP2 = true, PG8_ALIGN = true;

#define GAS __attribute__((address_space(1)))
#define LAS __attribute__((address_space(3)))
#define XB_TMO      128
#define XB_XCNT(j)  (256  + 64 * (j))
#define XB_XSUB(j)  (1280 + 64 * (j))
#define XB_XGEN(j)  (2304 + 64 * (j))
#define XB_TOP      3328
#define XB_TOPGEN   3392
#define XCD_BAR_WORDS 3456
#define XB_SPIN_CAP (1u << 22)
__device__ __forceinline__ unsigned xb_ld(unsigned* p)              { return __hip_atomic_load(p, __ATOMIC_RELAXED, __HIP_MEMORY_SCOPE_AGENT); }
__device__ __forceinline__ unsigned xb_add(unsigned* p, unsigned v) { return __hip_atomic_fetch_add(p, v, __ATOMIC_RELAXED, __HIP_MEMORY_SCOPE_AGENT); }
__device__ __forceinline__ unsigned xb_xcc_id() { return (unsigned)__builtin_amdgcn_s_getreg((3 << 11) | 20) & 0xFu; }
#define XB_SPIN(cond, bar) do { unsigned _sp = 0; while (cond) { __builtin_amdgcn_s_sleep(1); \
    if ((++_sp & 255u) == 0u) { if (xb_ld(&(bar)[XB_TMO])) break; if (_sp > XB_SPIN_CAP) { atomicAdd(&(bar)[XB_TMO], 1u); break; } } } } while (0)
struct XcdBarrier { unsigned* bar; unsigned x; volatile LAS unsigned* st; };
__device__ __forceinline__ XcdBarrier xcd_barrier_post(unsigned* bar, volatile LAS unsigned* st) {
    XcdBarrier b; b.bar = bar; b.x = xb_xcc_id(); b.st = st;
    if (threadIdx.x == 0) (void)xb_add(&bar[XB_XCNT(b.x)], 1u);
    return b;
}
__device__ __forceinline__ void xcd_barrier_complete(unsigned* bar, unsigned x, unsigned& nloc, unsigned& nx) {
    const unsigned G = gridDim.x * gridDim.y * gridDim.z;
    unsigned sum, cnt, mine, sp = 0u;
    for (;;) {
        sum = 0u; cnt = 0u; mine = 0u;
#pragma unroll
        for (unsigned j = 0; j < 16; ++j) { const unsigned c = xb_ld(&bar[XB_XCNT(j)]); sum += c; cnt += (c > 0u) ? 1u : 0u; mine = (j == x) ? c : mine; }
        if (sum == G) break;
        __builtin_amdgcn_s_sleep(1);
        if ((++sp & 255u) == 0u) { if (xb_ld(&bar[XB_TMO])) break; if (sp > XB_SPIN_CAP) { atomicAdd(&bar[XB_TMO], 1u); break; } }
    }
    nloc = mine > 0u ? mine : 1u; nx = cnt > 0u ? cnt : 1u;
}
__device__ __forceinline__ void xcd_barrier(const XcdBarrier& b) {
    asm volatile("s_waitcnt vmcnt(0)" ::: "memory");
    __syncthreads();
    if (threadIdx.x == 0) {
        unsigned* bar = b.bar;
        __builtin_amdgcn_s_waitcnt(0);
        unsigned nloc = b.st[0], nx = b.st[1];
        if (nloc == 0u) { xcd_barrier_complete(bar, b.x, nloc, nx); b.st[0] = nloc; b.st[1] = nx; }
        const unsigned old = xb_add(&bar[XB_XSUB(b.x)], 1u);
        const unsigned gen = old / nloc;
        if (old + 1u == (gen + 1u) * nloc) {
            __builtin_amdgcn_fence(__ATOMIC_RELEASE, "agent");
            asm volatile("s_waitcnt vmcnt(0)" ::: "memory");
            const unsigned og = xb_add(&bar[XB_TOP], 1u);
            const unsigned tg = og / nx;
            if (og + 1u == (tg + 1u) * nx) xb_add(&bar[XB_TOPGEN], 1u);
            else XB_SPIN(xb_ld(&bar[XB_TOPGEN]) == tg, bar);
            __builtin_amdgcn_fence(__ATOMIC_ACQUIRE, "agent");
            xb_add(&bar[XB_XGEN(b.x)], 1u);
            asm volatile("s_waitcnt vmcnt(0)" ::: "memory");
        } else {
            XB_SPIN(xb_ld(&bar[XB_XGEN(b.x)]) == gen, bar);
            __builtin_amdgcn_fence(__ATOMIC_ACQUIRE, "agent");
            asm volatile("s_waitcnt vmcnt(0)" ::: "memory");
        }
    }
    __syncthreads();
}
__device__ __forceinline__ unsigned f2bf(float f) { unsigned u = __builtin_bit_cast(unsigned, f); return (u + 0x7fffu + ((u >> 16) & 1u)) >> 16; }
__device__ __forceinline__ unsigned pk2(float lo, float hi) { return f2bf(lo) | (f2bf(hi) << 16); }
__device__ __forceinline__ float wave_sum(float v) {
#pragma unroll
    for (int o = 1; o < 64; o <<= 1) v += __shfl_xor(v, o);
    return v;
}

__device__ void nv_rms(const float* in, int ldin, const float* g, int ncols, int nrows, const float* base, int ldbase, float alpha, float* out, int ldout, int bid, int nblk) {
    const int lane = threadIdx.x & 63, wave = threadIdx.x >> 6, nw = blockDim.x >> 6;
    for (int r = bid * nw + wave; r < nrows; r += nblk * nw) {
        const float* ir = in + (size_t)r * ldin;
        float s = 0.f;
        for (int c = lane * 4; c < ncols; c += 256) { const float4 v = *(const float4*)(ir + c); s += v.x * v.x + v.y * v.y + v.z * v.z + v.w * v.w; }
        s = wave_sum(s);
        const float rs = 1.0f / sqrtf(s / (float)ncols + RMS_EPS);
        for (int c = lane * 4; c < ncols; c += 256) {
            const float4 v = *(const float4*)(ir + c); const float4 gg = *(const float4*)(g + c);
            float4 b = make_float4(0.f, 0.f, 0.f, 0.f); if (base) b = *(const float4*)(base + (size_t)r * ldbase + c);
            float4 o; o.x = b.x + alpha * (v.x * rs * gg.x); o.y = b.y + alpha * (v.y * rs * gg.y); o.z = b.z + alpha * (v.z * rs * gg.z); o.w = b.w + alpha * (v.w * rs * gg.w);
            *(float4*)(out + (size_t)r * ldout + c) = o;
        }
    }
}

template <int MODE>
__device__ void nv_gemm(const float* A, int lda, const float* B, const float* B2, int ldb, float* C, int ldc, int M, int N, int K, const float* bias, float* smem, int bid, int nblk) {
    float* As = smem;
    float* Bs = smem + 16 * 132;
    float* B2s = Bs + 16 * 64;
    const int t = threadIdx.x, ty = t >> 4, tx = t & 15;
    const int ntm = M / 128, ntn = N / 64;
    for (int tile = bid; tile < ntm * ntn; tile += nblk) {
        const int tm = tile / ntn, tn = tile % ntn, m0 = tm * 128, n0 = tn * 64;
        float acc[4][4], acc2[4][4];
#pragma unroll
        for (int i = 0; i < 4; ++i)
#pragma unroll
            for (int j = 0; j < 4; ++j) { acc[i][j] = 0.f; acc2[i][j] = 0.f; }
        for (int k0 = 0; k0 < K; k0 += 16) {
            {
                const int r = t >> 2, kc = (t & 3) * 4;
                const float4 v = *(const float4*)(A + (size_t)(m0 + r) * lda + k0 + kc);
                As[(kc + 0) * 132 + r] = v.x; As[(kc + 1) * 132 + r] = v.y; As[(kc + 2) * 132 + r] = v.z; As[(kc + 3) * 132 + r] = v.w;
            }
            {
                const int kr = t >> 5, c2 = (t & 31) * 2;
                const float2 v = *(const float2*)(B + (size_t)(k0 + kr) * ldb + n0 + c2);
                Bs[kr * 64 + c2] = v.x; Bs[kr * 64 + c2 + 1] = v.y;
                if (MODE == 1) { const float2 w = *(const float2*)(B2 + (size_t)(k0 + kr) * ldb + n0 + c2); B2s[kr * 64 + c2] = w.x; B2s[kr * 64 + c2 + 1] = w.y; }
            }
            __syncthreads();
#pragma unroll
            for (int kk = 0; kk < 16; ++kk) {
                const float4 a = *(const float4*)(As + kk * 132 + ty * 4);
                const float4 b = *(const float4*)(Bs + kk * 64 + tx * 4);
                const float av[4] = {a.x, a.y, a.z, a.w}, bv[4] = {b.x, b.y, b.z, b.w};
#pragma unroll
                for (int i = 0; i < 4; ++i)
#pragma unroll
                    for (int j = 0; j < 4; ++j) acc[i][j] += av[i] * bv[j];
                if (MODE == 1) {
                    const float4 b2 = *(const float4*)(B2s + kk * 64 + tx * 4);
                    const float b2v[4] = {b2.x, b2.y, b2.z, b2.w};
#pragma unroll
                    for (int i = 0; i < 4; ++i)
#pragma unroll
                        for (int j = 0; j < 4; ++j) acc2[i][j] += av[i] * b2v[j];
                }
            }
            __syncthreads();
        }
#pragma unroll
        for (int i = 0; i < 4; ++i) {
            const int r = m0 + ty * 4 + i, c = n0 + tx * 4;
            float o[4];
#pragma unroll
            for (int j = 0; j < 4; ++j) {
                float v = acc[i][j];
                if (MODE == 1) { const float sg = 1.0f / (1.0f + expf(-v)); v = v * sg * acc2[i][j]; }
                if (MODE == 2) { const float zz = v + bias[c + j]; const float sg = 1.0f / (1.0f + expf(-zz)); v = A[(size_t)r * lda + c + j] * sg; }
                o[j] = v;
            }
            *(float4*)(C + (size_t)r * ldc + c) = make_float4(o[0], o[1], o[2], o[3]);
        }
    }
}

__device__ __forceinline__ float bf2f(unsigned short b) { return __uint_as_float((unsigned)b << 16); }
__device__ void nv_kmean(const unsigned short* k, int ldk, float* kmean, int bid, int nblk) {
    for (int idx = bid * blockDim.x + threadIdx.x; idx < BATCH * NBLK * D_ATTN; idx += nblk * blockDim.x) {
        const int c = idx % D_ATTN, bn = idx / D_ATTN;
        const unsigned short* p = k + (size_t)bn * MOBA_L * ldk + c;
        float s = 0.f;
        for (int r = 0; r < MOBA_L; ++r) s += bf2f(p[(size_t)r * ldk]);
        kmean[idx] = s * (1.0f / MOBA_L);
    }
}

__device__ void nv_attn(const unsigned short* q, const unsigned short* k, const unsigned short* v, int ld, const float* kmean, unsigned short* out, int ldo, int bid, int nblk) {
    const int lane = threadIdx.x & 63, wave = threadIdx.x >> 6, nw = blockDim.x >> 6;
    const int nwu = BATCH * NH * (SEQ / 64);
    for (int wu = bid * nw + wave; wu < nwu; wu += nblk * nw) {
        const int wuu = __builtin_amdgcn_readfirstlane(wu);
        const int tc = wuu % (SEQ / 64), bh = wuu / (SEQ / 64), h = bh % NH, b = bh / NH;
        const int t = tc * 64 + lane, qb = (tc * 64) / MOBA_L;
        const float slope = exp2f(-(float)(h + 1));
        float qv[HD];
        const unsigned short* qp = q + (size_t)(b * SEQ + t) * ld + h * HD;
#pragma unroll
        for (int d = 0; d < HD; ++d) qv[d] = bf2f(qp[d]);
        float gate[NBLK];
#pragma unroll
        for (int n = 0; n < NBLK; ++n) {
            gate[n] = -1e30f;
            if (n < qb) { const float* km = kmean + (size_t)(b * NBLK + n) * D_ATTN + h * HD; float s = 0.f;
#pragma unroll
                for (int d = 0; d < HD; ++d) s += qv[d] * km[d];
                gate[n] = s; }
        }
        unsigned selmask = 0u;
#pragma unroll
        for (int n = 0; n < NBLK; ++n) {
            int rank = 0;
#pragma unroll
            for (int m2 = 0; m2 < NBLK; ++m2) { if (m2 < qb && (gate[m2] > gate[n] || (gate[m2] == gate[n] && m2 < n))) ++rank; }
            if (n < qb && rank < 3) selmask |= (1u << n);
        }
        float mrun = -INFINITY, lrun = 0.f, o[HD];
#pragma unroll
        for (int d = 0; d < HD; ++d) o[d] = 0.f;
        for (int n = 0; n <= qb; ++n) {
            const bool sel = (n == qb) || ((selmask >> n) & 1u);
            if (!__any(sel)) continue;
            for (int j = 0; j < MOBA_L; ++j) {
                const int kp = n * MOBA_L + j;
                const unsigned short* kr = k + (size_t)(b * SEQ + kp) * ld + h * HD;
                const unsigned short* vr = v + (size_t)(b * SEQ + kp) * ld + h * HD;
                float s = 0.f;
#pragma unroll
                for (int d = 0; d < HD; ++d) s += qv[d] * bf2f(kr[d]);
                s = s * 0.125f - slope * (float)(t - kp);
                const bool valid = sel && (kp <= t);
                if (valid) {
                    const float mn = fmaxf(mrun, s), corr = expf(mrun - mn), p = expf(s - mn);
                    lrun = lrun * corr + p;
#pragma unroll
                    for (int d = 0; d < HD; ++d) o[d] = o[d] * corr + p * bf2f(vr[d]);
                    mrun = mn;
                }
            }
        }
        const float inv = 1.0f / lrun;
        unsigned short* op = out + (size_t)(b * SEQ + t) * ldo + h * HD;
#pragma unroll
        for (int d = 0; d < HD; d += 2) *(unsigned*)(op + d) = pk2(o[d] * inv, o[d + 1] * inv);
    }
}

__device__ __forceinline__ float gelu_tanh(float x) { const float u = 0.7978845608028654f * (x + 0.044715f * x * x * x); return 0.5f * x * (1.0f + tanhf(u)); }

__device__ void nv_ssm(const unsigned short* us, int ldu, const float* lam_re, const float* lam_im, const float* log_dt, const float* b_re, const float* b_im,
                       const float* c_re, const float* c_im, const float* d_skip, unsigned short* yout, int ldy, int bid, int nblk) {
    const int lane = threadIdx.x & 63, wave = threadIdx.x >> 6, nw = blockDim.x >> 6;
    for (int wu = bid * nw + wave; wu < BATCH * NG; wu += nblk * nw) {
        const int wuu = __builtin_amdgcn_readfirstlane(wu);
        const int g = wuu % NG, b = wuu / NG, p = lane;
        const double lr = (double)lam_re[g * SSM_P + p], li = (double)lam_im[g * SSM_P + p], dt = exp((double)log_dt[g]);
        const double mag = exp(lr * dt), ang = li * dt, are = mag * cos(ang), aim = mag * sin(ang), den = lr * lr + li * li;
        const double fre = ((are - 1.0) * lr + aim * li) / den, fim = (aim * lr - (are - 1.0) * li) / den;
        const float a_re = (float)are, a_im = (float)aim;
        float bbr[SSM_GROUP], bbi[SSM_GROUP], cr[SSM_GROUP], ci[SSM_GROUP];
#pragma unroll
        for (int h = 0; h < SSM_GROUP; ++h) {
            const double br = (double)b_re[(g * SSM_P + p) * SSM_GROUP + h], bi = (double)b_im[(g * SSM_P + p) * SSM_GROUP + h];
            bbr[h] = (float)(fre * br - fim * bi); bbi[h] = (float)(fre * bi + fim * br);
            cr[h] = c_re[(g * SSM_GROUP + h) * SSM_P + p]; ci[h] = c_im[(g * SSM_GROUP + h) * SSM_P + p];
        }
        const float dsk = (lane < SSM_GROUP) ? d_skip[g * SSM_GROUP + lane] : 0.f;
        float hre = 0.f, him = 0.f;
        for (int t = 0; t < SEQ; ++t) {
            const unsigned short* up = us + (size_t)(b * SEQ + t) * ldu + g * SSM_GROUP;
            float xr = 0.f, xi = 0.f, uu[SSM_GROUP];
#pragma unroll
            for (int h = 0; h < SSM_GROUP; ++h) { uu[h] = bf2f(up[h]); xr += uu[h] * bbr[h]; xi += uu[h] * bbi[h]; }
            const float nre = a_re * hre - a_im * him + xr, nim = a_re * him + a_im * hre + xi;
            hre = nre; him = nim;
            float mine = 0.f, myu = 0.f;
#pragma unroll
            for (int h = 0; h < SSM_GROUP; ++h) { const float tot = wave_sum(hre * cr[h] - him * ci[h]); if (lane == h) { mine = tot; myu = uu[h]; } }
            if (lane < SSM_GROUP) { const float y = mine + dsk * myu; yout[(size_t)(b * SEQ + t) * ldy + g * SSM_GROUP + lane] = (unsigned short)f2bf(gelu_tanh(y)); }
        }
    }
}


#include <hip/hip_bf16.h>
#include <cmath>
namespace attn_body {
using bf16=__hip_bfloat16;
using bf16x8=__attribute__((ext_vector_type(8)))short;
using s16x4=__attribute__((ext_vector_type(4)))short;
using f32x16=__attribute__((ext_vector_type(16)))float;
using u32x4=__attribute__((ext_vector_type(4)))unsigned;
constexpr int BATCH=8,NHEAD=8,SEQ=2048,D=64,DM=NHEAD*D;
constexpr int NW=8,QBLK=32,QB=QBLK*NW,KVBLK=64,NQB=SEQ/QB;
constexpr int ATTN_PITCH=DM, ATTN_UNIT_ROWS=QB;
__device__ __forceinline__ int crow(int r,int hi){return (r&3)+8*(r>>2)+4*hi;}
#define SBAR() __builtin_amdgcn_sched_barrier(0)
__device__ __forceinline__ void cmask(f32x16&p0,f32x16&p1,int jb,int qrel,int hi){
  const float NEG=-INFINITY; int kb=64*jb+4*hi;
  #pragma unroll
  for(int r=0;r<16;++r){int kv=kb+(r&3)+8*(r>>2); if(kv>qrel)p0[r]=NEG; if(kv+32>qrel)p1[r]=NEG;}
}

constexpr int NSLOT=3, SLOTB=8192;
constexpr int LDS_K=0, LDS_V=NSLOT*SLOTB, LDS_WS=2*NSLOT*SLOTB, LDS_OST=LDS_WS+NW*64*4, LDS_BYTES=LDS_OST+NW*4096;
constexpr float C2=0.125f*1.4426950408889634f;
__device__ __forceinline__ void glds16(const void*gsrc,unsigned lds_dst){unsigned keep;
  asm volatile("s_mov_b32 %0, m0\n\ts_mov_b32 m0, %2\n\ts_nop 0\n\tglobal_load_lds_dwordx4 %1, off\n\ts_mov_b32 m0, %0":"=&s"(keep):"v"(gsrc),"s"(lds_dst):"memory");}
__device__ __forceinline__ float max3f(float a,float b,float c){float r;asm("v_max3_f32 %0, %1, %2, %3":"=v"(r):"v"(a),"v"(b),"v"(c));return r;}
__device__ __forceinline__ float max2f(float a,float b){float r;asm("v_max_f32_e32 %0, %1, %2":"=v"(r):"v"(a),"v"(b));return r;}
__device__ __forceinline__ float fadd_s(float a,float b){float r;asm("v_add_f32_e32 %0, %1, %2":"=v"(r):"v"(a),"v"(b));return r;}
__device__ __forceinline__ float fsub_s(float a,float b){float r;asm("v_sub_f32_e32 %0, %1, %2":"=v"(r):"v"(a),"v"(b));return r;}
typedef float f32x2_t __attribute__((ext_vector_type(2))); typedef __bf16 bf16x2_t __attribute__((ext_vector_type(2)));
__device__ __forceinline__ unsigned cvtpk_s(float lo,float hi){f32x2_t v={lo,hi};bf16x2_t b=__builtin_convertvector(v,bf16x2_t);return __builtin_bit_cast(unsigned,b);}
#define WAIT_BAR(N) asm volatile("s_waitcnt vmcnt(" #N ") lgkmcnt(0)\n\ts_barrier":::"memory")

__device__ __forceinline__ void qkt(f32x16&p0,f32x16&p1,const char*Kslot,const bf16x8*qr,int r32,int hi,bf16x8 ka0,bf16x8 ka1,bf16x8 qa){ const f32x16 negm=f32x16{};
  const char*kb=Kslot+hi*1024+r32*16;
  #pragma unroll
  for(int d0=0;d0<4;++d0){
    const bf16x8 b0=*reinterpret_cast<const bf16x8*>(kb+d0*2048);
    const bf16x8 b1=*reinterpret_cast<const bf16x8*>(kb+d0*2048+512);
    if(d0==0){p0=__builtin_amdgcn_mfma_f32_32x32x16_bf16(b0,qr[0],negm,0,0,0);p1=__builtin_amdgcn_mfma_f32_32x32x16_bf16(b1,qr[0],negm,0,0,0);}
    else{p0=__builtin_amdgcn_mfma_f32_32x32x16_bf16(b0,qr[d0],p0,0,0,0);p1=__builtin_amdgcn_mfma_f32_32x32x16_bf16(b1,qr[d0],p1,0,0,0);}}
  p0=__builtin_amdgcn_mfma_f32_32x32x16_bf16(ka0,qa,p0,0,0,0);p1=__builtin_amdgcn_mfma_f32_32x32x16_bf16(ka1,qa,p1,0,0,0);
}
typedef __attribute__((address_space(3))) const char* lds_cptr;
typedef short v4i16_t __attribute__((ext_vector_type(4)));
__device__ __forceinline__ void kload8(bf16x8*kf,lds_cptr kp){
  kf[0]=*(const __attribute__((address_space(3))) bf16x8*)(kp);      kf[1]=*(const __attribute__((address_space(3))) bf16x8*)(kp+512);
  kf[2]=*(const __attribute__((address_space(3))) bf16x8*)(kp+2048); kf[3]=*(const __attribute__((address_space(3))) bf16x8*)(kp+2560);
  kf[4]=*(const __attribute__((address_space(3))) bf16x8*)(kp+4096); kf[5]=*(const __attribute__((address_space(3))) bf16x8*)(kp+4608);
  kf[6]=*(const __attribute__((address_space(3))) bf16x8*)(kp+6144); kf[7]=*(const __attribute__((address_space(3))) bf16x8*)(kp+6656);
}
__device__ __forceinline__ void kload2(bf16x8*kf,lds_cptr kp,int j){ kf[2*j]=*(const __attribute__((address_space(3))) bf16x8*)(kp+j*2048); kf[2*j+1]=*(const __attribute__((address_space(3))) bf16x8*)(kp+j*2048+512); }
__device__ __forceinline__ s16x4 vtr(lds_cptr p){ return __builtin_bit_cast(s16x4,__builtin_amdgcn_ds_read_tr16_b64_v4i16((__attribute__((address_space(3))) v4i16_t*)p)); }
__device__ __forceinline__ float rowmax(const f32x16&p0,const f32x16&p1){
  float a=max3f(p0[0],p0[1],p1[0]),b=max3f(p0[2],p0[3],p1[1]);a=max3f(a,p1[2],p1[3]);
  #pragma unroll
  for(int r=4;r<16;r+=4){a=max3f(a,p0[r],p0[r+1]);b=max3f(b,p0[r+2],p0[r+3]);a=max3f(a,p1[r],p1[r+1]);b=max3f(b,p1[r+2],p1[r+3]);}
  const float m=max2f(a,b);
  auto rr=__builtin_amdgcn_permlane32_swap(__float_as_uint(m),__float_as_uint(m),false,false);
  return max2f(__uint_as_float(rr[0]),__uint_as_float(rr[1]));
}
__device__ __forceinline__ void pv(f32x16*o,int vb,bf16x8 pa0,bf16x8 pa1,bf16x8 pa2,bf16x8 pa3){
  #pragma unroll
  for(int d0=0;d0<2;++d0){s16x4 lo[4],hi[4];
    #pragma unroll
    for(int ks=0;ks<4;++ks){
      asm volatile("ds_read_b64_tr_b16 %0,%1 offset:%c2":"=&v"(lo[ks]):"v"(vb),"i"(d0*4096+ks*1024):"memory");
      asm volatile("ds_read_b64_tr_b16 %0,%1 offset:%c2":"=&v"(hi[ks]):"v"(vb),"i"(d0*4096+ks*1024+512):"memory");}
    asm volatile("s_waitcnt lgkmcnt(0)":::"memory");SBAR();
    #define PK(k) (bf16x8){lo[k][0],lo[k][1],lo[k][2],lo[k][3],hi[k][0],hi[k][1],hi[k][2],hi[k][3]}
    o[d0]=__builtin_amdgcn_mfma_f32_32x32x16_bf16(pa0,PK(0),o[d0],0,0,0);
    o[d0]=__builtin_amdgcn_mfma_f32_32x32x16_bf16(pa1,PK(1),o[d0],0,0,0);
    o[d0]=__builtin_amdgcn_mfma_f32_32x32x16_bf16(pa2,PK(2),o[d0],0,0,0);
    o[d0]=__builtin_amdgcn_mfma_f32_32x32x16_bf16(pa3,PK(3),o[d0],0,0,0);
    #undef PK
  }
}

#ifndef ATTN_STORE16
#define ATTN_STORE16(p,v) (*(u32x4*)(p)=(v))
#endif
__device__ __forceinline__ unsigned bfr(float x){ const unsigned u=__float_as_uint(x); return (u+0x7fffu+((u>>16)&1u))>>16; }
template<int THRL> __device__ __forceinline__ void attn_unit(int b,int h,int qb,const bf16*Q,const bf16*__restrict__ K,const bf16*__restrict__ V,bf16*O,const float*kmean,char*shm){
  int tid_=threadIdx.x; asm volatile("":"+v"(tid_)); const int tid=tid_,lane=tid&63,r32=lane&31,hi=lane>>5; const int wid=__builtin_amdgcn_readfirstlane(tid>>6);
  const long rowbase=(long)b*SEQ; const int q0=qb*QB;
  const bf16*Qw=Q+(rowbase+q0+wid*QBLK)*DM+h*D;
  const bf16*Kh=K+rowbase*DM+h*D,*Vh=V+rowbase*DM+h*D;
  const unsigned lds0=(unsigned)(uintptr_t)shm;
  float*wsf=(float*)(shm+LDS_WS)+wid*64;
  const bf16*ksrc=Kh+(long)lane*DM+wid*8;
  const bf16*vsrc=Vh+(long)(16*(wid&3)+(lane>>2))*DM+(wid>>2)*32+(lane&3)*8;
  const unsigned kdst=lds0+LDS_K+wid*1024, vdst=lds0+LDS_V+wid*1024;
  #define DMA_K(t,slot) glds16(ksrc+(long)(t)*KVBLK*DM,(unsigned)__builtin_amdgcn_readfirstlane(kdst+(slot)))
  #define DMA_V(t,slot) glds16(vsrc+(long)(t)*KVBLK*DM,(unsigned)__builtin_amdgcn_readfirstlane(vdst+(slot)))
  const int vb0=(int)(lds0+LDS_V)+((lane>>4)&1)*32+(lane&3)*8+(4*hi+((lane&15)>>2))*64;
  const char*Kbase=shm+LDS_K; bf16x8 kf[8];
  const lds_cptr shm3=(lds_cptr)shm; const lds_cptr kp0=shm3+LDS_K+hi*1024+r32*16; const lds_cptr vp0=shm3+LDS_V+((lane>>4)&1)*32+(lane&3)*8+(4*hi+((lane&15)>>2))*64;
  const int NT=(q0+QB)/KVBLK;
  DMA_K(0,0);DMA_V(0,0);DMA_K(1,SLOTB);
  bf16x8 qr[4];
  #pragma unroll
  for(int d0=0;d0<4;++d0)qr[d0]=*reinterpret_cast<const bf16x8*>(&Qw[(long)r32*DM+d0*16+hi*8]);
  unsigned selmask=0xffu;
  if(qb>=4){
    float g[7];
    #pragma unroll
    for(int n=0;n<7;++n){ g[n]=0.f;
      if(n<qb){ const float*km=kmean+((size_t)(b*8+n)*DM+h*D)+8*hi; float s=0.f;
        #pragma unroll
        for(int d0=0;d0<4;++d0){ const float4 k0=*(const float4*)(km+16*d0),k1=*(const float4*)(km+16*d0+4); const float kk[8]={k0.x,k0.y,k0.z,k0.w,k1.x,k1.y,k1.z,k1.w};
          #pragma unroll
          for(int j=0;j<8;++j)s+=__uint_as_float(((unsigned)(unsigned short)qr[d0][j])<<16)*kk[j]; }
        auto rr=__builtin_amdgcn_permlane32_swap(__float_as_uint(s),__float_as_uint(s),false,false); g[n]=__uint_as_float(rr[0])+__uint_as_float(rr[1]); } }
    selmask=0u;
    #pragma unroll
    for(int n=0;n<7;++n){ int rank=0;
      #pragma unroll
      for(int m2=0;m2<7;++m2){ if(m2<qb&&(g[m2]>g[n]||(g[m2]==g[n]&&m2<n)))++rank; }
      if(n<qb&&rank<3)selmask|=(1u<<n); }
  }
  const unsigned lanemask=(unsigned)hi-1u;
  unsigned qaw0,qaw1,kw1a,kw1b;
  { const float slope2=__builtin_amdgcn_exp2f(-(float)(h+1))*1.4426950408889634f; const unsigned shi_b=bfr(slope2); const float shi_f=__uint_as_float(shi_b<<16); const unsigned slo_b=bfr(slope2-shi_f);
    qaw0=(bfr(64.f*shi_f)|(bfr(64.f*__uint_as_float(slo_b<<16))<<16))&lanemask; qaw1=(shi_b|(slo_b<<16))&lanemask;
    const unsigned ba=bfr((float)r32),bb=bfr((float)(r32+32)); kw1a=(ba|(ba<<16))&lanemask; kw1b=(bb|(bb<<16))&lanemask; }
  unsigned qaw2m=0u,qaw3=0u;
  #define MSPLIT() do{ const float x_=-mhat; const unsigned b1_=bfr(x_); const float r1_=x_-__uint_as_float(b1_<<16); const unsigned b2_=bfr(r1_); const float r2_=r1_-__uint_as_float(b2_<<16); \
      qaw2m=(b1_<<16)&lanemask; qaw3=(b2_|(bfr(r2_)<<16))&lanemask; }while(0)
  #define AUG(t_,KA0,KA1,QA) const int t__=(t_); const float af_=(float)(t__-4*qb); const unsigned aw_=bfr(af_); const unsigned w0_=(aw_|(aw_<<16))&lanemask; \
      const bool sel_=(t__>=NT-4)||((selmask>>(t__>>2))&1u); const unsigned w2_=((sel_?0u:0x0000f14au)&lanemask)|qaw2m; const unsigned on_=0x3f803f80u&lanemask; \
      const bf16x8 KA0=__builtin_bit_cast(bf16x8,(u32x4){w0_,kw1a,on_,on_}); const bf16x8 KA1=__builtin_bit_cast(bf16x8,(u32x4){w0_,kw1b,on_,on_}); const bf16x8 QA=__builtin_bit_cast(bf16x8,(u32x4){qaw0,qaw1,w2_,qaw3});
  const f32x16 negm=f32x16{};
  float mhat=0.f,l_reg=0.f;f32x16 o[2];o[0]=f32x16{};o[1]=f32x16{};
  const int qrel=wid*QBLK+r32;
  #define CMASK(P0,P1,t) do{int jb_=(t)-(NT-4); if(jb_>=0)cmask(P0,P1,jb_,qrel,hi);}while(0)
  bool resc=false;
  #define START(P0,P1) do{ const float rm=rowmax(P0,P1); resc=false; \
    { const float dl=(rm<-1e29f)?0.f:rm; mhat=fadd_s(mhat,dl); \
      _Pragma("unroll") for(int r=0;r<16;++r){P0[r]=fsub_s(P0[r],dl);P1[r]=fsub_s(P1[r],dl);} \
      MSPLIT(); } \
    _Pragma("unroll") for(int r=0;r<16;++r)P0[r]=__builtin_amdgcn_exp2f(P0[r]); }while(0)
  #define RESC() do{ if(resc){ asm volatile("s_waitcnt lgkmcnt(0)":::"memory"); \
      _Pragma("unroll") for(int d_=0;d_<2;++d_) _Pragma("unroll") for(int r=0;r<16;++r)o[d_][r]*=wsf[crow(r,hi)]; } }while(0)
  f32x16 pA0,pA1,pB0,pB1;
  int sl_prev=0,sl_cur=0,sl_next=SLOTB;
  #define ROT() do{sl_prev=sl_cur;sl_cur=sl_next;sl_next=(sl_next==(NSLOT-1)*SLOTB)?0:sl_next+SLOTB;}while(0)
  DMA_K(2,2*SLOTB);
  WAIT_BAR(3);
  { AUG(0,ka0_,ka1_,qa_) qkt(pA0,pA1,Kbase,qr,r32,hi,ka0_,ka1_,qa_); } asm volatile("s_nop 15\n\ts_nop 7":"+v"(pA0),"+v"(pA1));CMASK(pA0,pA1,0);
  START(pA0,pA1);
  _Pragma("unroll") for(int r=0;r<16;++r)pA1[r]=__builtin_amdgcn_exp2f(pA1[r]);
  WAIT_BAR(0);
  DMA_K(3,0);DMA_V(1,SLOTB);
  ROT();
  kload8(kf,kp0+sl_cur);
  WAIT_BAR(2);
  s16x4 vlo[8],vhi[8]; u32x4 pw0,pw1,pw2,pw3;
  #define PKW(P,B) cvtpk_s(P[B],P[B+1])
  #define PAF(k) __builtin_bit_cast(bf16x8,pw##k)
  #define VFR(i) (bf16x8){vlo[i][0],vlo[i][1],vlo[i][2],vlo[i][3],vhi[i][0],vhi[i][1],vhi[i][2],vhi[i][3]}
  #define PIN(x) asm volatile("":"+v"(x))
  #define MX3(a,b,c) __builtin_fmaxf(__builtin_fmaxf((a),(b)),(c))
  #define GAPA(MF,A0,A1,A2,A3,W0,W1,PW) do{ MF; sacc+=A0; sacc+=A1; sacc+=A2; sacc+=A3; PIN(sacc); W0; W1; PIN(PW); SBAR(); }while(0)
  #define EX(v) __builtin_amdgcn_exp2f(v)
  #define GAPB(MF,X,B) do{ MF; X[B]=EX(X[B]); X[B+1]=EX(X[B+1]); X[B+2]=EX(X[B+2]); X[B+3]=EX(X[B+3]); PIN(X); SBAR(); }while(0)
  #define VRD(i) do{ vlo[i]=vtr(vp_+(((i)>>2)*4096+((i)&3)*1024)); vhi[i]=vtr(vp_+(((i)>>2)*4096+((i)&3)*1024+512)); }while(0)
  #define KRD(G,j) do{ if(G){ kload2(kf,kp0+sl_next,j); SBAR(); } }while(0)
  #define STEP(C0,C1,P0,P1,t,GK,GV,GL) do{ SBAR(); \
    const lds_cptr vp_=vp0+sl_prev; \
    VRD(0); SBAR(); float sacc=(P0[0]+P0[1]); \
    GAPA(C0=__builtin_amdgcn_mfma_f32_32x32x16_bf16(kf[0],qr[0],negm,0,0,0), P0[2],P0[3],P0[4],P0[5],     pw0[0]=PKW(P0,0), pw0[1]=PKW(P0,2), pw0); \
    VRD(4); SBAR(); GAPA(C1=__builtin_amdgcn_mfma_f32_32x32x16_bf16(kf[1],qr[0],negm,0,0,0), P0[6],P0[7],P0[8],P0[9],     pw0[2]=PKW(P0,4), pw0[3]=PKW(P0,6), pw0); \
    VRD(1); SBAR(); GAPA(C0=__builtin_amdgcn_mfma_f32_32x32x16_bf16(kf[2],qr[1],C0,0,0,0),   P0[10],P0[11],P0[12],P0[13], pw1[0]=PKW(P0,8), pw1[1]=PKW(P0,10), pw1); \
    VRD(5); SBAR(); GAPA(C1=__builtin_amdgcn_mfma_f32_32x32x16_bf16(kf[3],qr[1],C1,0,0,0),   P0[14],P0[15],P1[0],P1[1],   pw1[2]=PKW(P0,12),pw1[3]=PKW(P0,14), pw1); \
    VRD(2); SBAR(); GAPA(C0=__builtin_amdgcn_mfma_f32_32x32x16_bf16(kf[4],qr[2],C0,0,0,0),   P1[2],P1[3],P1[4],P1[5],     pw2[0]=PKW(P1,0), pw2[1]=PKW(P1,2), pw2); \
    VRD(6); SBAR(); GAPA(C1=__builtin_amdgcn_mfma_f32_32x32x16_bf16(kf[5],qr[2],C1,0,0,0),   P1[6],P1[7],P1[8],P1[9],     pw2[2]=PKW(P1,4), pw2[3]=PKW(P1,6), pw2); \
    VRD(3); SBAR(); GAPA(C0=__builtin_amdgcn_mfma_f32_32x32x16_bf16(kf[6],qr[3],C0,0,0,0),   P1[10],P1[11],P1[12],P1[13], pw3[0]=PKW(P1,8), pw3[1]=PKW(P1,10), pw3); \
    VRD(7); SBAR(); GAPA(C1=__builtin_amdgcn_mfma_f32_32x32x16_bf16(kf[7],qr[3],C1,0,0,0),   P1[14],P1[15],0.f,0.f,       pw3[2]=PKW(P1,12),pw3[3]=PKW(P1,14), pw3); \
    { AUG(t,ka0_,ka1_,qa_) C0=__builtin_amdgcn_mfma_f32_32x32x16_bf16(ka0_,qa_,C0,0,0,0); SBAR(); C1=__builtin_amdgcn_mfma_f32_32x32x16_bf16(ka1_,qa_,C1,0,0,0); } SBAR(); \
    l_reg+=sacc; \
    if(GK){DMA_K((t)+3,sl_cur);} if(GV){DMA_V((t)+1,sl_next);} \
    CMASK(C0,C1,t); \
    { float a=MX3(C0[0],C0[1],C1[0]),b=MX3(C0[2],C0[3],C1[1]); a=MX3(a,C1[2],C1[3]); \
      _Pragma("unroll") for(int r=4;r<16;r+=4){a=MX3(a,C0[r],C0[r+1]);b=MX3(b,C0[r+2],C0[r+3]);a=MX3(a,C1[r],C1[r+1]);b=MX3(b,C1[r+2],C1[r+3]);} \
      float rm=__builtin_fmaxf(a,b); { auto rr=__builtin_amdgcn_permlane32_swap(__float_as_uint(rm),__float_as_uint(rm),false,false); rm=__builtin_fmaxf(__uint_as_float(rr[0]),__uint_as_float(rr[1])); } \
      resc=false; \
      if(__builtin_expect(__any(rm>(float)THRL),0)){ const float dl=__builtin_fmaxf(rm,0.f); mhat+=dl; \
        _Pragma("unroll") for(int r=0;r<16;++r){C0[r]-=dl;C1[r]-=dl;} \
        MSPLIT(); \
        const float f=__builtin_amdgcn_exp2f(-dl); l_reg*=f; if(hi==0)wsf[r32]=f; resc=true; } } \
    SBAR(); \
    GAPB(o[0]=__builtin_amdgcn_mfma_f32_32x32x16_bf16(PAF(0),VFR(0),o[0],0,0,0), C0,0); \
    GAPB(o[1]=__builtin_amdgcn_mfma_f32_32x32x16_bf16(PAF(0),VFR(4),o[1],0,0,0), C0,4); \
    KRD(GL,0); GAPB(o[0]=__builtin_amdgcn_mfma_f32_32x32x16_bf16(PAF(1),VFR(1),o[0],0,0,0), C0,8); \
    KRD(GL,1); GAPB(o[1]=__builtin_amdgcn_mfma_f32_32x32x16_bf16(PAF(1),VFR(5),o[1],0,0,0), C0,12); \
    KRD(GL,2); GAPB(o[0]=__builtin_amdgcn_mfma_f32_32x32x16_bf16(PAF(2),VFR(2),o[0],0,0,0), C1,0); \
    KRD(GL,3); GAPB(o[1]=__builtin_amdgcn_mfma_f32_32x32x16_bf16(PAF(2),VFR(6),o[1],0,0,0), C1,4); \
    GAPB(o[0]=__builtin_amdgcn_mfma_f32_32x32x16_bf16(PAF(3),VFR(3),o[0],0,0,0), C1,8); \
    GAPB(o[1]=__builtin_amdgcn_mfma_f32_32x32x16_bf16(PAF(3),VFR(7),o[1],0,0,0), C1,12); \
    }while(0)
  int t=1;
  #undef CMASK
  #define CMASK(P0,P1,t) do{}while(0)
  for(;t+5<NT;t+=2){
    STEP(pB0,pB1,pA0,pA1,t,true,true,true);     WAIT_BAR(2); RESC(); ROT();
    STEP(pA0,pA1,pB0,pB1,t+1,true,true,true);   WAIT_BAR(2); RESC(); ROT();
  }
  #undef CMASK
  #define CMASK(P0,P1,t) do{int jb_=(t)-(NT-4); if(jb_>=0)cmask(P0,P1,jb_,qrel,hi);}while(0)
  #define ENDW(tt) do{ if((tt)+3<NT){WAIT_BAR(2);} else if((tt)+2<NT){WAIT_BAR(1);} else {WAIT_BAR(0);} }while(0)
  for(;t+1<NT;t+=2){
    STEP(pB0,pB1,pA0,pA1,t,(t+3<NT),(t+1<NT),(t+1<NT));       ENDW(t);   RESC(); ROT();
    STEP(pA0,pA1,pB0,pB1,t+1,(t+4<NT),(t+2<NT),(t+2<NT));     ENDW(t+1); RESC(); ROT();
  }
  STEP(pB0,pB1,pA0,pA1,NT-1,false,false,false); RESC();
  { float sacc=pB0[0]+pB0[1]; _Pragma("unroll") for(int r=2;r<16;++r)sacc+=pB0[r]; _Pragma("unroll") for(int r=0;r<16;++r)sacc+=pB1[r]; l_reg+=sacc;
    pw0=(u32x4){PKW(pB0,0),PKW(pB0,2),PKW(pB0,4),PKW(pB0,6)};pw1=(u32x4){PKW(pB0,8),PKW(pB0,10),PKW(pB0,12),PKW(pB0,14)};pw2=(u32x4){PKW(pB1,0),PKW(pB1,2),PKW(pB1,4),PKW(pB1,6)};pw3=(u32x4){PKW(pB1,8),PKW(pB1,10),PKW(pB1,12),PKW(pB1,14)};
    SBAR(); pv(o,vb0+sl_cur,PAF(0),PAF(1),PAF(2),PAF(3)); }
  #undef PKW
  #undef PAF
  #undef VFR
  #undef PIN
  #undef MX3
  #undef GAPA
  #undef GAPB
  #undef EX
  #undef VRD
  #undef KRD
  #undef STEP
  #undef ENDW
  {auto rr=__builtin_amdgcn_permlane32_swap(__float_as_uint(l_reg),__float_as_uint(l_reg),false,false);l_reg=__uint_as_float(rr[0])+__uint_as_float(rr[1]);}
  if(hi==0)wsf[32+r32]=l_reg;asm volatile("s_waitcnt lgkmcnt(0)":::"memory");
  float rli[16];
  #pragma unroll
  for(int r=0;r<16;++r)rli[r]=__builtin_amdgcn_rcpf(wsf[32+crow(r,hi)]);
  bf16*Ow=O+(rowbase+q0+wid*QBLK)*DM+h*D;
  { bf16*stg=(bf16*)(shm+LDS_OST)+wid*2048;
    #pragma unroll
    for(int r=0;r<16;++r){const int orow=crow(r,hi);
      #pragma unroll
      for(int d0=0;d0<2;++d0)stg[orow*64+d0*32+r32]=__float2bfloat16(o[d0][r]*rli[r]);}
    asm volatile("s_waitcnt lgkmcnt(0)":::"memory");
    #pragma unroll
    for(int i=0;i<4;++i){const int row=i*8+(lane>>3),ch=lane&7; const u32x4 v=*(const u32x4*)(stg+row*64+ch*8); ATTN_STORE16(Ow+(long)row*DM+ch*8,v);} }
  asm volatile("s_waitcnt lgkmcnt(0)\n\ts_barrier":::"memory");
  #undef DMA_K
  #undef DMA_V
  #undef CMASK
  #undef START
  #undef RESC
  #undef ROT
  #undef AUG
  #undef MSPLIT
}
constexpr int ATTN_LDS_BYTES=LDS_BYTES;
struct AttnTensors { const bf16* Q; const bf16* K; const bf16* V; bf16* O; const float* kmean; };
struct AttnUnit { int bh; int qb; };
struct StaticOrder {
  int vcu,G;
  __device__ __forceinline__ explicit StaticOrder(int grid,int block):vcu((grid%8==0)?(block%8)*(grid/8)+block/8:block),G(grid){}
  __device__ __forceinline__ bool next(int i,AttnUnit&u)const{ const int p=vcu+(i>>1)*G; if(p>=BATCH*NHEAD*4)return false; const int s=p&3; u.bh=p>>2; u.qb=(i&1)?s:7-s; return true; }
  __device__ __forceinline__ void a_ready(const AttnUnit&)const{}
  __device__ __forceinline__ void done(const AttnUnit&)const{}
};
template<class Sched,int THRL=8> __device__ __forceinline__ void attn_phase(char*lds,const AttnTensors&T,const Sched&S){
  AttnUnit u;
  for(int i=0;S.next(i,u);++i){ S.a_ready(u); attn_unit<THRL>(u.bh/NHEAD,u.bh%NHEAD,u.qb,T.Q,T.K,T.V,T.O,T.kmean,lds); S.done(u); }
}
#undef SBAR
#undef WAIT_BAR
}

constexpr size_t MiB = 1048576;
constexpr size_t WS_WUP1 = 0, WS_WDN1 = 11 * MiB, WS_WUP2 = 17 * MiB, WS_WDN2 = 28 * MiB, WS_WIN = 34 * MiB, WS_WGLU = 38 * MiB, WS_WOUT = 39 * MiB;
constexpr size_t WS_XNB = 42 * MiB, WS_F = 74 * MiB, WS_HACT = 138 * MiB;
constexpr size_t WS_Q = 138 * MiB, WS_ATT = 202 * MiB, WS_YG = 218 * MiB, WS_Z = 234 * MiB, WS_KMEAN = 250 * MiB;
constexpr size_t QKVU_STRIDE = (size_t)MTOK * 512;
constexpr size_t WS_CTL = 255 * MiB, CTL_BYTES = 65536;
constexpr int LDS_BYTES = 147456, MISC_OFF = 131072 + 320;
typedef unsigned short bf16;

__device__ __forceinline__ void p0_transpose_item(const float* W, int K, int N, bf16* WT, int mode, LAS float* scr, int item, int lane) {
    const int nblk = N / 32, kb = item / nblk, nb = item % nblk, k0 = 64 * kb, n0 = 32 * nb;
    const int r0 = (mode == 0) ? n0 : (256 * (n0 / 128) + (n0 % 128) + (mode == 2 ? 128 : 0));
#pragma unroll 8
    for (int i = 0; i < 32; ++i) { const int kk = 2 * i + (lane >> 5); scr[kk * 33 + (lane & 31)] = W[(size_t)(k0 + kk) * N + n0 + (lane & 31)]; }
    asm volatile("s_waitcnt lgkmcnt(0)" ::: "memory");
    const int c = lane & 7;
#pragma unroll
    for (int j = 0; j < 4; ++j) { const int n = (lane >> 3) + 8 * j; const LAS float* s = scr + (8 * c) * 33 + n;
        uint4 o; o.x = pk2(s[0 * 33], s[1 * 33]); o.y = pk2(s[2 * 33], s[3 * 33]); o.z = pk2(s[4 * 33], s[5 * 33]); o.w = pk2(s[6 * 33], s[7 * 33]);
        *(uint4*)(WT + (size_t)(r0 + n) * K + k0 + 8 * c) = o; }
    asm volatile("s_waitcnt lgkmcnt(0)" ::: "memory");
}
struct ConvJob { const float* W; bf16* WT; int K, N, mode, items; };
__device__ __forceinline__ void conv_weights(const Args& a, LAS unsigned char* lds, int bid, int nblk) {
    const int lane = threadIdx.x & 63, wave = threadIdx.x >> 6;
    LAS float* scr = (LAS float*)(lds + wave * 16384);
    const int gw = bid * NWAVES + wave, NGW = nblk * NWAVES;
    constexpr int I_G = (D_MODEL / 64) * (D_FF / 32), I_D = (D_FF / 64) * (D_MODEL / 32), I_IN = (D_MODEL / 64) * (D_IN / 32), I_GL = (D_SSM / 64) * (D_SSM / 32), I_O = (D_MODEL / 64) * (D_MODEL / 32);
    constexpr int NITEMS = 4 * I_G + 2 * I_D + I_IN + I_GL + I_O;
    for (int it = gw; it < NITEMS; it += NGW) {
        int r = it;
        if (r < I_G) { p0_transpose_item(a.in[I_F1WG], D_MODEL, D_FF, (bf16*)(a.ws + WS_WUP1), 1, scr, r, lane); continue; } r -= I_G;
        if (r < I_G) { p0_transpose_item(a.in[I_F1WU], D_MODEL, D_FF, (bf16*)(a.ws + WS_WUP1), 2, scr, r, lane); continue; } r -= I_G;
        if (r < I_D) { p0_transpose_item(a.in[I_F1WD], D_FF, D_MODEL, (bf16*)(a.ws + WS_WDN1), 0, scr, r, lane); continue; } r -= I_D;
        if (r < I_G) { p0_transpose_item(a.in[I_F2WG], D_MODEL, D_FF, (bf16*)(a.ws + WS_WUP2), 1, scr, r, lane); continue; } r -= I_G;
        if (r < I_G) { p0_transpose_item(a.in[I_F2WU], D_MODEL, D_FF, (bf16*)(a.ws + WS_WUP2), 2, scr, r, lane); continue; } r -= I_G;
        if (r < I_D) { p0_transpose_item(a.in[I_F2WD], D_FF, D_MODEL, (bf16*)(a.ws + WS_WDN2), 0, scr, r, lane); continue; } r -= I_D;
        if (r < I_IN) { p0_transpose_item(a.in[I_WIN], D_MODEL, D_IN, (bf16*)(a.ws + WS_WIN), 0, scr, r, lane); continue; } r -= I_IN;
        if (r < I_GL) { p0_transpose_item(a.in[I_WGLU], D_SSM, D_SSM, (bf16*)(a.ws + WS_WGLU), 0, scr, r, lane); continue; } r -= I_GL;
        p0_transpose_item(a.in[I_WOUT], D_MODEL, D_MODEL, (bf16*)(a.ws + WS_WOUT), 0, scr, r, lane);
    }
}
__device__ __forceinline__ void rms_rows_bf16(const float* in, const float* g, bf16* out, int bid, int nblk) {
    const int lane = threadIdx.x & 63, wave = threadIdx.x >> 6;
    for (int r = bid * NWAVES + wave; r < MTOK; r += nblk * NWAVES) {
        const float4* ir = (const float4*)(in + (size_t)r * D_MODEL) + lane;
        float4 v[4]; float s = 0.f;
#pragma unroll
        for (int j = 0; j < 4; ++j) { v[j] = ir[64 * j]; s += v[j].x * v[j].x + v[j].y * v[j].y + v[j].z * v[j].z + v[j].w * v[j].w; }
        s = wave_sum(s);
        const float rs = 1.0f / sqrtf(s * (1.0f / D_MODEL) + RMS_EPS);
        uint2* o8 = (uint2*)(out + (size_t)r * D_MODEL) + lane;
#pragma unroll
        for (int j = 0; j < 4; ++j) { const float4 gg = ((const float4*)g)[lane + 64 * j];
            uint2 o; o.x = pk2(v[j].x * rs * gg.x, v[j].y * rs * gg.y); o.y = pk2(v[j].z * rs * gg.z, v[j].w * rs * gg.w); o8[64 * j] = o; }
    }
}
__device__ __forceinline__ void rms512_bf16(const bf16* in, const float* g, bf16* out, int coff, int bid, int nblk) {
    const int lane = threadIdx.x & 63, wave = threadIdx.x >> 6;
    for (int r = bid * NWAVES + wave; r < MTOK; r += nblk * NWAVES) {
        const uint4 w = *((const uint4*)(in + (size_t)r * 512) + lane);
        float v[8]; v[0] = __uint_as_float(w.x << 16); v[1] = __uint_as_float(w.x & 0xffff0000u); v[2] = __uint_as_float(w.y << 16); v[3] = __uint_as_float(w.y & 0xffff0000u);
        v[4] = __uint_as_float(w.z << 16); v[5] = __uint_as_float(w.z & 0xffff0000u); v[6] = __uint_as_float(w.w << 16); v[7] = __uint_as_float(w.w & 0xffff0000u);
        float s = 0.f;
#pragma unroll
        for (int e = 0; e < 8; ++e) s += v[e] * v[e];
        s = wave_sum(s);
        const float rs = 1.0f / sqrtf(s * (1.0f / 512.0f) + RMS_EPS);
        const float4 g0 = ((const float4*)g)[2 * lane], g1 = ((const float4*)g)[2 * lane + 1];
        uint4 o; o.x = pk2(v[0] * rs * g0.x, v[1] * rs * g0.y); o.y = pk2(v[2] * rs * g0.z, v[3] * rs * g0.w); o.z = pk2(v[4] * rs * g1.x, v[5] * rs * g1.y); o.w = pk2(v[6] * rs * g1.z, v[7] * rs * g1.w);
        *((uint4*)(out + (size_t)r * 1024 + coff) + lane) = o;
    }
}

__global__ void __launch_bounds__(NTHR, 2) k_mega(Args a) {
    extern __shared__ __attribute__((aligned(16))) unsigned char lds[];
    LAS unsigned char* ldsl = (LAS unsigned char*)lds;
    const int bid = blockIdx.x, nblk = gridDim.x;
    volatile LAS unsigned* MISC = (volatile LAS unsigned*)(ldsl + MISC_OFF);
    if (threadIdx.x < 32) MISC[threadIdx.x] = 0u;
    __syncthreads();
    XcdBarrier bar = xcd_barrier_post((unsigned*)(a.ws + WS_CTL), MISC + 8);
    bf16* WUP1 = (bf16*)(a.ws + WS_WUP1); bf16* WDN1 = (bf16*)(a.ws + WS_WDN1); bf16* WUP2 = (bf16*)(a.ws + WS_WUP2); bf16* WDN2 = (bf16*)(a.ws + WS_WDN2);
    bf16* WINT = (bf16*)(a.ws + WS_WIN); bf16* WGLUT = (bf16*)(a.ws + WS_WGLU); bf16* WOUTT = (bf16*)(a.ws + WS_WOUT);
    bf16* XNB = (bf16*)(a.ws + WS_XNB); bf16* HACT = (bf16*)(a.ws + WS_HACT); float* FB = (float*)(a.ws + WS_F);
    bf16* QB = (bf16*)(a.ws + WS_Q); bf16* KB = QB + QKVU_STRIDE; bf16* VB = KB + QKVU_STRIDE; bf16* USB = VB + QKVU_STRIDE;
    bf16* ATT = (bf16*)(a.ws + WS_ATT); bf16* YG = (bf16*)(a.ws + WS_YG); bf16* ZB = (bf16*)(a.ws + WS_Z); float* KMEAN = (float*)(a.ws + WS_KMEAN);
    float* H = a.out;
    const float* x = a.in[I_X];
    conv_weights(a, ldsl, bid, nblk); rms_rows_bf16(x, a.in[I_F1PRE], XNB, bid, nblk);
    xcd_barrier(bar);
    { pg8::Gemm g{XNB, WUP1, MTOK, 2 * D_FF, D_MODEL}; pg8::StaticOrder S; S.init(MTOK, 2 * D_FF, nblk, bid); pg8::EpiSwiGLU E{HACT, D_FF};
      pg8::gemm_phase<pg8::EpiSwiGLU, pg8::StaticOrder, PG8_ALIGN, PG8_SP2>(ldsl, g, S, E); }
    xcd_barrier(bar);
    { pg8::Gemm g{HACT, WDN1, MTOK, D_MODEL, D_FF}; pg8::StaticOrder S; S.init(MTOK, D_MODEL, nblk, bid); pg8::EpiF32 E{FB, D_MODEL};
      pg8::gemm_phase<pg8::EpiF32, pg8::StaticOrder, PG8_ALIGN, PG8_SP2>(ldsl, g, S, E); }
    xcd_barrier(bar);
    nv_rms(FB, 1024, a.in[I_F1POST], 1024, MTOK, x, 1024, 0.5f, H, 1024, bid, nblk);
    xcd_barrier(bar);
    rms_rows_bf16(H, a.in[I_MIXPRE], XNB, bid, nblk);
    xcd_barrier(bar);
    { pg8::Gemm g{XNB, WINT, MTOK, D_IN, D_MODEL}; pg8::StaticOrder S; S.init(MTOK, D_IN, nblk, bid); pg8::EpiBf16Split E{QB, QKVU_STRIDE, attn_body::C2};
      pg8::gemm_phase<pg8::EpiBf16Split, pg8::StaticOrder, PG8_ALIGN, PG8_SP2>(ldsl, g, S, E); }
    xcd_barrier(bar);
    nv_kmean(KB, 512, KMEAN, bid, nblk);
    xcd_barrier(bar);
    { const attn_body::AttnTensors AT{(const attn_body::bf16*)QB, (const attn_body::bf16*)KB, (const attn_body::bf16*)VB, (attn_body::bf16*)ATT, KMEAN};
      const attn_body::StaticOrder S(nblk, bid); attn_body::attn_phase<attn_body::StaticOrder>((char*)lds, AT, S); }
    xcd_barrier(bar);
    nv_ssm(USB, 512, a.in[I_LAMRE], a.in[I_LAMIM], a.in[I_LOGDT], a.in[I_BRE], a.in[I_BIM], a.in[I_CRE], a.in[I_CIM], a.in[I_DSKIP], YG, 512, bid, nblk);
    xcd_barrier(bar);
    { pg8::Gemm g{YG, WGLUT, MTOK, D_SSM, D_SSM}; pg8::StaticOrder S; S.init(MTOK, D_SSM, nblk, bid); pg8::EpiGLU E{YG, ZB, a.in[I_BGLU]};
      pg8::gemm_phase<pg8::EpiGLU, pg8::StaticOrder, PG8_ALIGN, PG8_SP2>(ldsl, g, S, E); }
    xcd_barrier(bar);
    rms512_bf16(ATT, a.in[I_ATTNG], XNB, 0, bid, nblk); rms512_bf16(ZB, a.in[I_SSMG], XNB, 512, bid, nblk);
    xcd_barrier(bar);
    { pg8::Gemm g{XNB, WOUTT, MTOK, D_MODEL, D_MODEL}; pg8::StaticOrder S; S.init(MTOK, D_MODEL, nblk, bid); pg8::EpiF32 E{FB, D_MODEL};
      pg8::gemm_phase<pg8::EpiF32, pg8::StaticOrder, PG8_ALIGN, PG8_SP2>(ldsl, g, S, E); }
    xcd_barrier(bar);
    nv_rms(FB, 1024, a.in[I_MIXPOST], 1024, MTOK, H, 1024, 1.0f, H, 1024, bid, nblk);
    xcd_barrier(bar);
    rms_rows_bf16(H, a.in[I_F2PRE], XNB, bid, nblk);
    xcd_barrier(bar);
    { pg8::Gemm g{XNB, WUP2, MTOK, 2 * D_FF, D_MODEL}; pg8::StaticOrder S; S.init(MTOK, 2 * D_FF, nblk, bid); pg8::EpiSwiGLU E{HACT, D_FF};
      pg8::gemm_phase<pg8::EpiSwiGLU, pg8::StaticOrder, PG8_ALIGN, PG8_SP2>(ldsl, g, S, E); }
    xcd_barrier(bar);
    { pg8::Gemm g{HACT, WDN2, MTOK, D_MODEL, D_FF}; pg8::StaticOrder S; S.init(MTOK, D_MODEL, nblk, bid); pg8::EpiF32 E{FB, D_MODEL};
      pg8::gemm_phase<pg8::EpiF32, pg8::StaticOrder, PG8_ALIGN, PG8_SP2>(ldsl, g, S, E); }
    xcd_barrier(bar);
    nv_rms(FB, 1024, a.in[I_F2POST], 1024, MTOK, H, 1024, 0.5f, H, 1024, bid, nblk);
}

extern "C" void kernel_launch(void* const* d_in, const int* in_sizes, int n_in, void* d_out, int out_size, void* d_ws, size_t ws_size, hipStream_t stream) {
    static int grid = 0;
    if (grid == 0) {
        if (n_in != 27 || out_size != MTOK * D_MODEL || ws_size < 256u * 1048576u) { fprintf(stderr, "kernel_launch: unexpected shapes n_in %d out %d ws %zu\n", n_in, out_size, ws_size); grid = -1; return; }
        int dev = 0, cus = 0, per_cu = 0;
        if (hipGetDevice(&dev) != hipSuccess || hipDeviceGetAttribute(&cus, hipDeviceAttributeMultiprocessorCount, dev) != hipSuccess) { grid = -1; return; }
        if (hipFuncSetAttribute((const void*)k_mega, hipFuncAttributeMaxDynamicSharedMemorySize, LDS_BYTES) != hipSuccess) { fprintf(stderr, "hipFuncSetAttribute failed\n"); grid = -1; return; }
        if (hipOccupancyMaxActiveBlocksPerMultiprocessor(&per_cu, (const void*)k_mega, NTHR, LDS_BYTES) != hipSuccess || per_cu < 1) { fprintf(stderr, "occupancy query: %d blocks per CU\n", per_cu); grid = -1; (void)hipGetLastError(); return; }
        grid = cus;
    }
    if (grid < 0) return;
    if (hipMemsetAsync((char*)d_ws + WS_CTL, 0, CTL_BYTES, stream) != hipSuccess) return;
    Args a{};
    for (int i = 0; i < 27; ++i) a.in[i] = (const float*)d_in[i];
    a.out = (float*)d_out; a.ws = (unsigned char*)d_ws;
    hipLaunchKernelGGL(k_mega, dim3(grid), dim3(NTHR), LDS_BYTES, stream, a);
}
```

```cpp
#include <hip/hip_runtime.h>
#include <cstdint>
#include <cstdio>

constexpr int D_MODEL = 1024, BATCH = 8, SEQ = 2048, MTOK = BATCH * SEQ;
constexpr int NH = 8, HD = 64, D_ATTN = 512, MOBA_L = 256, NBLK = SEQ / MOBA_L;
constexpr int SSM_GROUP = 16, D_SSM = 512, NG = 32, SSM_P = 64;
constexpr int D_IN = 2048, D_FF = 2816;
constexpr float RMS_EPS = 1e-6f;
constexpr int NTHR = 512, NWAVES = 8;

struct Args {
    const float* in[27];
    float* out;
    unsigned char* ws;
    int stage, pad;
};
enum { I_X = 0, I_F1PRE, I_F1WG, I_F1WU, I_F1WD, I_F1POST, I_MIXPRE, I_WIN, I_LAMRE, I_LAMIM, I_LOGDT, I_BRE, I_BIM, I_CRE, I_CIM, I_DSKIP,
       I_WGLU, I_BGLU, I_ATTNG, I_SSMG, I_WOUT, I_MIXPOST, I_F2PRE, I_F2WG, I_F2WU, I_F2WD, I_F2POST };

namespace pg8 {
#define PG8_LAS __attribute__((address_space(3)))
typedef unsigned short bf16_t;
typedef short bf16x8 __attribute__((ext_vector_type(8)));
typedef float f32x4 __attribute__((ext_vector_type(4)));
typedef unsigned u32x4 __attribute__((ext_vector_type(4)));
constexpr int BM = 256, BK = 64, HALF = 128, HTB = HALF * BK * 2  , STAGE_BYTES = 8 * HTB, NXCD = 8, WGM = 8;

__host__ __device__ __forceinline__ int lds_byte(int r, int c) { const int st = (r >> 4) * 2 + (c >> 5), rr = r & 15, cc = c & 31, ob = rr * 64 + cc * 2; return st * 1024 + (ob ^ (((ob >> 9) & 1) << 5)); }
__host__ __device__ __forceinline__ void stage_rc(int b, int& R, int& C) { const int st = b / 1024, sb = b % 1024, swz = sb ^ (((sb >> 9) & 1) << 5); R = (st >> 1) * 16 + swz / 64; C = (st & 1) * 32 + (swz % 64) / 2; }
__host__ __device__ __forceinline__ int perm32(int rho) { const int n = rho >> 4, i = rho & 15; return 8 * (i >> 2) + 4 * n + (i & 3); }

struct Unit { int pm, pn; };
struct Gemm { const bf16_t* A; const bf16_t* Bt; int M, N, K; };

struct StaticOrder {
    int nM, nN, nwg, G, c;
    __host__ __device__ void init(int M, int N, int G_, int c_) { nM = M / BM; nN = N / BM; nwg = nM * nN; G = G_; c = c_; }
    __host__ __device__ bool next(int i, Unit& u) const {
        const long L = (long)i * G + c; if (L >= nwg) return false;
        int wgid = (int)L; { const int q = nwg / NXCD, r = nwg % NXCD, xcd = wgid % NXCD, off = wgid / NXCD; wgid = (xcd < r ? xcd * (q + 1) : r * (q + 1) + (xcd - r) * q) + off; }
        const int nig = WGM * nN, gid = wgid / nig, fm = gid * WGM, gsz = (nM - fm) < WGM ? (nM - fm) : WGM;
        u.pm = fm + ((wgid % nig) % gsz); u.pn = (wgid % nig) / gsz; return true;
    }
    __device__ __forceinline__ void a_ready(const Unit&) const {}
    __device__ __forceinline__ void done(const Unit&) const {}
};

__device__ __forceinline__ unsigned cvt_pk_bf16(float lo, float hi) { unsigned r; asm volatile("v_cvt_pk_bf16_f32 %0, %1, %2" : "=v"(r) : "v"(lo), "v"(hi)); return r; }

struct EpiF32 {
    static constexpr bool PERM = false, AFTER_DRAIN = false;
    float* C; int ldc;
    __device__ __forceinline__ void operator()(const f32x4 (&acc)[2][2][4][2], const Unit& u, int wr, int wc, int fr, int fq) const {
        const int row0 = u.pm * BM + wr * 64 + fr, col0 = u.pn * BM + wc * 32 + 4 * fq;
#pragma unroll
        for (int ai = 0; ai < 2; ++ai)
#pragma unroll
            for (int m = 0; m < 4; ++m) { float* rowp = C + (size_t)(row0 + ai * HALF + m * 16) * ldc + col0;
#pragma unroll
                for (int bj = 0; bj < 2; ++bj)
#pragma unroll
                    for (int n = 0; n < 2; ++n) *(f32x4*)(rowp + bj * HALF + n * 16) = acc[ai][bj][m][n]; }
    }
};
struct EpiSwiGLU {
    static constexpr bool PERM = true, AFTER_DRAIN = false;
    bf16_t* O; int ldc;
    __device__ __forceinline__ void operator()(const f32x4 (&acc)[2][2][4][2], const Unit& u, int wr, int wc, int fr, int fq) const {
        const int row0 = u.pm * BM + wr * 64 + fr, col0 = u.pn * HALF + wc * 32 + 8 * fq;
#pragma unroll
        for (int ai = 0; ai < 2; ++ai)
#pragma unroll
            for (int m = 0; m < 4; ++m) { bf16_t* rowp = O + (size_t)(row0 + ai * HALF + m * 16) * ldc + col0;
                float o[8];
#pragma unroll
                for (int n = 0; n < 2; ++n)
#pragma unroll
                    for (int e = 0; e < 4; ++e) { const float g = acc[ai][0][m][n][e], up = acc[ai][1][m][n][e];
                        const float sg = __builtin_amdgcn_rcpf(1.0f + __builtin_amdgcn_exp2f(-1.4426950408889634f * g)); o[n * 4 + e] = g * sg * up; }
                u32x4 w; w.x = cvt_pk_bf16(o[0], o[1]); w.y = cvt_pk_bf16(o[2], o[3]); w.z = cvt_pk_bf16(o[4], o[5]); w.w = cvt_pk_bf16(o[6], o[7]);
                *(u32x4*)rowp = w; }
    }
};


struct EpiBf16Split {
    static constexpr bool PERM = true, AFTER_DRAIN = false;
    bf16_t* O; size_t split_stride; float scale0;
    __device__ __forceinline__ void operator()(const f32x4 (&acc)[2][2][4][2], const Unit& u, int wr, int wc, int fr, int fq) const {
        const int row0 = u.pm * BM + wr * 64 + fr; const int t = (u.pn * BM) / 512; const int colt = u.pn * BM - t * 512;
        bf16_t* base = O + (size_t)t * split_stride; const int col0 = colt + wc * 32 + 8 * fq; const float sc = (t == 0) ? scale0 : 1.0f;
#pragma unroll
        for (int ai = 0; ai < 2; ++ai)
#pragma unroll
            for (int m = 0; m < 4; ++m) { bf16_t* rowp = base + (size_t)(row0 + ai * HALF + m * 16) * 512 + col0;
#pragma unroll
                for (int bj = 0; bj < 2; ++bj) { const f32x4 v0 = acc[ai][bj][m][0] * sc, v1 = acc[ai][bj][m][1] * sc;
                    u32x4 w; w.x = cvt_pk_bf16(v0[0], v0[1]); w.y = cvt_pk_bf16(v0[2], v0[3]); w.z = cvt_pk_bf16(v1[0], v1[1]); w.w = cvt_pk_bf16(v1[2], v1[3]);
                    *(u32x4*)(rowp + bj * HALF) = w; } }
    }
};
struct EpiGLU {
    static constexpr bool PERM = true, AFTER_DRAIN = false;
    const bf16_t* Y; bf16_t* Z; const float* bias;
    __device__ __forceinline__ void operator()(const f32x4 (&acc)[2][2][4][2], const Unit& u, int wr, int wc, int fr, int fq) const {
        const int row0 = u.pm * BM + wr * 64 + fr, col0 = u.pn * BM + wc * 32 + 8 * fq;
#pragma unroll
        for (int ai = 0; ai < 2; ++ai)
#pragma unroll
            for (int m = 0; m < 4; ++m) { const size_t ro = (size_t)(row0 + ai * HALF + m * 16) * 512 + col0;
#pragma unroll
                for (int bj = 0; bj < 2; ++bj) { const u32x4 yw = *(const u32x4*)(Y + ro + bj * HALF);
                    const f32x4 b0 = *(const f32x4*)(bias + col0 + bj * HALF), b1 = *(const f32x4*)(bias + col0 + bj * HALF + 4);
                    float o[8];
#pragma unroll
                    for (int e = 0; e < 8; ++e) { const float a = (e < 4 ? acc[ai][bj][m][0][e & 3] : acc[ai][bj][m][1][e & 3]) + (e < 4 ? b0[e & 3] : b1[e & 3]);
                        const unsigned yy = yw[e >> 1]; const float y = __uint_as_float((e & 1) ? (yy & 0xffff0000u) : (yy << 16));
                        o[e] = y * __builtin_amdgcn_rcpf(1.0f + __builtin_amdgcn_exp2f(-1.4426950408889634f * a)); }
                    u32x4 w; w.x = cvt_pk_bf16(o[0], o[1]); w.y = cvt_pk_bf16(o[2], o[3]); w.z = cvt_pk_bf16(o[4], o[5]); w.w = cvt_pk_bf16(o[6], o[7]);
                    *(u32x4*)(Z + ro + bj * HALF) = w; } }
    }
};

template <class Epi, class Sched, bool ALIGN_EPI = false, bool SP2 = false>
__device__ __forceinline__ void gemm_phase(PG8_LAS unsigned char* lds, const Gemm g, const Sched& S, const Epi& E) {
    int tid_ = threadIdx.x; asm volatile("" : "+v"(tid_));
    const int tid = tid_, wid = __builtin_amdgcn_readfirstlane(tid >> 6), lane = tid & 63, wr = wid >> 2, wc = wid & 3, fr = lane & 15, fq = lane >> 4;
    const int K = g.K, nt = K / BK;
    unsigned voffA[2], voffB[2];
#pragma unroll
    for (int i = 0; i < 2; ++i) { int R, C; stage_rc(tid * 16 + i * 8192, R, C); const int Rb = Epi::PERM ? ((R & ~31) + perm32(R & 31)) : R;
        voffA[i] = (unsigned)(R * K + C) * 2u; voffB[i] = (unsigned)(Rb * K + C) * 2u; }
    const size_t kstep = (size_t)(BK * 2);
    const size_t hstep = (size_t)HALF * K * 2;
    const size_t tstep = 2 * hstep;
    const unsigned ldsw = (unsigned)wid * 1024u;
    const int aoff = lds_byte(wr * 64 + fr, fq * 8), boff = lds_byte(wc * 32 + fr, fq * 8);
#define PG8_SA(b, h) (((b) * 2 + (h)) * HTB)
#define PG8_SB(b, h) ((4 + (b) * 2 + (h)) * HTB)
#define PG8_STAGE(bufoff, gbase, voff) do { _Pragma("unroll") for (int _i = 0; _i < 2; ++_i) \
        __builtin_amdgcn_global_load_lds((const unsigned*)((const char*)(gbase) + (voff)[_i]), (PG8_LAS unsigned*)(lds + (bufoff) + ldsw + _i * 8192), 16, 0, 0); } while (0)
#define PG8_LDA(dst, b, h) do { _Pragma("unroll") for (int m = 0; m < 4; ++m) _Pragma("unroll") for (int k = 0; k < 2; ++k) dst[m][k] = *(const PG8_LAS bf16x8*)(lds + PG8_SA(b, h) + aoff + m * 2048 + k * 1024); } while (0)
#define PG8_LDB(dst, b, h) do { _Pragma("unroll") for (int n = 0; n < 2; ++n) _Pragma("unroll") for (int k = 0; k < 2; ++k) dst[n][k] = *(const PG8_LAS bf16x8*)(lds + PG8_SB(b, h) + boff + n * 2048 + k * 1024); } while (0)
#define PG8_MMA(ai, bj, At, Bt) do { __builtin_amdgcn_s_setprio(1); _Pragma("unroll") for (int m = 0; m < 4; ++m) _Pragma("unroll") for (int n = 0; n < 2; ++n) _Pragma("unroll") for (int k = 0; k < 2; ++k) \
        acc[ai][bj][m][n] = __builtin_amdgcn_mfma_f32_16x16x32_bf16(Bt[n][k], At[m][k], acc[ai][bj][m][n], 0, 0, 0); __builtin_amdgcn_s_setprio(0); } while (0)
#define PG8_WAIT_V(n) asm volatile("s_waitcnt vmcnt(" #n ")" ::: "memory")
#define PG8_WAIT_L(n) asm volatile("s_waitcnt lgkmcnt(" #n ")" ::: "memory")
#define PG8_BAR __builtin_amdgcn_s_barrier()
#define PG8_SCHED __builtin_amdgcn_sched_barrier(0)
    Unit cur, nxt; int ui = 0;
    if (!S.next(0, cur)) return;
    f32x4 acc[2][2][4][2];
#pragma unroll
    for (int a = 0; a < 2; ++a)
#pragma unroll
        for (int b = 0; b < 2; ++b)
#pragma unroll
            for (int m = 0; m < 4; ++m)
#pragma unroll
                for (int n = 0; n < 2; ++n) acc[a][b][m][n] = (f32x4){0.f, 0.f, 0.f, 0.f};
    bf16x8 At[4][2], B0[2][2], B1[2][2];
    const char* cA = (const char*)g.A + (size_t)cur.pm * tstep; const char* cB = (const char*)g.Bt + (size_t)cur.pn * tstep;
    S.a_ready(cur);
    if constexpr (SP2) {
        PG8_STAGE(PG8_SB(0, 0), cB, voffB); PG8_STAGE(PG8_SB(0, 1), cB + hstep, voffB); PG8_STAGE(PG8_SA(0, 0), cA, voffA); PG8_STAGE(PG8_SA(0, 1), cA + hstep, voffA);
        if (wr == 1) PG8_BAR;
        PG8_WAIT_V(2); PG8_BAR;
        PG8_STAGE(PG8_SB(1, 0), cB + kstep, voffB); PG8_STAGE(PG8_SA(1, 0), cA + kstep, voffA); PG8_STAGE(PG8_SB(1, 1), cB + hstep + kstep, voffB);
        PG8_WAIT_V(6); PG8_BAR;
    } else {
        PG8_STAGE(PG8_SB(0, 0), cB, voffB); PG8_STAGE(PG8_SA(0, 0), cA, voffA); PG8_STAGE(PG8_SB(0, 1), cB + hstep, voffB); PG8_STAGE(PG8_SA(0, 1), cA + hstep, voffA);
        if (wr == 1) PG8_BAR;
        PG8_WAIT_V(4); PG8_BAR;
        PG8_STAGE(PG8_SB(1, 0), cB + kstep, voffB); PG8_STAGE(PG8_SA(1, 0), cA + kstep, voffA); PG8_STAGE(PG8_SB(1, 1), cB + hstep + kstep, voffB);
        PG8_WAIT_V(6); PG8_BAR;
    }
    for (;;) {
        const bool has_next = S.next(ui + 1, nxt);
        const char* nA = has_next ? (const char*)g.A + (size_t)nxt.pm * tstep : cA; const char* nB = has_next ? (const char*)g.Bt + (size_t)nxt.pn * tstep : cB;
        for (int t = 0; t < nt; t += 2) {
            const bool last = (t == nt - 2);
            const char* a1 = cA + (size_t)(t + 1) * kstep;
            const char* a2 = last ? nA : cA + (size_t)(t + 2) * kstep; const char* b2 = last ? nB : cB + (size_t)(t + 2) * kstep;
            const char* a3 = a2 + kstep; const char* b3 = b2 + kstep;
            if (last && has_next) S.a_ready(nxt);
            if constexpr (SP2) {
            PG8_LDB(B0, 0, 0); PG8_LDB(B1, 0, 1); PG8_SCHED; PG8_LDA(At, 0, 0); PG8_STAGE(PG8_SA(1, 1), a1 + hstep, voffA);
            PG8_WAIT_V(8); PG8_WAIT_L(0); PG8_BAR; PG8_MMA(0, 0, At, B0); PG8_MMA(0, 1, At, B1); PG8_BAR; PG8_SCHED;
            PG8_LDA(At, 0, 1); PG8_STAGE(PG8_SB(0, 0), b2, voffB); PG8_STAGE(PG8_SB(0, 1), b2 + hstep, voffB); PG8_STAGE(PG8_SA(0, 0), a2, voffA);
            PG8_WAIT_V(8); PG8_WAIT_L(0); PG8_BAR; PG8_MMA(1, 0, At, B0); PG8_MMA(1, 1, At, B1); PG8_BAR; PG8_SCHED;
            PG8_LDB(B0, 1, 0); PG8_LDB(B1, 1, 1); PG8_SCHED; PG8_LDA(At, 1, 0); PG8_STAGE(PG8_SA(0, 1), a2 + hstep, voffA);
            PG8_WAIT_V(8); PG8_WAIT_L(0); PG8_BAR; PG8_MMA(0, 0, At, B0); PG8_MMA(0, 1, At, B1); PG8_BAR; PG8_SCHED;
            PG8_LDA(At, 1, 1); PG8_STAGE(PG8_SB(1, 0), b3, voffB); PG8_STAGE(PG8_SB(1, 1), b3 + hstep, voffB); PG8_STAGE(PG8_SA(1, 0), a3, voffA);
            PG8_WAIT_V(8); PG8_WAIT_L(0); PG8_BAR; PG8_MMA(1, 0, At, B0); PG8_MMA(1, 1, At, B1); PG8_BAR; PG8_SCHED;
            } else {
            PG8_LDB(B0, 0, 0); PG8_SCHED; PG8_LDA(At, 0, 0); PG8_STAGE(PG8_SA(1, 1), a1 + hstep, voffA);
            PG8_WAIT_L(8); PG8_BAR; PG8_WAIT_L(0); PG8_MMA(0, 0, At, B0); PG8_BAR; PG8_SCHED;
            PG8_LDB(B1, 0, 1); PG8_STAGE(PG8_SB(0, 0), b2, voffB);
            PG8_BAR; PG8_WAIT_L(0); PG8_MMA(0, 1, At, B1); PG8_BAR;
            PG8_LDA(At, 0, 1); PG8_STAGE(PG8_SA(0, 0), a2, voffA);
            PG8_BAR; PG8_WAIT_L(0); PG8_MMA(1, 0, At, B0); PG8_BAR; PG8_SCHED;
            PG8_STAGE(PG8_SB(0, 1), b2 + hstep, voffB);
            PG8_WAIT_V(6); PG8_BAR; PG8_MMA(1, 1, At, B1); PG8_BAR;
            PG8_LDB(B0, 1, 0); PG8_SCHED; PG8_LDA(At, 1, 0); PG8_STAGE(PG8_SA(0, 1), a2 + hstep, voffA);
            PG8_WAIT_L(8); PG8_BAR; PG8_WAIT_L(0); PG8_MMA(0, 0, At, B0); PG8_BAR; PG8_SCHED;
            PG8_LDB(B1, 1, 1); PG8_STAGE(PG8_SB(1, 0), b3, voffB);
            PG8_BAR; PG8_WAIT_L(0); PG8_MMA(0, 1, At, B1); PG8_BAR;
            PG8_LDA(At, 1, 1); PG8_STAGE(PG8_SA(1, 0), a3, voffA);
            PG8_BAR; PG8_WAIT_L(0); PG8_MMA(1, 0, At, B0); PG8_BAR; PG8_SCHED;
            PG8_STAGE(PG8_SB(1, 1), b3 + hstep, voffB);
            PG8_WAIT_V(6); PG8_BAR; PG8_MMA(1, 1, At, B1); PG8_BAR;
            }
        }
        if constexpr (ALIGN_EPI) { if (wr == 0) PG8_BAR; }
        if constexpr (!Epi::AFTER_DRAIN) { E(acc, cur, wr, wc, fr, fq); S.done(cur); }
        if (!has_next) break;
#pragma unroll
        for (int a = 0; a < 2; ++a)
#pragma unroll
            for (int b = 0; b < 2; ++b)
#pragma unroll
                for (int m = 0; m < 4; ++m)
#pragma unroll
                    for (int n = 0; n < 2; ++n) acc[a][b][m][n] = (f32x4){0.f, 0.f, 0.f, 0.f};
        cur = nxt; cA = nA; cB = nB; ++ui;
        if constexpr (ALIGN_EPI) { if (wr == 1) PG8_BAR; }
    }
    PG8_WAIT_V(0);
    if constexpr (!ALIGN_EPI) { if (wr == 0) PG8_BAR; }
    PG8_BAR;
    if constexpr (Epi::AFTER_DRAIN) { E.fused(acc, cur, wr, wc, fr, fq, lds, wid, lane); S.done(cur); }
#undef PG8_SA
#undef PG8_SB
#undef PG8_STAGE
#undef PG8_LDA
#undef PG8_LDB
#undef PG8_MMA
#undef PG8_WAIT_V
#undef PG8_WAIT_L
#undef PG8_BAR
#undef PG8_SCHED
}
}

constexpr bool PG8_SP2 = true, PG8_ALIGN = true;

#define GAS __attribute__((address_space(1)))
#define LAS __attribute__((address_space(3)))
#define XB_TMO      128
#define XB_XCNT(j)  (256  + 64 * (j))
#define XB_XSUB(j)  (1280 + 64 * (j))
#define XB_XGEN(j)  (2304 + 64 * (j))
#define XB_TOP      3328
#define XB_TOPGEN   3392
#define XCD_BAR_WORDS 3456
#define XB_SPIN_CAP (1u << 22)
__device__ __forceinline__ unsigned xb_ld(unsigned* p)              { return __hip_atomic_load(p, __ATOMIC_RELAXED, __HIP_MEMORY_SCOPE_AGENT); }
__device__ __forceinline__ unsigned xb_add(unsigned* p, unsigned v) { return __hip_atomic_fetch_add(p, v, __ATOMIC_RELAXED, __HIP_MEMORY_SCOPE_AGENT); }
__device__ __forceinline__ unsigned xb_xcc_id() { return (unsigned)__builtin_amdgcn_s_getreg((3 << 11) | 20) & 0xFu; }
#define XB_SPIN(cond, bar) do { unsigned _sp = 0; while (cond) { __builtin_amdgcn_s_sleep(1); \
    if ((++_sp & 255u) == 0u) { if (xb_ld(&(bar)[XB_TMO])) break; if (_sp > XB_SPIN_CAP) { atomicAdd(&(bar)[XB_TMO], 1u); break; } } } } while (0)
struct XcdBarrier { unsigned* bar; unsigned x; volatile LAS unsigned* st; };
__device__ __forceinline__ XcdBarrier xcd_barrier_post(unsigned* bar, volatile LAS unsigned* st) {
    XcdBarrier b; b.bar = bar; b.x = xb_xcc_id(); b.st = st;
    if (threadIdx.x == 0) (void)xb_add(&bar[XB_XCNT(b.x)], 1u);
    return b;
}
__device__ __forceinline__ void xcd_barrier_complete(unsigned* bar, unsigned x, unsigned& nloc, unsigned& nx) {
    const unsigned G = gridDim.x * gridDim.y * gridDim.z;
    unsigned sum, cnt, mine, sp = 0u;
    for (;;) {
        sum = 0u; cnt = 0u; mine = 0u;
#pragma unroll
        for (unsigned j = 0; j < 16; ++j) { const unsigned c = xb_ld(&bar[XB_XCNT(j)]); sum += c; cnt += (c > 0u) ? 1u : 0u; mine = (j == x) ? c : mine; }
        if (sum == G) break;
        __builtin_amdgcn_s_sleep(1);
        if ((++sp & 255u) == 0u) { if (xb_ld(&bar[XB_TMO])) break; if (sp > XB_SPIN_CAP) { atomicAdd(&bar[XB_TMO], 1u); break; } }
    }
    nloc = mine > 0u ? mine : 1u; nx = cnt > 0u ? cnt : 1u;
}
__device__ __forceinline__ void xcd_barrier(const XcdBarrier& b) {
    asm volatile("s_waitcnt vmcnt(0)" ::: "memory");
    __syncthreads();
    if (threadIdx.x == 0) {
        unsigned* bar = b.bar;
        __builtin_amdgcn_s_waitcnt(0);
        unsigned nloc = b.st[0], nx = b.st[1];
        if (nloc == 0u) { xcd_barrier_complete(bar, b.x, nloc, nx); b.st[0] = nloc; b.st[1] = nx; }
        const unsigned old = xb_add(&bar[XB_XSUB(b.x)], 1u);
        const unsigned gen = old / nloc;
        if (old + 1u == (gen + 1u) * nloc) {
            __builtin_amdgcn_fence(__ATOMIC_RELEASE, "agent");
            asm volatile("s_waitcnt vmcnt(0)" ::: "memory");
            const unsigned og = xb_add(&bar[XB_TOP], 1u);
            const unsigned tg = og / nx;
            if (og + 1u == (tg + 1u) * nx) xb_add(&bar[XB_TOPGEN], 1u);
            else XB_SPIN(xb_ld(&bar[XB_TOPGEN]) == tg, bar);
            __builtin_amdgcn_fence(__ATOMIC_ACQUIRE, "agent");
            xb_add(&bar[XB_XGEN(b.x)], 1u);
            asm volatile("s_waitcnt vmcnt(0)" ::: "memory");
        } else {
            XB_SPIN(xb_ld(&bar[XB_XGEN(b.x)]) == gen, bar);
            __builtin_amdgcn_fence(__ATOMIC_ACQUIRE, "agent");
            asm volatile("s_waitcnt vmcnt(0)" ::: "memory");
        }
    }
    __syncthreads();
}
__device__ __forceinline__ unsigned f2bf(float f) { unsigned u = __builtin_bit_cast(unsigned, f); return (u + 0x7fffu + ((u >> 16) & 1u)) >> 16; }
__device__ __forceinline__ unsigned pk2(float lo, float hi) { return f2bf(lo) | (f2bf(hi) << 16); }
__device__ __forceinline__ float wave_sum(float v) {
#pragma unroll
    for (int o = 1; o < 64; o <<= 1) v += __shfl_xor(v, o);
    return v;
}

__device__ void nv_rms(const float* in, int ldin, const float* g, int ncols, int nrows, const float* base, int ldbase, float alpha, float* out, int ldout, int bid, int nblk) {
    const int lane = threadIdx.x & 63, wave = threadIdx.x >> 6, nw = blockDim.x >> 6;
    for (int r = bid * nw + wave; r < nrows; r += nblk * nw) {
        const float* ir = in + (size_t)r * ldin;
        float s = 0.f;
        for (int c = lane * 4; c < ncols; c += 256) { const float4 v = *(const float4*)(ir + c); s += v.x * v.x + v.y * v.y + v.z * v.z + v.w * v.w; }
        s = wave_sum(s);
        const float rs = 1.0f / sqrtf(s / (float)ncols + RMS_EPS);
        for (int c = lane * 4; c < ncols; c += 256) {
            const float4 v = *(const float4*)(ir + c); const float4 gg = *(const float4*)(g + c);
            float4 b = make_float4(0.f, 0.f, 0.f, 0.f); if (base) b = *(const float4*)(base + (size_t)r * ldbase + c);
            float4 o; o.x = b.x + alpha * (v.x * rs * gg.x); o.y = b.y + alpha * (v.y * rs * gg.y); o.z = b.z + alpha * (v.z * rs * gg.z); o.w = b.w + alpha * (v.w * rs * gg.w);
            *(float4*)(out + (size_t)r * ldout + c) = o;
        }
    }
}

template <int MODE>
__device__ void nv_gemm(const float* A, int lda, const float* B, const float* B2, int ldb, float* C, int ldc, int M, int N, int K, const float* bias, float* smem, int bid, int nblk) {
    float* As = smem;
    float* Bs = smem + 16 * 132;
    float* B2s = Bs + 16 * 64;
    const int t = threadIdx.x, ty = t >> 4, tx = t & 15;
    const int ntm = M / 128, ntn = N / 64;
    for (int tile = bid; tile < ntm * ntn; tile += nblk) {
        const int tm = tile / ntn, tn = tile % ntn, m0 = tm * 128, n0 = tn * 64;
        float acc[4][4], acc2[4][4];
#pragma unroll
        for (int i = 0; i < 4; ++i)
#pragma unroll
            for (int j = 0; j < 4; ++j) { acc[i][j] = 0.f; acc2[i][j] = 0.f; }
        for (int k0 = 0; k0 < K; k0 += 16) {
            {
                const int r = t >> 2, kc = (t & 3) * 4;
                const float4 v = *(const float4*)(A + (size_t)(m0 + r) * lda + k0 + kc);
                As[(kc + 0) * 132 + r] = v.x; As[(kc + 1) * 132 + r] = v.y; As[(kc + 2) * 132 + r] = v.z; As[(kc + 3) * 132 + r] = v.w;
            }
            {
                const int kr = t >> 5, c2 = (t & 31) * 2;
                const float2 v = *(const float2*)(B + (size_t)(k0 + kr) * ldb + n0 + c2);
                Bs[kr * 64 + c2] = v.x; Bs[kr * 64 + c2 + 1] = v.y;
                if (MODE == 1) { const float2 w = *(const float2*)(B2 + (size_t)(k0 + kr) * ldb + n0 + c2); B2s[kr * 64 + c2] = w.x; B2s[kr * 64 + c2 + 1] = w.y; }
            }
            __syncthreads();
#pragma unroll
            for (int kk = 0; kk < 16; ++kk) {
                const float4 a = *(const float4*)(As + kk * 132 + ty * 4);
                const float4 b = *(const float4*)(Bs + kk * 64 + tx * 4);
                const float av[4] = {a.x, a.y, a.z, a.w}, bv[4] = {b.x, b.y, b.z, b.w};
#pragma unroll
                for (int i = 0; i < 4; ++i)
#pragma unroll
                    for (int j = 0; j < 4; ++j) acc[i][j] += av[i] * bv[j];
                if (MODE == 1) {
                    const float4 b2 = *(const float4*)(B2s + kk * 64 + tx * 4);
                    const float b2v[4] = {b2.x, b2.y, b2.z, b2.w};
#pragma unroll
                    for (int i = 0; i < 4; ++i)
#pragma unroll
                        for (int j = 0; j < 4; ++j) acc2[i][j] += av[i] * b2v[j];
                }
            }
            __syncthreads();
        }
#pragma unroll
        for (int i = 0; i < 4; ++i) {
            const int r = m0 + ty * 4 + i, c = n0 + tx * 4;
            float o[4];
#pragma unroll
            for (int j = 0; j < 4; ++j) {
                float v = acc[i][j];
                if (MODE == 1) { const float sg = 1.0f / (1.0f + expf(-v)); v = v * sg * acc2[i][j]; }
                if (MODE == 2) { const float zz = v + bias[c + j]; const float sg = 1.0f / (1.0f + expf(-zz)); v = A[(size_t)r * lda + c + j] * sg; }
                o[j] = v;
            }
            *(float4*)(C + (size_t)r * ldc + c) = make_float4(o[0], o[1], o[2], o[3]);
        }
    }
}

__device__ __forceinline__ float bf2f(unsigned short b) { return __uint_as_float((unsigned)b << 16); }
__device__ void nv_kmean(const unsigned short* k, int ldk, float* kmean, int bid, int nblk) {
    for (int idx = bid * blockDim.x + threadIdx.x; idx < BATCH * NBLK * D_ATTN; idx += nblk * blockDim.x) {
        const int c = idx % D_ATTN, bn = idx / D_ATTN;
        const unsigned short* p = k + (size_t)bn * MOBA_L * ldk + c;
        float s = 0.f;
        for (int r = 0; r < MOBA_L; ++r) s += bf2f(p[(size_t)r * ldk]);
        kmean[idx] = s * (1.0f / MOBA_L);
    }
}

__device__ void nv_attn(const unsigned short* q, const unsigned short* k, const unsigned short* v, int ld, const float* kmean, unsigned short* out, int ldo, int bid, int nblk) {
    const int lane = threadIdx.x & 63, wave = threadIdx.x >> 6, nw = blockDim.x >> 6;
    const int nwu = BATCH * NH * (SEQ / 64);
    for (int wu = bid * nw + wave; wu < nwu; wu += nblk * nw) {
        const int wuu = __builtin_amdgcn_readfirstlane(wu);
        const int tc = wuu % (SEQ / 64), bh = wuu / (SEQ / 64), h = bh % NH, b = bh / NH;
        const int t = tc * 64 + lane, qb = (tc * 64) / MOBA_L;
        const float slope = exp2f(-(float)(h + 1));
        float qv[HD];
        const unsigned short* qp = q + (size_t)(b * SEQ + t) * ld + h * HD;
#pragma unroll
        for (int d = 0; d < HD; ++d) qv[d] = bf2f(qp[d]);
        float gate[NBLK];
#pragma unroll
        for (int n = 0; n < NBLK; ++n) {
            gate[n] = -1e30f;
            if (n < qb) { const float* km = kmean + (size_t)(b * NBLK + n) * D_ATTN + h * HD; float s = 0.f;
#pragma unroll
                for (int d = 0; d < HD; ++d) s += qv[d] * km[d];
                gate[n] = s; }
        }
        unsigned selmask = 0u;
#pragma unroll
        for (int n = 0; n < NBLK; ++n) {
            int rank = 0;
#pragma unroll
            for (int m2 = 0; m2 < NBLK; ++m2) { if (m2 < qb && (gate[m2] > gate[n] || (gate[m2] == gate[n] && m2 < n))) ++rank; }
            if (n < qb && rank < 3) selmask |= (1u << n);
        }
        float mrun = -INFINITY, lrun = 0.f, o[HD];
#pragma unroll
        for (int d = 0; d < HD; ++d) o[d] = 0.f;
        for (int n = 0; n <= qb; ++n) {
            const bool sel = (n == qb) || ((selmask >> n) & 1u);
            if (!__any(sel)) continue;
            for (int j = 0; j < MOBA_L; ++j) {
                const int kp = n * MOBA_L + j;
                const unsigned short* kr = k + (size_t)(b * SEQ + kp) * ld + h * HD;
                const unsigned short* vr = v + (size_t)(b * SEQ + kp) * ld + h * HD;
                float s = 0.f;
#pragma unroll
                for (int d = 0; d < HD; ++d) s += qv[d] * bf2f(kr[d]);
                s = s * 0.125f - slope * (float)(t - kp);
                const bool valid = sel && (kp <= t);
                if (valid) {
                    const float mn = fmaxf(mrun, s), corr = expf(mrun - mn), p = expf(s - mn);
                    lrun = lrun * corr + p;
#pragma unroll
                    for (int d = 0; d < HD; ++d) o[d] = o[d] * corr + p * bf2f(vr[d]);
                    mrun = mn;
                }
            }
        }
        const float inv = 1.0f / lrun;
        unsigned short* op = out + (size_t)(b * SEQ + t) * ldo + h * HD;
#pragma unroll
        for (int d = 0; d < HD; d += 2) *(unsigned*)(op + d) = pk2(o[d] * inv, o[d + 1] * inv);
    }
}

__device__ __forceinline__ float gelu_tanh(float x) { const float u = 0.7978845608028654f * (x + 0.044715f * x * x * x); return 0.5f * x * (1.0f + tanhf(u)); }

__device__ void nv_ssm(const unsigned short* us, int ldu, const float* lam_re, const float* lam_im, const float* log_dt, const float* b_re, const float* b_im,
                       const float* c_re, const float* c_im, const float* d_skip, unsigned short* yout, int ldy, int bid, int nblk) {
    const int lane = threadIdx.x & 63, wave = threadIdx.x >> 6, nw = blockDim.x >> 6;
    for (int wu = bid * nw + wave; wu < BATCH * NG; wu += nblk * nw) {
        const int wuu = __builtin_amdgcn_readfirstlane(wu);
        const int g = wuu % NG, b = wuu / NG, p = lane;
        const double lr = (double)lam_re[g * SSM_P + p], li = (double)lam_im[g * SSM_P + p], dt = exp((double)log_dt[g]);
        const double mag = exp(lr * dt), ang = li * dt, are = mag * cos(ang), aim = mag * sin(ang), den = lr * lr + li * li;
        const double fre = ((are - 1.0) * lr + aim * li) / den, fim = (aim * lr - (are - 1.0) * li) / den;
        const float a_re = (float)are, a_im = (float)aim;
        float bbr[SSM_GROUP], bbi[SSM_GROUP], cr[SSM_GROUP], ci[SSM_GROUP];
#pragma unroll
        for (int h = 0; h < SSM_GROUP; ++h) {
            const double br = (double)b_re[(g * SSM_P + p) * SSM_GROUP + h], bi = (double)b_im[(g * SSM_P + p) * SSM_GROUP + h];
            bbr[h] = (float)(fre * br - fim * bi); bbi[h] = (float)(fre * bi + fim * br);
            cr[h] = c_re[(g * SSM_GROUP + h) * SSM_P + p]; ci[h] = c_im[(g * SSM_GROUP + h) * SSM_P + p];
        }
        const float dsk = (lane < SSM_GROUP) ? d_skip[g * SSM_GROUP + lane] : 0.f;
        float hre = 0.f, him = 0.f;
        for (int t = 0; t < SEQ; ++t) {
            const unsigned short* up = us + (size_t)(b * SEQ + t) * ldu + g * SSM_GROUP;
            float xr = 0.f, xi = 0.f, uu[SSM_GROUP];
#pragma unroll
            for (int h = 0; h < SSM_GROUP; ++h) { uu[h] = bf2f(up[h]); xr += uu[h] * bbr[h]; xi += uu[h] * bbi[h]; }
            const float nre = a_re * hre - a_im * him + xr, nim = a_re * him + a_im * hre + xi;
            hre = nre; him = nim;
            float mine = 0.f, myu = 0.f;
#pragma unroll
            for (int h = 0; h < SSM_GROUP; ++h) { const float tot = wave_sum(hre * cr[h] - him * ci[h]); if (lane == h) { mine = tot; myu = uu[h]; } }
            if (lane < SSM_GROUP) { const float y = mine + dsk * myu; yout[(size_t)(b * SEQ + t) * ldy + g * SSM_GROUP + lane] = (unsigned short)f2bf(gelu_tanh(y)); }
        }
    }
}


#include <hip/hip_bf16.h>
#include <cmath>
namespace attn_body {
using bf16=__hip_bfloat16;
using bf16x8=__attribute__((ext_vector_type(8)))short;
using s16x4=__attribute__((ext_vector_type(4)))short;
using f32x16=__attribute__((ext_vector_type(16)))float;
using u32x4=__attribute__((ext_vector_type(4)))unsigned;
constexpr int BATCH=8,NHEAD=8,SEQ=2048,D=64,DM=NHEAD*D;
constexpr int NW=8,QBLK=32,QB=QBLK*NW,KVBLK=64,NQB=SEQ/QB;
constexpr int ATTN_PITCH=DM, ATTN_UNIT_ROWS=QB;
__device__ __forceinline__ int crow(int r,int hi){return (r&3)+8*(r>>2)+4*hi;}
#define SBAR() __builtin_amdgcn_sched_barrier(0)
__device__ __forceinline__ void cmask(f32x16&p0,f32x16&p1,int jb,int qrel,int hi){
  const float NEG=-INFINITY; int kb=64*jb+4*hi;
  #pragma unroll
  for(int r=0;r<16;++r){int kv=kb+(r&3)+8*(r>>2); if(kv>qrel)p0[r]=NEG; if(kv+32>qrel)p1[r]=NEG;}
}

constexpr int NSLOT=3, SLOTB=8192;
constexpr int LDS_K=0, LDS_V=NSLOT*SLOTB, LDS_WS=2*NSLOT*SLOTB, LDS_OST=LDS_WS+NW*64*4, LDS_BYTES=LDS_OST+NW*4096;
constexpr float C2=0.125f*1.4426950408889634f;
__device__ __forceinline__ void glds16(const void*gsrc,unsigned lds_dst){unsigned keep;
  asm volatile("s_mov_b32 %0, m0\n\ts_mov_b32 m0, %2\n\ts_nop 0\n\tglobal_load_lds_dwordx4 %1, off\n\ts_mov_b32 m0, %0":"=&s"(keep):"v"(gsrc),"s"(lds_dst):"memory");}
__device__ __forceinline__ float max3f(float a,float b,float c){float r;asm("v_max3_f32 %0, %1, %2, %3":"=v"(r):"v"(a),"v"(b),"v"(c));return r;}
__device__ __forceinline__ float max2f(float a,float b){float r;asm("v_max_f32_e32 %0, %1, %2":"=v"(r):"v"(a),"v"(b));return r;}
__device__ __forceinline__ float fadd_s(float a,float b){float r;asm("v_add_f32_e32 %0, %1, %2":"=v"(r):"v"(a),"v"(b));return r;}
__device__ __forceinline__ float fsub_s(float a,float b){float r;asm("v_sub_f32_e32 %0, %1, %2":"=v"(r):"v"(a),"v"(b));return r;}
typedef float f32x2_t __attribute__((ext_vector_type(2))); typedef __bf16 bf16x2_t __attribute__((ext_vector_type(2)));
__device__ __forceinline__ unsigned cvtpk_s(float lo,float hi){f32x2_t v={lo,hi};bf16x2_t b=__builtin_convertvector(v,bf16x2_t);return __builtin_bit_cast(unsigned,b);}
#define WAIT_BAR(N) asm volatile("s_waitcnt vmcnt(" #N ") lgkmcnt(0)\n\ts_barrier":::"memory")

__device__ __forceinline__ void qkt(f32x16&p0,f32x16&p1,const char*Kslot,const bf16x8*qr,int r32,int hi,bf16x8 ka0,bf16x8 ka1,bf16x8 qa){ const f32x16 negm=f32x16{};
  const char*kb=Kslot+hi*1024+r32*16;
  #pragma unroll
  for(int d0=0;d0<4;++d0){
    const bf16x8 b0=*reinterpret_cast<const bf16x8*>(kb+d0*2048);
    const bf16x8 b1=*reinterpret_cast<const bf16x8*>(kb+d0*2048+512);
    if(d0==0){p0=__builtin_amdgcn_mfma_f32_32x32x16_bf16(b0,qr[0],negm,0,0,0);p1=__builtin_amdgcn_mfma_f32_32x32x16_bf16(b1,qr[0],negm,0,0,0);}
    else{p0=__builtin_amdgcn_mfma_f32_32x32x16_bf16(b0,qr[d0],p0,0,0,0);p1=__builtin_amdgcn_mfma_f32_32x32x16_bf16(b1,qr[d0],p1,0,0,0);}}
  p0=__builtin_amdgcn_mfma_f32_32x32x16_bf16(ka0,qa,p0,0,0,0);p1=__builtin_amdgcn_mfma_f32_32x32x16_bf16(ka1,qa,p1,0,0,0);
}
typedef __attribute__((address_space(3))) const char* lds_cptr;
typedef short v4i16_t __attribute__((ext_vector_type(4)));
__device__ __forceinline__ void kload8(bf16x8*kf,lds_cptr kp){
  kf[0]=*(const __attribute__((address_space(3))) bf16x8*)(kp);      kf[1]=*(const __attribute__((address_space(3))) bf16x8*)(kp+512);
  kf[2]=*(const __attribute__((address_space(3))) bf16x8*)(kp+2048); kf[3]=*(const __attribute__((address_space(3))) bf16x8*)(kp+2560);
  kf[4]=*(const __attribute__((address_space(3))) bf16x8*)(kp+4096); kf[5]=*(const __attribute__((address_space(3))) bf16x8*)(kp+4608);
  kf[6]=*(const __attribute__((address_space(3))) bf16x8*)(kp+6144); kf[7]=*(const __attribute__((address_space(3))) bf16x8*)(kp+6656);
}
__device__ __forceinline__ void kload2(bf16x8*kf,lds_cptr kp,int j){ kf[2*j]=*(const __attribute__((address_space(3))) bf16x8*)(kp+j*2048); kf[2*j+1]=*(const __attribute__((address_space(3))) bf16x8*)(kp+j*2048+512); }
__device__ __forceinline__ s16x4 vtr(lds_cptr p){ return __builtin_bit_cast(s16x4,__builtin_amdgcn_ds_read_tr16_b64_v4i16((__attribute__((address_space(3))) v4i16_t*)p)); }
__device__ __forceinline__ float rowmax(const f32x16&p0,const f32x16&p1){
  float a=max3f(p0[0],p0[1],p1[0]),b=max3f(p0[2],p0[3],p1[1]);a=max3f(a,p1[2],p1[3]);
  #pragma unroll
  for(int r=4;r<16;r+=4){a=max3f(a,p0[r],p0[r+1]);b=max3f(b,p0[r+2],p0[r+3]);a=max3f(a,p1[r],p1[r+1]);b=max3f(b,p1[r+2],p1[r+3]);}
  const float m=max2f(a,b);
  auto rr=__builtin_amdgcn_permlane32_swap(__float_as_uint(m),__float_as_uint(m),false,false);
  return max2f(__uint_as_float(rr[0]),__uint_as_float(rr[1]));
}
__device__ __forceinline__ void pv(f32x16*o,int vb,bf16x8 pa0,bf16x8 pa1,bf16x8 pa2,bf16x8 pa3){
  #pragma unroll
  for(int d0=0;d0<2;++d0){s16x4 lo[4],hi[4];
    #pragma unroll
    for(int ks=0;ks<4;++ks){
      asm volatile("ds_read_b64_tr_b16 %0,%1 offset:%c2":"=&v"(lo[ks]):"v"(vb),"i"(d0*4096+ks*1024):"memory");
      asm volatile("ds_read_b64_tr_b16 %0,%1 offset:%c2":"=&v"(hi[ks]):"v"(vb),"i"(d0*4096+ks*1024+512):"memory");}
    asm volatile("s_waitcnt lgkmcnt(0)":::"memory");SBAR();
    #define PK(k) (bf16x8){lo[k][0],lo[k][1],lo[k][2],lo[k][3],hi[k][0],hi[k][1],hi[k][2],hi[k][3]}
    o[d0]=__builtin_amdgcn_mfma_f32_32x32x16_bf16(pa0,PK(0),o[d0],0,0,0);
    o[d0]=__builtin_amdgcn_mfma_f32_32x32x16_bf16(pa1,PK(1),o[d0],0,0,0);
    o[d0]=__builtin_amdgcn_mfma_f32_32x32x16_bf16(pa2,PK(2),o[d0],0,0,0);
    o[d0]=__builtin_amdgcn_mfma_f32_32x32x16_bf16(pa3,PK(3),o[d0],0,0,0);
    #undef PK
  }
}

#ifndef ATTN_STORE16
#define ATTN_STORE16(p,v) (*(u32x4*)(p)=(v))
#endif
__device__ __forceinline__ unsigned bfr(float x){ const unsigned u=__float_as_uint(x); return (u+0x7fffu+((u>>16)&1u))>>16; }
template<int THRL> __device__ __forceinline__ void attn_unit(int b,int h,int qb,const bf16*Q,const bf16*__restrict__ K,const bf16*__restrict__ V,bf16*O,const float*kmean,char*shm){
  int tid_=threadIdx.x; asm volatile("":"+v"(tid_)); const int tid=tid_,lane=tid&63,r32=lane&31,hi=lane>>5; const int wid=__builtin_amdgcn_readfirstlane(tid>>6);
  const long rowbase=(long)b*SEQ; const int q0=qb*QB;
  const bf16*Qw=Q+(rowbase+q0+wid*QBLK)*DM+h*D;
  const bf16*Kh=K+rowbase*DM+h*D,*Vh=V+rowbase*DM+h*D;
  const unsigned lds0=(unsigned)(uintptr_t)shm;
  float*wsf=(float*)(shm+LDS_WS)+wid*64;
  const bf16*ksrc=Kh+(long)lane*DM+wid*8;
  const bf16*vsrc=Vh+(long)(16*(wid&3)+(lane>>2))*DM+(wid>>2)*32+(lane&3)*8;
  const unsigned kdst=lds0+LDS_K+wid*1024, vdst=lds0+LDS_V+wid*1024;
  #define DMA_K(t,slot) glds16(ksrc+(long)(t)*KVBLK*DM,(unsigned)__builtin_amdgcn_readfirstlane(kdst+(slot)))
  #define DMA_V(t,slot) glds16(vsrc+(long)(t)*KVBLK*DM,(unsigned)__builtin_amdgcn_readfirstlane(vdst+(slot)))
  const int vb0=(int)(lds0+LDS_V)+((lane>>4)&1)*32+(lane&3)*8+(4*hi+((lane&15)>>2))*64;
  const char*Kbase=shm+LDS_K; bf16x8 kf[8];
  const lds_cptr shm3=(lds_cptr)shm; const lds_cptr kp0=shm3+LDS_K+hi*1024+r32*16; const lds_cptr vp0=shm3+LDS_V+((lane>>4)&1)*32+(lane&3)*8+(4*hi+((lane&15)>>2))*64;
  const int NT=(q0+QB)/KVBLK;
  DMA_K(0,0);DMA_V(0,0);DMA_K(1,SLOTB);
  bf16x8 qr[4];
  #pragma unroll
  for(int d0=0;d0<4;++d0)qr[d0]=*reinterpret_cast<const bf16x8*>(&Qw[(long)r32*DM+d0*16+hi*8]);
  unsigned selmask=0xffu;
  if(qb>=4){
    float g[7];
    #pragma unroll
    for(int n=0;n<7;++n){ g[n]=0.f;
      if(n<qb){ const float*km=kmean+((size_t)(b*8+n)*DM+h*D)+8*hi; float s=0.f;
        #pragma unroll
        for(int d0=0;d0<4;++d0){ const float4 k0=*(const float4*)(km+16*d0),k1=*(const float4*)(km+16*d0+4); const float kk[8]={k0.x,k0.y,k0.z,k0.w,k1.x,k1.y,k1.z,k1.w};
          #pragma unroll
          for(int j=0;j<8;++j)s+=__uint_as_float(((unsigned)(unsigned short)qr[d0][j])<<16)*kk[j]; }
        auto rr=__builtin_amdgcn_permlane32_swap(__float_as_uint(s),__float_as_uint(s),false,false); g[n]=__uint_as_float(rr[0])+__uint_as_float(rr[1]); } }
    selmask=0u;
    #pragma unroll
    for(int n=0;n<7;++n){ int rank=0;
      #pragma unroll
      for(int m2=0;m2<7;++m2){ if(m2<qb&&(g[m2]>g[n]||(g[m2]==g[n]&&m2<n)))++rank; }
      if(n<qb&&rank<3)selmask|=(1u<<n); }
  }
  const unsigned lanemask=(unsigned)hi-1u;
  unsigned qaw0,qaw1,kw1a,kw1b;
  { const float slope2=__builtin_amdgcn_exp2f(-(float)(h+1))*1.4426950408889634f; const unsigned shi_b=bfr(slope2); const float shi_f=__uint_as_float(shi_b<<16); const unsigned slo_b=bfr(slope2-shi_f);
    qaw0=(bfr(64.f*shi_f)|(bfr(64.f*__uint_as_float(slo_b<<16))<<16))&lanemask; qaw1=(shi_b|(slo_b<<16))&lanemask;
    const unsigned ba=bfr((float)r32),bb=bfr((float)(r32+32)); kw1a=(ba|(ba<<16))&lanemask; kw1b=(bb|(bb<<16))&lanemask; }
  unsigned qaw2m=0u,qaw3=0u;
  #define MSPLIT() do{ const float x_=-mhat; const unsigned b1_=bfr(x_); const float r1_=x_-__uint_as_float(b1_<<16); const unsigned b2_=bfr(r1_); const float r2_=r1_-__uint_as_float(b2_<<16); \
      qaw2m=(b1_<<16)&lanemask; qaw3=(b2_|(bfr(r2_)<<16))&lanemask; }while(0)
  #define AUG(t_,KA0,KA1,QA) const int t__=(t_); const float af_=(float)(t__-4*qb); const unsigned aw_=bfr(af_); const unsigned w0_=(aw_|(aw_<<16))&lanemask; \
      const bool sel_=(t__>=NT-4)||((selmask>>(t__>>2))&1u); const unsigned w2_=((sel_?0u:0x0000f14au)&lanemask)|qaw2m; const unsigned on_=0x3f803f80u&lanemask; \
      const bf16x8 KA0=__builtin_bit_cast(bf16x8,(u32x4){w0_,kw1a,on_,on_}); const bf16x8 KA1=__builtin_bit_cast(bf16x8,(u32x4){w0_,kw1b,on_,on_}); const bf16x8 QA=__builtin_bit_cast(bf16x8,(u32x4){qaw0,qaw1,w2_,qaw3});
  const f32x16 negm=f32x16{};
  float mhat=0.f,l_reg=0.f;f32x16 o[2];o[0]=f32x16{};o[1]=f32x16{};
  const int qrel=wid*QBLK+r32;
  #define CMASK(P0,P1,t) do{int jb_=(t)-(NT-4); if(jb_>=0)cmask(P0,P1,jb_,qrel,hi);}while(0)
  bool resc=false;
  #define START(P0,P1) do{ const float rm=rowmax(P0,P1); resc=false; \
    { const float dl=(rm<-1e29f)?0.f:rm; mhat=fadd_s(mhat,dl); \
      _Pragma("unroll") for(int r=0;r<16;++r){P0[r]=fsub_s(P0[r],dl);P1[r]=fsub_s(P1[r],dl);} \
      MSPLIT(); } \
    _Pragma("unroll") for(int r=0;r<16;++r)P0[r]=__builtin_amdgcn_exp2f(P0[r]); }while(0)
  #define RESC() do{ if(resc){ asm volatile("s_waitcnt lgkmcnt(0)":::"memory"); \
      _Pragma("unroll") for(int d_=0;d_<2;++d_) _Pragma("unroll") for(int r=0;r<16;++r)o[d_][r]*=wsf[crow(r,hi)]; } }while(0)
  f32x16 pA0,pA1,pB0,pB1;
  int sl_prev=0,sl_cur=0,sl_next=SLOTB;
  #define ROT() do{sl_prev=sl_cur;sl_cur=sl_next;sl_next=(sl_next==(NSLOT-1)*SLOTB)?0:sl_next+SLOTB;}while(0)
  DMA_K(2,2*SLOTB);
  WAIT_BAR(3);
  { AUG(0,ka0_,ka1_,qa_) qkt(pA0,pA1,Kbase,qr,r32,hi,ka0_,ka1_,qa_); } asm volatile("s_nop 15\n\ts_nop 7":"+v"(pA0),"+v"(pA1));CMASK(pA0,pA1,0);
  START(pA0,pA1);
  _Pragma("unroll") for(int r=0;r<16;++r)pA1[r]=__builtin_amdgcn_exp2f(pA1[r]);
  WAIT_BAR(0);
  DMA_K(3,0);DMA_V(1,SLOTB);
  ROT();
  kload8(kf,kp0+sl_cur);
  WAIT_BAR(2);
  s16x4 vlo[8],vhi[8]; u32x4 pw0,pw1,pw2,pw3;
  #define PKW(P,B) cvtpk_s(P[B],P[B+1])
  #define PAF(k) __builtin_bit_cast(bf16x8,pw##k)
  #define VFR(i) (bf16x8){vlo[i][0],vlo[i][1],vlo[i][2],vlo[i][3],vhi[i][0],vhi[i][1],vhi[i][2],vhi[i][3]}
  #define PIN(x) asm volatile("":"+v"(x))
  #define MX3(a,b,c) __builtin_fmaxf(__builtin_fmaxf((a),(b)),(c))
  #define GAPA(MF,A0,A1,A2,A3,W0,W1,PW) do{ MF; sacc+=A0; sacc+=A1; sacc+=A2; sacc+=A3; PIN(sacc); W0; W1; PIN(PW); SBAR(); }while(0)
  #define EX(v) __builtin_amdgcn_exp2f(v)
  #define GAPB(MF,X,B) do{ MF; X[B]=EX(X[B]); X[B+1]=EX(X[B+1]); X[B+2]=EX(X[B+2]); X[B+3]=EX(X[B+3]); PIN(X); SBAR(); }while(0)
  #define VRD(i) do{ vlo[i]=vtr(vp_+(((i)>>2)*4096+((i)&3)*1024)); vhi[i]=vtr(vp_+(((i)>>2)*4096+((i)&3)*1024+512)); }while(0)
  #define KRD(G,j) do{ if(G){ kload2(kf,kp0+sl_next,j); SBAR(); } }while(0)
  #define STEP(C0,C1,P0,P1,t,GK,GV,GL) do{ SBAR(); \
    const lds_cptr vp_=vp0+sl_prev; \
    VRD(0); SBAR(); float sacc=(P0[0]+P0[1]); \
    GAPA(C0=__builtin_amdgcn_mfma_f32_32x32x16_bf16(kf[0],qr[0],negm,0,0,0), P0[2],P0[3],P0[4],P0[5],     pw0[0]=PKW(P0,0), pw0[1]=PKW(P0,2), pw0); \
    VRD(4); SBAR(); GAPA(C1=__builtin_amdgcn_mfma_f32_32x32x16_bf16(kf[1],qr[0],negm,0,0,0), P0[6],P0[7],P0[8],P0[9],     pw0[2]=PKW(P0,4), pw0[3]=PKW(P0,6), pw0); \
    VRD(1); SBAR(); GAPA(C0=__builtin_amdgcn_mfma_f32_32x32x16_bf16(kf[2],qr[1],C0,0,0,0),   P0[10],P0[11],P0[12],P0[13], pw1[0]=PKW(P0,8), pw1[1]=PKW(P0,10), pw1); \
    VRD(5); SBAR(); GAPA(C1=__builtin_amdgcn_mfma_f32_32x32x16_bf16(kf[3],qr[1],C1,0,0,0),   P0[14],P0[15],P1[0],P1[1],   pw1[2]=PKW(P0,12),pw1[3]=PKW(P0,14), pw1); \
    VRD(2); SBAR(); GAPA(C0=__builtin_amdgcn_mfma_f32_32x32x16_bf16(kf[4],qr[2],C0,0,0,0),   P1[2],P1[3],P1[4],P1[5],     pw2[0]=PKW(P1,0), pw2[1]=PKW(P1,2), pw2); \
    VRD(6); SBAR(); GAPA(C1=__builtin_amdgcn_mfma_f32_32x32x16_bf16(kf[5],qr[2],C1,0,0,0),   P1[6],P1[7],P1[8],P1[9],     pw2[2]=PKW(P1,4), pw2[3]=PKW(P1,6), pw2); \
    VRD(3); SBAR(); GAPA(C0=__builtin_amdgcn_mfma_f32_32x32x16_bf16(kf[6],qr[3],C0,0,0,0),   P1[10],P1[11],P1[12],P1[13], pw3[0]=PKW(P1,8), pw3[1]=PKW(P1,10), pw3); \
    VRD(7); SBAR(); GAPA(C1=__builtin_amdgcn_mfma_f32_32x32x16_bf16(kf[7],qr[3],C1,0,0,0),   P1[14],P1[15],0.f,0.f,       pw3[2]=PKW(P1,12),pw3[3]=PKW(P1,14), pw3); \
    { AUG(t,ka0_,ka1_,qa_) C0=__builtin_amdgcn_mfma_f32_32x32x16_bf16(ka0_,qa_,C0,0,0,0); SBAR(); C1=__builtin_amdgcn_mfma_f32_32x32x16_bf16(ka1_,qa_,C1,0,0,0); } SBAR(); \
    l_reg+=sacc; \
    if(GK){DMA_K((t)+3,sl_cur);} if(GV){DMA_V((t)+1,sl_next);} \
    CMASK(C0,C1,t); \
    { float a=MX3(C0[0],C0[1],C1[0]),b=MX3(C0[2],C0[3],C1[1]); a=MX3(a,C1[2],C1[3]); \
      _Pragma("unroll") for(int r=4;r<16;r+=4){a=MX3(a,C0[r],C0[r+1]);b=MX3(b,C0[r+2],C0[r+3]);a=MX3(a,C1[r],C1[r+1]);b=MX3(b,C1[r+2],C1[r+3]);} \
      float rm=__builtin_fmaxf(a,b); { auto rr=__builtin_amdgcn_permlane32_swap(__float_as_uint(rm),__float_as_uint(rm),false,false); rm=__builtin_fmaxf(__uint_as_float(rr[0]),__uint_as_float(rr[1])); } \
      resc=false; \
      if(__builtin_expect(__any(rm>(float)THRL),0)){ const float dl=__builtin_fmaxf(rm,0.f); mhat+=dl; \
        _Pragma("unroll") for(int r=0;r<16;++r){C0[r]-=dl;C1[r]-=dl;} \
        MSPLIT(); \
        const float f=__builtin_amdgcn_exp2f(-dl); l_reg*=f; if(hi==0)wsf[r32]=f; resc=true; } } \
    SBAR(); \
    GAPB(o[0]=__builtin_amdgcn_mfma_f32_32x32x16_bf16(PAF(0),VFR(0),o[0],0,0,0), C0,0); \
    GAPB(o[1]=__builtin_amdgcn_mfma_f32_32x32x16_bf16(PAF(0),VFR(4),o[1],0,0,0), C0,4); \
    KRD(GL,0); GAPB(o[0]=__builtin_amdgcn_mfma_f32_32x32x16_bf16(PAF(1),VFR(1),o[0],0,0,0), C0,8); \
    KRD(GL,1); GAPB(o[1]=__builtin_amdgcn_mfma_f32_32x32x16_bf16(PAF(1),VFR(5),o[1],0,0,0), C0,12); \
    KRD(GL,2); GAPB(o[0]=__builtin_amdgcn_mfma_f32_32x32x16_bf16(PAF(2),VFR(2),o[0],0,0,0), C1,0); \
    KRD(GL,3); GAPB(o[1]=__builtin_amdgcn_mfma_f32_32x32x16_bf16(PAF(2),VFR(6),o[1],0,0,0), C1,4); \
    GAPB(o[0]=__builtin_amdgcn_mfma_f32_32x32x16_bf16(PAF(3),VFR(3),o[0],0,0,0), C1,8); \
    GAPB(o[1]=__builtin_amdgcn_mfma_f32_32x32x16_bf16(PAF(3),VFR(7),o[1],0,0,0), C1,12); \
    }while(0)
  int t=1;
  #undef CMASK
  #define CMASK(P0,P1,t) do{}while(0)
  for(;t+5<NT;t+=2){
    STEP(pB0,pB1,pA0,pA1,t,true,true,true);     WAIT_BAR(2); RESC(); ROT();
    STEP(pA0,pA1,pB0,pB1,t+1,true,true,true);   WAIT_BAR(2); RESC(); ROT();
  }
  #undef CMASK
  #define CMASK(P0,P1,t) do{int jb_=(t)-(NT-4); if(jb_>=0)cmask(P0,P1,jb_,qrel,hi);}while(0)
  #define ENDW(tt) do{ if((tt)+3<NT){WAIT_BAR(2);} else if((tt)+2<NT){WAIT_BAR(1);} else {WAIT_BAR(0);} }while(0)
  for(;t+1<NT;t+=2){
    STEP(pB0,pB1,pA0,pA1,t,(t+3<NT),(t+1<NT),(t+1<NT));       ENDW(t);   RESC(); ROT();
    STEP(pA0,pA1,pB0,pB1,t+1,(t+4<NT),(t+2<NT),(t+2<NT));     ENDW(t+1); RESC(); ROT();
  }
  STEP(pB0,pB1,pA0,pA1,NT-1,false,false,false); RESC();
  { float sacc=pB0[0]+pB0[1]; _Pragma("unroll") for(int r=2;r<16;++r)sacc+=pB0[r]; _Pragma("unroll") for(int r=0;r<16;++r)sacc+=pB1[r]; l_reg+=sacc;
    pw0=(u32x4){PKW(pB0,0),PKW(pB0,2),PKW(pB0,4),PKW(pB0,6)};pw1=(u32x4){PKW(pB0,8),PKW(pB0,10),PKW(pB0,12),PKW(pB0,14)};pw2=(u32x4){PKW(pB1,0),PKW(pB1,2),PKW(pB1,4),PKW(pB1,6)};pw3=(u32x4){PKW(pB1,8),PKW(pB1,10),PKW(pB1,12),PKW(pB1,14)};
    SBAR(); pv(o,vb0+sl_cur,PAF(0),PAF(1),PAF(2),PAF(3)); }
  #undef PKW
  #undef PAF
  #undef VFR
  #undef PIN
  #undef MX3
  #undef GAPA
  #undef GAPB
  #undef EX
  #undef VRD
  #undef KRD
  #undef STEP
  #undef ENDW
  {auto rr=__builtin_amdgcn_permlane32_swap(__float_as_uint(l_reg),__float_as_uint(l_reg),false,false);l_reg=__uint_as_float(rr[0])+__uint_as_float(rr[1]);}
  if(hi==0)wsf[32+r32]=l_reg;asm volatile("s_waitcnt lgkmcnt(0)":::"memory");
  float rli[16];
  #pragma unroll
  for(int r=0;r<16;++r)rli[r]=__builtin_amdgcn_rcpf(wsf[32+crow(r,hi)]);
  bf16*Ow=O+(rowbase+q0+wid*QBLK)*DM+h*D;
  { bf16*stg=(bf16*)(shm+LDS_OST)+wid*2048;
    #pragma unroll
    for(int r=0;r<16;++r){const int orow=crow(r,hi);
      #pragma unroll
      for(int d0=0;d0<2;++d0)stg[orow*64+d0*32+r32]=__float2bfloat16(o[d0][r]*rli[r]);}
    asm volatile("s_waitcnt lgkmcnt(0)":::"memory");
    #pragma unroll
    for(int i=0;i<4;++i){const int row=i*8+(lane>>3),ch=lane&7; const u32x4 v=*(const u32x4*)(stg+row*64+ch*8); ATTN_STORE16(Ow+(long)row*DM+ch*8,v);} }
  asm volatile("s_waitcnt lgkmcnt(0)\n\ts_barrier":::"memory");
  #undef DMA_K
  #undef DMA_V
  #undef CMASK
  #undef START
  #undef RESC
  #undef ROT
  #undef AUG
  #undef MSPLIT
}
constexpr int ATTN_LDS_BYTES=LDS_BYTES;
struct AttnTensors { const bf16* Q; const bf16* K; const bf16* V; bf16* O; const float* kmean; };
struct AttnUnit { int bh; int qb; };
struct StaticOrder {
  int vcu,G;
  __device__ __forceinline__ explicit StaticOrder(int grid,int block):vcu((grid%8==0)?(block%8)*(grid/8)+block/8:block),G(grid){}
  __device__ __forceinline__ bool next(int i,AttnUnit&u)const{ const int p=vcu+(i>>1)*G; if(p>=BATCH*NHEAD*4)return false; const int s=p&3; u.bh=p>>2; u.qb=(i&1)?s:7-s; return true; }
  __device__ __forceinline__ void a_ready(const AttnUnit&)const{}
  __device__ __forceinline__ void done(const AttnUnit&)const{}
};
template<class Sched,int THRL=8> __device__ __forceinline__ void attn_phase(char*lds,const AttnTensors&T,const Sched&S){
  AttnUnit u;
  for(int i=0;S.next(i,u);++i){ S.a_ready(u); attn_unit<THRL>(u.bh/NHEAD,u.bh%NHEAD,u.qb,T.Q,T.K,T.V,T.O,T.kmean,lds); S.done(u); }
}
#undef SBAR
#undef WAIT_BAR
}


namespace ssm {
typedef short bf16x8 __attribute__((ext_vector_type(8)));
typedef float f32x16 __attribute__((ext_vector_type(16)));
typedef float f32x4 __attribute__((ext_vector_type(4)));
constexpr int CHUNK = 256, NCHUNK = SEQ / CHUNK, SUB = 32;
struct Tables { const float* AP; const bf16x8* BX; const bf16x8* CM; };
__device__ __forceinline__ int crow(int r, int hi) { return (r & 3) + 8 * (r >> 2) + 4 * hi; }
__device__ __forceinline__ float gelu_tanh_fast(float x) { const float u2 = 1.5957691216057308f * (x + 0.044715f * x * x * x);
    return x * __builtin_amdgcn_rcpf(1.0f + __builtin_amdgcn_exp2f(-1.4426950408889634f * u2)); }

__device__ __forceinline__ void ssm_params(const float* lam_re, const float* lam_im, const float* log_dt, const float* b_re, const float* b_im, const float* c_re, const float* c_im, const float* d_skip,
                                           float* AP, unsigned short* BX, unsigned short* CM, int bid, int nblk) {
    const int gt = bid * blockDim.x + threadIdx.x, nt = nblk * blockDim.x;
    for (int i = gt; i < NG * SSM_P; i += nt) {
        const int g = i / SSM_P, p = i % SSM_P;
        const double lr = (double)lam_re[i], li = (double)lam_im[i], dt = exp((double)log_dt[g]);
        const double mag = exp(lr * dt), ang = li * dt, are = mag * cos(ang), aim = mag * sin(ang), den = lr * lr + li * li;
        const double fre = ((are - 1.0) * lr + aim * li) / den, fim = (aim * lr - (are - 1.0) * li) / den;
        const double mag2 = exp(lr * dt * 256.0), ang2 = li * dt * 256.0;
        AP[i * 4 + 0] = (float)are; AP[i * 4 + 1] = (float)aim; AP[i * 4 + 2] = (float)(mag2 * cos(ang2)); AP[i * 4 + 3] = (float)(mag2 * sin(ang2));
        const int pb = p >> 5, r32 = p & 31;
        for (int h = 0; h < SSM_GROUP; ++h) {
            const double br = (double)b_re[i * SSM_GROUP + h], bi = (double)b_im[i * SSM_GROUP + h];
            const int lane = (h >> 3) * 32 + r32, j = h & 7;
            BX[((size_t)(g * 4 + pb * 2 + 0) * 64 + lane) * 8 + j] = (unsigned short)f2bf((float)(fre * br - fim * bi));
            BX[((size_t)(g * 4 + pb * 2 + 1) * 64 + lane) * 8 + j] = (unsigned short)f2bf((float)(fre * bi + fim * br));
        }
    }
    for (int i = gt; i < NG * 5 * 64 * 8; i += nt) {
        const int j = i & 7, lane = (i >> 3) & 63, ks = (i >> 9) % 5, g = i / (5 * 512);
        const int ho = lane & 15, k = 32 * ks + 8 * (lane >> 4) + j;
        float v = 0.f;
        if (k < 64) v = c_re[(g * SSM_GROUP + ho) * SSM_P + k];
        else if (k < 128) v = -c_im[(g * SSM_GROUP + ho) * SSM_P + (k - 64)];
        else if (k - 128 == ho) v = d_skip[g * SSM_GROUP + ho];
        CM[i] = (unsigned short)f2bf(v);
    }
}

template <bool PASS2>
__device__ __forceinline__ void ssm_unit(int b, int g, int c, const unsigned short* us, const Tables T, float* send, unsigned short* yg, LAS unsigned char* wl, int lane) {
    const int r32 = lane & 31, hi = lane >> 5;
    const size_t row0 = (size_t)b * SEQ + (size_t)c * CHUNK;
    const f32x4 ap = *(const f32x4*)(T.AP + (size_t)(g * SSM_P + lane) * 4);
    const float a_re = ap[0], a_im = ap[1];
    float hre = 0.f, him = 0.f;
    if (PASS2) {
        const float2* se = (const float2*)send + ((size_t)(b * NG + g) * NCHUNK) * SSM_P + lane;
        for (int j = 0; j < c; ++j) { const float2 sj = se[(size_t)j * SSM_P]; const float nr = ap[2] * hre - ap[3] * him + sj.x, ni = ap[2] * him + ap[3] * hre + sj.y; hre = nr; him = ni; }
    }
    bf16x8 bx[4];
#pragma unroll
    for (int f = 0; f < 4; ++f) bx[f] = T.BX[(size_t)(g * 4 + f) * 64 + lane];
    bf16x8 cm[5];
    if (PASS2) {
#pragma unroll
        for (int ks = 0; ks < 5; ++ks) cm[ks] = T.CM[(size_t)(g * 5 + ks) * 64 + lane];
    }
    unsigned hoff[8];
#pragma unroll
    for (int k = 0; k < 8; ++k) hoff[k] = ((((unsigned)lane >> 3) ^ (unsigned)k) << 4) + ((unsigned)lane & 7u) * 2u;
    unsigned aoff[4];
#pragma unroll
    for (int ks = 0; ks < 4; ++ks) aoff[ks] = ((unsigned)lane & 15u) * 512u + (((unsigned)(4 * ks + (lane >> 4)) ^ ((unsigned)lane & 7u)) << 4);
    const unsigned short* ua = us + (row0 + r32) * 512 + 16 * g + 8 * hi;
    const unsigned short* ub = us + (row0 + (lane & 15)) * 512 + 16 * g + 8 * ((lane >> 4) & 1);
    for (int st = 0; st < CHUNK / SUB; ++st) {
        const bf16x8 uA = *(const bf16x8*)(ua + (size_t)st * SUB * 512);
#pragma unroll
        for (int f = 0; f < 4; ++f) {
            const f32x16 z = {};
            const f32x16 xa = __builtin_amdgcn_mfma_f32_32x32x16_bf16(uA, bx[f], z, 0, 0, 0);
#pragma unroll
            for (int r = 0; r < 16; ++r) *(LAS float*)(wl + crow(r, hi) * 512 + (f & 1) * 256 + ((f >> 1) * 32 + r32) * 4) = xa[r];
        }
#pragma unroll
        for (int t = 0; t < SUB; ++t) {
            const float xr = *(const LAS float*)(wl + t * 512 + lane * 4), xi = *(const LAS float*)(wl + t * 512 + 256 + lane * 4);
            const float nr = __builtin_fmaf(a_re, hre, __builtin_fmaf(-a_im, him, xr)), ni = __builtin_fmaf(a_re, him, __builtin_fmaf(a_im, hre, xi));
            hre = nr; him = ni;
            if (PASS2) { const unsigned w = pg8::cvt_pk_bf16(hre, him);
                *(LAS unsigned short*)(wl + t * 512 + hoff[t & 7]) = (unsigned short)(w & 0xffffu); *(LAS unsigned short*)(wl + t * 512 + hoff[t & 7] + 128) = (unsigned short)(w >> 16); }
        }
        if (PASS2) {
#pragma unroll
            for (int mb = 0; mb < 2; ++mb) {
                f32x4 y = {0.f, 0.f, 0.f, 0.f};
#pragma unroll
                for (int ks = 0; ks < 4; ++ks) { const bf16x8 af = *(const LAS bf16x8*)(wl + mb * 16 * 512 + aoff[ks]); y = __builtin_amdgcn_mfma_f32_16x16x32_bf16(af, cm[ks], y, 0, 0, 0); }
                bf16x8 uf = *(const bf16x8*)(ub + ((size_t)st * SUB + mb * 16) * 512);
                if ((lane >> 4) >= 2) uf = (bf16x8){0, 0, 0, 0, 0, 0, 0, 0};
                y = __builtin_amdgcn_mfma_f32_16x16x32_bf16(uf, cm[4], y, 0, 0, 0);
                unsigned short* yo = yg + (row0 + (size_t)st * SUB + mb * 16 + 4 * (lane >> 4)) * 512 + 16 * g + (lane & 15);
#pragma unroll
                for (int r = 0; r < 4; ++r) yo[(size_t)r * 512] = (unsigned short)f2bf(gelu_tanh_fast(y[r]));
            }
        }
    }
    if (!PASS2) ((float2*)send)[((size_t)(b * NG + g) * NCHUNK + c) * SSM_P + lane] = make_float2(hre, him);
}
template <bool PASS2>
__device__ __forceinline__ void ssm_phase(const unsigned short* us, const Tables T, float* send, unsigned short* yg, LAS unsigned char* lds, int bid, int nblk) {
    int tid_ = threadIdx.x; asm volatile("" : "+v"(tid_));
    const int lane = tid_ & 63, wave = __builtin_amdgcn_readfirstlane(tid_ >> 6);
    for (int u = bid; u < BATCH * NCHUNK * 4; u += nblk) ssm_unit<PASS2>(u >> 5, 8 * (u & 3) + wave, (u >> 2) & 7, us, T, send, yg, lds + wave * 16384, lane);
}
}

constexpr size_t MiB = 1048576;
constexpr size_t WS_WUP1 = 0, WS_WDN1 = 11 * MiB, WS_WUP2 = 17 * MiB, WS_WDN2 = 28 * MiB, WS_WIN = 34 * MiB, WS_WGLU = 38 * MiB, WS_WOUT = 39 * MiB;
constexpr size_t WS_XNB = 42 * MiB, WS_F = 74 * MiB, WS_HACT = 138 * MiB;
constexpr size_t WS_Q = 138 * MiB, WS_ATT = 202 * MiB, WS_YG = 218 * MiB, WS_Z = 234 * MiB, WS_KMEAN = 250 * MiB;
constexpr size_t WS_SSM_AP = 251 * MiB, WS_SSM_BX = WS_SSM_AP + 65536, WS_SSM_CM = WS_SSM_BX + 131072, WS_SSM_SEND = 252 * MiB;
constexpr size_t QKVU_STRIDE = (size_t)MTOK * 512;
constexpr size_t WS_CTL = 255 * MiB, CTL_BYTES = 65536;
constexpr int LDS_BYTES = 147456, MISC_OFF = 131072 + 320;
typedef unsigned short bf16;

__device__ __forceinline__ void p0_transpose_item(const float* W, int K, int N, bf16* WT, int mode, LAS float* scr, int item, int lane) {
    const int nblk = N / 32, kb = item / nblk, nb = item % nblk, k0 = 64 * kb, n0 = 32 * nb;
    const int r0 = (mode == 0) ? n0 : (256 * (n0 / 128) + (n0 % 128) + (mode == 2 ? 128 : 0));
#pragma unroll 8
    for (int i = 0; i < 32; ++i) { const int kk = 2 * i + (lane >> 5); scr[kk * 33 + (lane & 31)] = W[(size_t)(k0 + kk) * N + n0 + (lane & 31)]; }
    asm volatile("s_waitcnt lgkmcnt(0)" ::: "memory");
    const int c = lane & 7;
#pragma unroll
    for (int j = 0; j < 4; ++j) { const int n = (lane >> 3) + 8 * j; const LAS float* s = scr + (8 * c) * 33 + n;
        uint4 o; o.x = pk2(s[0 * 33], s[1 * 33]); o.y = pk2(s[2 * 33], s[3 * 33]); o.z = pk2(s[4 * 33], s[5 * 33]); o.w = pk2(s[6 * 33], s[7 * 33]);
        *(uint4*)(WT + (size_t)(r0 + n) * K + k0 + 8 * c) = o; }
    asm volatile("s_waitcnt lgkmcnt(0)" ::: "memory");
}
struct ConvJob { const float* W; bf16* WT; int K, N, mode, items; };
__device__ __forceinline__ void conv_weights(const Args& a, LAS unsigned char* lds, int bid, int nblk) {
    const int lane = threadIdx.x & 63, wave = threadIdx.x >> 6;
    LAS float* scr = (LAS float*)(lds + wave * 16384);
    const int gw = bid * NWAVES + wave, NGW = nblk * NWAVES;
    constexpr int I_G = (D_MODEL / 64) * (D_FF / 32), I_D = (D_FF / 64) * (D_MODEL / 32), I_IN = (D_MODEL / 64) * (D_IN / 32), I_GL = (D_SSM / 64) * (D_SSM / 32), I_O = (D_MODEL / 64) * (D_MODEL / 32);
    constexpr int NITEMS = 4 * I_G + 2 * I_D + I_IN + I_GL + I_O;
    for (int it = gw; it < NITEMS; it += NGW) {
        int r = it;
        if (r < I_G) { p0_transpose_item(a.in[I_F1WG], D_MODEL, D_FF, (bf16*)(a.ws + WS_WUP1), 1, scr, r, lane); continue; } r -= I_G;
        if (r < I_G) { p0_transpose_item(a.in[I_F1WU], D_MODEL, D_FF, (bf16*)(a.ws + WS_WUP1), 2, scr, r, lane); continue; } r -= I_G;
        if (r < I_D) { p0_transpose_item(a.in[I_F1WD], D_FF, D_MODEL, (bf16*)(a.ws + WS_WDN1), 0, scr, r, lane); continue; } r -= I_D;
        if (r < I_G) { p0_transpose_item(a.in[I_F2WG], D_MODEL, D_FF, (bf16*)(a.ws + WS_WUP2), 1, scr, r, lane); continue; } r -= I_G;
        if (r < I_G) { p0_transpose_item(a.in[I_F2WU], D_MODEL, D_FF, (bf16*)(a.ws + WS_WUP2), 2, scr, r, lane); continue; } r -= I_G;
        if (r < I_D) { p0_transpose_item(a.in[I_F2WD], D_FF, D_MODEL, (bf16*)(a.ws + WS_WDN2), 0, scr, r, lane); continue; } r -= I_D;
        if (r < I_IN) { p0_transpose_item(a.in[I_WIN], D_MODEL, D_IN, (bf16*)(a.ws + WS_WIN), 0, scr, r, lane); continue; } r -= I_IN;
        if (r < I_GL) { p0_transpose_item(a.in[I_WGLU], D_SSM, D_SSM, (bf16*)(a.ws + WS_WGLU), 0, scr, r, lane); continue; } r -= I_GL;
        p0_transpose_item(a.in[I_WOUT], D_MODEL, D_MODEL, (bf16*)(a.ws + WS_WOUT), 0, scr, r, lane);
    }
}
__device__ __forceinline__ void rms_rows_bf16(const float* in, const float* g, bf16* out, int bid, int nblk) {
    const int lane = threadIdx.x & 63, wave = threadIdx.x >> 6;
    for (int r = bid * NWAVES + wave; r < MTOK; r += nblk * NWAVES) {
        const float4* ir = (const float4*)(in + (size_t)r * D_MODEL) + lane;
        float4 v[4]; float s = 0.f;
#pragma unroll
        for (int j = 0; j < 4; ++j) { v[j] = ir[64 * j]; s += v[j].x * v[j].x + v[j].y * v[j].y + v[j].z * v[j].z + v[j].w * v[j].w; }
        s = wave_sum(s);
        const float rs = 1.0f / sqrtf(s * (1.0f / D_MODEL) + RMS_EPS);
        uint2* o8 = (uint2*)(out + (size_t)r * D_MODEL) + lane;
#pragma unroll
        for (int j = 0; j < 4; ++j) { const float4 gg = ((const float4*)g)[lane + 64 * j];
            uint2 o; o.x = pk2(v[j].x * rs * gg.x, v[j].y * rs * gg.y); o.y = pk2(v[j].z * rs * gg.z, v[j].w * rs * gg.w); o8[64 * j] = o; }
    }
}
__device__ __forceinline__ void rms512_bf16(const bf16* in, const float* g, bf16* out, int coff, int bid, int nblk) {
    const int lane = threadIdx.x & 63, wave = threadIdx.x >> 6;
    for (int r = bid * NWAVES + wave; r < MTOK; r += nblk * NWAVES) {
        const uint4 w = *((const uint4*)(in + (size_t)r * 512) + lane);
        float v[8]; v[0] = __uint_as_float(w.x << 16); v[1] = __uint_as_float(w.x & 0xffff0000u); v[2] = __uint_as_float(w.y << 16); v[3] = __uint_as_float(w.y & 0xffff0000u);
        v[4] = __uint_as_float(w.z << 16); v[5] = __uint_as_float(w.z & 0xffff0000u); v[6] = __uint_as_float(w.w << 16); v[7] = __uint_as_float(w.w & 0xffff0000u);
        float s = 0.f;
#pragma unroll
        for (int e = 0; e < 8; ++e) s += v[e] * v[e];
        s = wave_sum(s);
        const float rs = 1.0f / sqrtf(s * (1.0f / 512.0f) + RMS_EPS);
        const float4 g0 = ((const float4*)g)[2 * lane], g1 = ((const float4*)g)[2 * lane + 1];
        uint4 o; o.x = pk2(v[0] * rs * g0.x, v[1] * rs * g0.y); o.y = pk2(v[2] * rs * g0.z, v[3] * rs * g0.w); o.z = pk2(v[4] * rs * g1.x, v[5] * rs * g1.y); o.w = pk2(v[6] * rs * g1.z, v[7] * rs * g1.w);
        *((uint4*)(out + (size_t)r * 1024 + coff) + lane) = o;
    }
}

__global__ void __launch_bounds__(NTHR, 2) k_mega(Args a) {
    extern __shared__ __attribute__((aligned(16))) unsigned char lds[];
    LAS unsigned char* ldsl = (LAS unsigned char*)lds;
    const int bid = blockIdx.x, nblk = gridDim.x;
    volatile LAS unsigned* MISC = (volatile LAS unsigned*)(ldsl + MISC_OFF);
    if (threadIdx.x < 32) MISC[threadIdx.x] = 0u;
    __syncthreads();
    XcdBarrier bar = xcd_barrier_post((unsigned*)(a.ws + WS_CTL), MISC + 8);
    bf16* WUP1 = (bf16*)(a.ws + WS_WUP1); bf16* WDN1 = (bf16*)(a.ws + WS_WDN1); bf16* WUP2 = (bf16*)(a.ws + WS_WUP2); bf16* WDN2 = (bf16*)(a.ws + WS_WDN2);
    bf16* WINT = (bf16*)(a.ws + WS_WIN); bf16* WGLUT = (bf16*)(a.ws + WS_WGLU); bf16* WOUTT = (bf16*)(a.ws + WS_WOUT);
    bf16* XNB = (bf16*)(a.ws + WS_XNB); bf16* HACT = (bf16*)(a.ws + WS_HACT); float* FB = (float*)(a.ws + WS_F);
    bf16* QB = (bf16*)(a.ws + WS_Q); bf16* KB = QB + QKVU_STRIDE; bf16* VB = KB + QKVU_STRIDE; bf16* USB = VB + QKVU_STRIDE;
    bf16* ATT = (bf16*)(a.ws + WS_ATT); bf16* YG = (bf16*)(a.ws + WS_YG); bf16* ZB = (bf16*)(a.ws + WS_Z); float* KMEAN = (float*)(a.ws + WS_KMEAN);
    float* H = a.out;
    const float* x = a.in[I_X];
    conv_weights(a, ldsl, bid, nblk); rms_rows_bf16(x, a.in[I_F1PRE], XNB, bid, nblk);
    ssm::ssm_params(a.in[I_LAMRE], a.in[I_LAMIM], a.in[I_LOGDT], a.in[I_BRE], a.in[I_BIM], a.in[I_CRE], a.in[I_CIM], a.in[I_DSKIP], (float*)(a.ws + WS_SSM_AP), (unsigned short*)(a.ws + WS_SSM_BX), (unsigned short*)(a.ws + WS_SSM_CM), bid, nblk);
    xcd_barrier(bar);
    { pg8::Gemm g{XNB, WUP1, MTOK, 2 * D_FF, D_MODEL}; pg8::StaticOrder S; S.init(MTOK, 2 * D_FF, nblk, bid); pg8::EpiSwiGLU E{HACT, D_FF};
      pg8::gemm_phase<pg8::EpiSwiGLU, pg8::StaticOrder, PG8_ALIGN, PG8_SP2>(ldsl, g, S, E); }
    xcd_barrier(bar);
    { pg8::Gemm g{HACT, WDN1, MTOK, D_MODEL, D_FF}; pg8::StaticOrder S; S.init(MTOK, D_MODEL, nblk, bid); pg8::EpiF32 E{FB, D_MODEL};
      pg8::gemm_phase<pg8::EpiF32, pg8::StaticOrder, PG8_ALIGN, PG8_SP2>(ldsl, g, S, E); }
    xcd_barrier(bar);
    nv_rms(FB, 1024, a.in[I_F1POST], 1024, MTOK, x, 1024, 0.5f, H, 1024, bid, nblk);
    xcd_barrier(bar);
    rms_rows_bf16(H, a.in[I_MIXPRE], XNB, bid, nblk);
    xcd_barrier(bar);
    { pg8::Gemm g{XNB, WINT, MTOK, D_IN, D_MODEL}; pg8::StaticOrder S; S.init(MTOK, D_IN, nblk, bid); pg8::EpiBf16Split E{QB, QKVU_STRIDE, attn_body::C2};
      pg8::gemm_phase<pg8::EpiBf16Split, pg8::StaticOrder, PG8_ALIGN, PG8_SP2>(ldsl, g, S, E); }
    xcd_barrier(bar);
    const ssm::Tables ST{(const float*)(a.ws + WS_SSM_AP), (const ssm::bf16x8*)(a.ws + WS_SSM_BX), (const ssm::bf16x8*)(a.ws + WS_SSM_CM)};
    nv_kmean(KB, 512, KMEAN, bid, nblk);
    ssm::ssm_phase<false>(USB, ST, (float*)(a.ws + WS_SSM_SEND), YG, ldsl, bid, nblk);
    xcd_barrier(bar);
    { const attn_body::AttnTensors AT{(const attn_body::bf16*)QB, (const attn_body::bf16*)KB, (const attn_body::bf16*)VB, (attn_body::bf16*)ATT, KMEAN};
      const attn_body::StaticOrder S(nblk, bid); attn_body::attn_phase<attn_body::StaticOrder>((char*)lds, AT, S); }
    __syncthreads();
    ssm::ssm_phase<true>(USB, ST, (float*)(a.ws + WS_SSM_SEND), YG, ldsl, bid, nblk);
    xcd_barrier(bar);
    { pg8::Gemm g{YG, WGLUT, MTOK, D_SSM, D_SSM}; pg8::StaticOrder S; S.init(MTOK, D_SSM, nblk, bid); pg8::EpiGLU E{YG, ZB, a.in[I_BGLU]};
      pg8::gemm_phase<pg8::EpiGLU, pg8::StaticOrder, PG8_ALIGN, PG8_SP2>(ldsl, g, S, E); }
    xcd_barrier(bar);
    rms512_bf16(ATT, a.in[I_ATTNG], XNB, 0, bid, nblk); rms512_bf16(ZB, a.in[I_SSMG], XNB, 512, bid, nblk);
    xcd_barrier(bar);
    { pg8::Gemm g{XNB, WOUTT, MTOK, D_MODEL, D_MODEL}; pg8::StaticOrder S; S.init(MTOK, D_MODEL, nblk, bid); pg8::EpiF32 E{FB, D_MODEL};
      pg8::gemm_phase<pg8::EpiF32, pg8::StaticOrder, PG8_ALIGN, PG8_SP2>(ldsl, g, S, E); }
    xcd_barrier(bar);
    nv_rms(FB, 1024, a.in[I_MIXPOST], 1024, MTOK, H, 1024, 1.0f, H, 1024, bid, nblk);
    xcd_barrier(bar);
    rms_rows_bf16(H, a.in[I_F2PRE], XNB, bid, nblk);
    xcd_barrier(bar);
    { pg8::Gemm g{XNB, WUP2, MTOK, 2 * D_FF, D_MODEL}; pg8::StaticOrder S; S.init(MTOK, 2 * D_FF, nblk, bid); pg8::EpiSwiGLU E{HACT, D_FF};
      pg8::gemm_phase<pg8::EpiSwiGLU, pg8::StaticOrder, PG8_ALIGN, PG8_SP2>(ldsl, g, S, E); }
    xcd_barrier(bar);
    { pg8::Gemm g{HACT, WDN2, MTOK, D_MODEL, D_FF}; pg8::StaticOrder S; S.init(MTOK, D_MODEL, nblk, bid); pg8::EpiF32 E{FB, D_MODEL};
      pg8::gemm_phase<pg8::EpiF32, pg8::StaticOrder, PG8_ALIGN, PG8_SP2>(ldsl, g, S, E); }
    xcd_barrier(bar);
    nv_rms(FB, 1024, a.in[I_F2POST], 1024, MTOK, H, 1024, 0.5f, H, 1024, bid, nblk);
}

extern "C" void kernel_launch(void* const* d_in, const int* in_sizes, int n_in, void* d_out, int out_size, void* d_ws, size_t ws_size, hipStream_t stream) {
    static int grid = 0;
    if (grid == 0) {
        if (n_in != 27 || out_size != MTOK * D_MODEL || ws_size < 256u * 1048576u) { fprintf(stderr, "kernel_launch: unexpected shapes n_in %d out %d ws %zu\n", n_in, out_size, ws_size); grid = -1; return; }
        int dev = 0, cus = 0, per_cu = 0;
        if (hipGetDevice(&dev) != hipSuccess || hipDeviceGetAttribute(&cus, hipDeviceAttributeMultiprocessorCount, dev) != hipSuccess) { grid = -1; return; }
        if (hipFuncSetAttribute((const void*)k_mega, hipFuncAttributeMaxDynamicSharedMemorySize, LDS_BYTES) != hipSuccess) { fprintf(stderr, "hipFuncSetAttribute failed\n"); grid = -1; return; }
        if (hipOccupancyMaxActiveBlocksPerMultiprocessor(&per_cu, (const void*)k_mega, NTHR, LDS_BYTES) != hipSuccess || per_cu < 1) { fprintf(stderr, "occupancy query: %d blocks per CU\n", per_cu); grid = -1; (void)hipGetLastError(); return; }
        grid = cus;
    }
    if (grid < 0) return;
    if (hipMemsetAsync((char*)d_ws + WS_CTL, 0, CTL_BYTES, stream) != hipSuccess) return;
    Args a{};
    for (int i = 0; i < 27; ++i) a.in[i] = (const float*)d_in[i];
    a.out = (float*)d_out; a.ws = (unsigned char*)d_ws;
    hipLaunchKernelGGL(k_mega, dim3(grid), dim3(NTHR), LDS_BYTES, stream, a);
}
```

```cpp
#include <hip/hip_runtime.h>
#include <cstdint>
#include <cstdio>

#ifndef PROBE_A
#define PROBE_A (-1)
#define PROBE_B (-1)
#endif
#define PROBE_AMP 8
extern __shared__ __attribute__((aligned(16))) unsigned char g_lds_all[];
#define PSTAMP(i) do { if (PROBE_A >= 0 && ((i) == PROBE_A || (i) == PROBE_B) && blockIdx.x == 0 && threadIdx.x == 0) \
    ((__attribute__((address_space(3))) unsigned long long*)((__attribute__((address_space(3))) unsigned char*)g_lds_all + 131072 + 512))[(i) == PROBE_A ? 0 : 1] = __builtin_amdgcn_s_memrealtime(); } while (0)
constexpr int D_MODEL = 1024, BATCH = 8, SEQ = 2048, MTOK = BATCH * SEQ;
constexpr int NH = 8, HD = 64, D_ATTN = 512, MOBA_L = 256, NBLK = SEQ / MOBA_L;
constexpr int SSM_GROUP = 16, D_SSM = 512, NG = 32, SSM_P = 64;
constexpr int D_IN = 2048, D_FF = 2816;
constexpr float RMS_EPS = 1e-6f;
constexpr int NTHR = 512, NWAVES = 8;
constexpr size_t GROUP_STRIDE = (size_t)SEQ * D_FF;

struct Args {
    const float* in[27];
    float* out;
    unsigned char* ws;
    int stage, pad;
};
enum { I_X = 0, I_F1PRE, I_F1WG, I_F1WU, I_F1WD, I_F1POST, I_MIXPRE, I_WIN, I_LAMRE, I_LAMIM, I_LOGDT, I_BRE, I_BIM, I_CRE, I_CIM, I_DSKIP,
       I_WGLU, I_BGLU, I_ATTNG, I_SSMG, I_WOUT, I_MIXPOST, I_F2PRE, I_F2WG, I_F2WU, I_F2WD, I_F2POST };

namespace pg8 {
#define PG8_LAS __attribute__((address_space(3)))
typedef unsigned short bf16_t;
typedef short bf16x8 __attribute__((ext_vector_type(8)));
typedef float f32x4 __attribute__((ext_vector_type(4)));
typedef unsigned u32x4 __attribute__((ext_vector_type(4)));
constexpr int BM = 256, BK = 64, HALF = 128, HTB = HALF * BK * 2  , STAGE_BYTES = 8 * HTB, NXCD = 8, WGM = 8;

__host__ __device__ __forceinline__ int lds_byte(int r, int c) { const int st = (r >> 4) * 2 + (c >> 5), rr = r & 15, cc = c & 31, ob = rr * 64 + cc * 2; return st * 1024 + (ob ^ (((ob >> 9) & 1) << 5)); }
__host__ __device__ __forceinline__ void stage_rc(int b, int& R, int& C) { const int st = b / 1024, sb = b % 1024, swz = sb ^ (((sb >> 9) & 1) << 5); R = (st >> 1) * 16 + swz / 64; C = (st & 1) * 32 + (swz % 64) / 2; }
__host__ __device__ __forceinline__ int perm32(int rho) { const int n = rho >> 4, i = rho & 15; return 8 * (i >> 2) + 4 * n + (i & 3); }

struct Unit { int pm, pn, half; };
struct Gemm { const bf16_t* A; const bf16_t* Bt; int M, N, K; };

struct StaticOrder {
    int nM, nN, nwg, G, c;
    __host__ __device__ void init(int M, int N, int G_, int c_) { nM = M / BM; nN = N / BM; nwg = nM * nN; G = G_; c = c_; }
    __host__ __device__ bool next(int i, Unit& u) const { return unit_of((long)i * G + c, -1, u); }
    __host__ __device__ bool unit_of(long L, int half, Unit& u) const {
        const bool ok = L < nwg; if (!ok) L = 0;
        int wgid = (int)L; { const int q = nwg / NXCD, r = nwg % NXCD, xcd = wgid % NXCD, off = wgid / NXCD; wgid = (xcd < r ? xcd * (q + 1) : r * (q + 1) + (xcd - r) * q) + off; }
        const int nig = WGM * nN, gid = wgid / nig, fm = gid * WGM, gsz = (nM - fm) < WGM ? (nM - fm) : WGM;
        u = Unit{fm + ((wgid % nig) % gsz), (wgid % nig) / gsz, half}; return ok;
    }
    __device__ __forceinline__ void a_ready(const Unit&) const {}
    __device__ __forceinline__ void done(const Unit&) const {}
};
struct SplitLastOrder : StaticOrder {
    __host__ __device__ bool next(int i, Unit& u) const {
        const int nfull = nwg / G, nlast = nwg % G;
        const bool split = (i >= nfull) && (2 * nlast == G);
        const long L = split ? (i == nfull ? (long)nfull * G + (c % nlast) : (long)nwg) : (long)i * G + c;
        return unit_of(L, split ? c / nlast : -1, u);
    }
};

__device__ __forceinline__ unsigned cvt_pk_bf16(float lo, float hi) { unsigned r; asm volatile("v_cvt_pk_bf16_f32 %0, %1, %2" : "=v"(r) : "v"(lo), "v"(hi)); return r; }

struct EpiF32 {
    static constexpr bool PERM = false, AFTER_DRAIN = false;
    float* C; int ldc;
    __device__ __forceinline__ void operator()(const f32x4 (&acc)[2][2][4][2], const Unit& u, int wr, int wc, int fr, int fq) const {
        const int row0 = u.pm * BM + wr * 64 + fr, col0 = u.pn * BM + wc * 32 + 4 * fq;
#pragma unroll
        for (int ai = 0; ai < 2; ++ai)
#pragma unroll
            for (int m = 0; m < 4; ++m) { float* rowp = C + (size_t)(row0 + ai * HALF + m * 16) * ldc + col0;
#pragma unroll
                for (int bj = 0; bj < 2; ++bj)
#pragma unroll
                    for (int n = 0; n < 2; ++n) *(f32x4*)(rowp + bj * HALF + n * 16) = acc[ai][bj][m][n]; }
    }
};
struct EpiSwiGLU {
    static constexpr bool PERM = true, AFTER_DRAIN = false;
    bf16_t* O; int ldc; int split_pn;
    __device__ __forceinline__ void operator()(const f32x4 (&acc)[2][2][4][2], const Unit& u, int wr, int wc, int fr, int fq) const {
        const int row0 = u.pm * BM + wr * 64 + fr;
        if (u.pn < split_pn) {
            const int col0 = u.pn * HALF + wc * 32 + 8 * fq;
#pragma unroll
            for (int ai = 0; ai < 2; ++ai) {
                if (u.half >= 0 && u.half != ai) continue;
#pragma unroll
                for (int m = 0; m < 4; ++m) { bf16_t* rowp = O + (size_t)(row0 + ai * HALF + m * 16) * ldc + col0;
                    float o[8];
#pragma unroll
                    for (int n = 0; n < 2; ++n)
#pragma unroll
                        for (int e = 0; e < 4; ++e) { const float g = acc[ai][0][m][n][e], up = acc[ai][1][m][n][e];
                            const float sg = __builtin_amdgcn_rcpf(1.0f + __builtin_amdgcn_exp2f(-1.4426950408889634f * g)); o[n * 4 + e] = g * sg * up; }
                    u32x4 w; w.x = cvt_pk_bf16(o[0], o[1]); w.y = cvt_pk_bf16(o[2], o[3]); w.z = cvt_pk_bf16(o[4], o[5]); w.w = cvt_pk_bf16(o[6], o[7]);
                    *(u32x4*)rowp = w; } }
        } else {
            typedef unsigned u32x2v __attribute__((ext_vector_type(2)));
#pragma unroll
            for (int bj = 0; bj < 2; ++bj) {
                if (u.half >= 0 && u.half != bj) continue;
                const int col0 = u.pn * HALF + bj * 64 + wc * 16 + 4 * fq;
#pragma unroll
                for (int ai = 0; ai < 2; ++ai)
#pragma unroll
                    for (int m = 0; m < 4; ++m) { float o[4];
#pragma unroll
                        for (int e = 0; e < 4; ++e) { const float g = acc[ai][bj][m][0][e], up = acc[ai][bj][m][1][e];
                            const float sg = __builtin_amdgcn_rcpf(1.0f + __builtin_amdgcn_exp2f(-1.4426950408889634f * g)); o[e] = g * sg * up; }
                        u32x2v w; w.x = cvt_pk_bf16(o[0], o[1]); w.y = cvt_pk_bf16(o[2], o[3]);
                        *(u32x2v*)(O + (size_t)(row0 + ai * HALF + m * 16) * ldc + col0) = w; }
            }
        }
    }
};
struct EpiBf16Split {
    static constexpr bool PERM = true, AFTER_DRAIN = false;
    bf16_t* O; size_t split_stride; size_t group_stride; float scale0; float* kmp;
    __device__ __forceinline__ void operator()(const f32x4 (&acc)[2][2][4][2], const Unit& u, int wr, int wc, int fr, int fq) const {
        const int row0 = u.pm * BM + wr * 64 + fr; const int t = (u.pn * BM) / 512; const int colt = u.pn * BM - t * 512;
        bf16_t* base = O + (size_t)(u.pm >> 3) * group_stride + (size_t)t * split_stride - (size_t)(u.pm >> 3) * 2048 * 512; const int col0 = colt + wc * 32 + 8 * fq; const float sc = (t == 0) ? scale0 : 1.0f;
#pragma unroll
        for (int ai = 0; ai < 2; ++ai)
#pragma unroll
            for (int m = 0; m < 4; ++m) { bf16_t* rowp = base + (size_t)(row0 + ai * HALF + m * 16) * 512 + col0;
#pragma unroll
                for (int bj = 0; bj < 2; ++bj) { const f32x4 v0 = acc[ai][bj][m][0] * sc, v1 = acc[ai][bj][m][1] * sc;
                    u32x4 w; w.x = cvt_pk_bf16(v0[0], v0[1]); w.y = cvt_pk_bf16(v0[2], v0[3]); w.z = cvt_pk_bf16(v1[0], v1[1]); w.w = cvt_pk_bf16(v1[2], v1[3]);
                    *(u32x4*)(rowp + bj * HALF) = w; } }
        if (t == 1) {
            f32x4 cs[2][2];
#pragma unroll
            for (int bj = 0; bj < 2; ++bj)
#pragma unroll
                for (int n = 0; n < 2; ++n) { f32x4 a = acc[0][bj][0][n];
#pragma unroll
                    for (int m = 1; m < 4; ++m) a += acc[0][bj][m][n];
#pragma unroll
                    for (int m = 0; m < 4; ++m) a += acc[1][bj][m][n];
#pragma unroll
                    for (int e = 0; e < 4; ++e) { float v = a[e]; v += __shfl_xor(v, 1); v += __shfl_xor(v, 2); v += __shfl_xor(v, 4); v += __shfl_xor(v, 8); a[e] = v; }
                    cs[bj][n] = a; }
            if (fr == 0) { float* kp = kmp + ((size_t)wr * 64 + u.pm) * 512 + col0;
#pragma unroll
                for (int bj = 0; bj < 2; ++bj) { *(f32x4*)(kp + bj * HALF) = cs[bj][0]; *(f32x4*)(kp + bj * HALF + 4) = cs[bj][1]; } }
        }
    }
};
struct EpiGLU {
    static constexpr bool PERM = true, AFTER_DRAIN = false;
    const bf16_t* Y; bf16_t* Z; const float* bias;
    __device__ __forceinline__ void operator()(const f32x4 (&acc)[2][2][4][2], const Unit& u, int wr, int wc, int fr, int fq) const {
        const int row0 = u.pm * BM + wr * 64 + fr, col0 = u.pn * BM + wc * 32 + 8 * fq;
#pragma unroll
        for (int ai = 0; ai < 2; ++ai)
#pragma unroll
            for (int m = 0; m < 4; ++m) { const size_t ro = (size_t)(row0 + ai * HALF + m * 16) * 512 + col0;
#pragma unroll
                for (int bj = 0; bj < 2; ++bj) { const u32x4 yw = *(const u32x4*)(Y + ro + bj * HALF);
                    const f32x4 b0 = *(const f32x4*)(bias + col0 + bj * HALF), b1 = *(const f32x4*)(bias + col0 + bj * HALF + 4);
                    float o[8];
#pragma unroll
                    for (int e = 0; e < 8; ++e) { const float a = (e < 4 ? acc[ai][bj][m][0][e & 3] : acc[ai][bj][m][1][e & 3]) + (e < 4 ? b0[e & 3] : b1[e & 3]);
                        const unsigned yy = yw[e >> 1]; const float y = __uint_as_float((e & 1) ? (yy & 0xffff0000u) : (yy << 16));
                        o[e] = y * __builtin_amdgcn_rcpf(1.0f + __builtin_amdgcn_exp2f(-1.4426950408889634f * a)); }
                    u32x4 w; w.x = cvt_pk_bf16(o[0], o[1]); w.y = cvt_pk_bf16(o[2], o[3]); w.z = cvt_pk_bf16(o[4], o[5]); w.w = cvt_pk_bf16(o[6], o[7]);
                    *(u32x4*)(Z + ro + bj * HALF) = w; } }
    }
};


struct PanelRms {
    unsigned* xbuf;
    unsigned* cnt;
    unsigned* tmo;
    int ntn; float eps; unsigned code;
    __device__ __forceinline__ bool run(const f32x4 (&v)[2][2][4][2], const Unit& u, int wr, int wc, int fr, int fq, PG8_LAS unsigned char* lds, int wid, int lane) const {
        PG8_LAS float* P = (PG8_LAS float*)lds;
        PG8_LAS float* S = (PG8_LAS float*)(lds + 8192);
        PG8_LAS unsigned* flag = (PG8_LAS unsigned*)(lds + 8192 + 2048);
#pragma unroll
        for (int ai = 0; ai < 2; ++ai)
#pragma unroll
            for (int m = 0; m < 4; ++m) {
                float q = 0.f;
#pragma unroll
                for (int bj = 0; bj < 2; ++bj)
#pragma unroll
                    for (int n = 0; n < 2; ++n) { const f32x4 x = v[ai][bj][m][n]; q += (x[0] * x[0] + x[1] * x[1]) + (x[2] * x[2] + x[3] * x[3]); }
                q += __shfl_xor(q, 16); q += __shfl_xor(q, 32);
                if (fq == 0) P[(ai * HALF + wr * 64 + m * 16 + fr) * 4 + wc] = q;
            }
        if (wid == 0 && lane == 0) flag[0] = 0u;
        asm volatile("s_waitcnt lgkmcnt(0)" ::: "memory"); __builtin_amdgcn_s_barrier(); asm volatile("" ::: "memory");
        const int row = wid * 32 + (lane & 31);
        if (lane < 32) {
            const float tot = (P[row * 4 + 0] + P[row * 4 + 1]) + (P[row * 4 + 2] + P[row * 4 + 3]);
            const unsigned sidx = (unsigned)(u.pm * BM + row) * 4u;
            __hip_atomic_store(xbuf + (sidx + (unsigned)u.pn), __float_as_uint(tot) & 0x7fffffffu, __ATOMIC_RELAXED, __HIP_MEMORY_SCOPE_AGENT);
            float q = tot; bool dead = false;
            for (unsigned it = 0;; ++it) {
                float sacc = tot; unsigned neg = 0u;
#pragma unroll
                for (int t = 0; t < 4; ++t) if (t < ntn && t != u.pn) { const unsigned w = __hip_atomic_load(xbuf + (sidx + (unsigned)t), __ATOMIC_RELAXED, __HIP_MEMORY_SCOPE_AGENT); neg |= w; sacc += __uint_as_float(w); }
                if (!(neg >> 31)) { q = sacc; break; }
                if (it > (1u << 16)) { dead = true; break; }
                __builtin_amdgcn_s_sleep(1);
            }
            if (dead) { unsigned expect = 0u; __hip_atomic_compare_exchange_strong(tmo + 1, &expect, code | (unsigned)(u.pm & 0xff), __ATOMIC_RELAXED, __ATOMIC_RELAXED, __HIP_MEMORY_SCOPE_AGENT);
                        __hip_atomic_store(tmo, 1u, __ATOMIC_RELAXED, __HIP_MEMORY_SCOPE_AGENT); flag[0] = 1u; }
            S[row] = 1.0f / sqrtf(q / (256.0f * (float)ntn) + eps);
        }
        asm volatile("s_waitcnt vmcnt(0) lgkmcnt(0)" ::: "memory"); __builtin_amdgcn_s_barrier(); asm volatile("" ::: "memory");
        const bool bad = flag[0] != 0u;
        return bad;
    }
};
struct EpiRmsRes {
    static constexpr bool PERM = false, AFTER_DRAIN = true;
    const float* base; float* out; int ldc; const float* g; float alpha; PanelRms st;
    __device__ __forceinline__ void fused(f32x4 (&acc)[2][2][4][2], const Unit& u, int wr, int wc, int fr, int fq, PG8_LAS unsigned char* lds, int wid, int lane) const {
        const PG8_LAS float* S = (const PG8_LAS float*)(lds + 8192);
        const int col0 = u.pn * BM + wc * 32 + 4 * fq;
        constexpr int NPRE = 4;
        f32x4 pre[NPRE][2][2];
#pragma unroll
        for (int m = 0; m < NPRE; ++m) { const size_t off = (size_t)(u.pm * BM + wr * 64 + m * 16 + fr) * ldc + col0;
#pragma unroll
            for (int bj = 0; bj < 2; ++bj)
#pragma unroll
                for (int n = 0; n < 2; ++n) pre[m][bj][n] = *(const f32x4*)(base + off + bj * HALF + n * 16); }
        const bool bad = st.run(acc, u, wr, wc, fr, fq, lds, wid, lane);
        const float qnan = __builtin_nanf("");
        f32x4 gv[2][2];
#pragma unroll
        for (int bj = 0; bj < 2; ++bj)
#pragma unroll
            for (int n = 0; n < 2; ++n) gv[bj][n] = *(const f32x4*)(g + col0 + bj * HALF + n * 16) * alpha;
#pragma unroll
        for (int ai = 0; ai < 2; ++ai)
#pragma unroll
            for (int m = 0; m < 4; ++m) { const int r = ai * HALF + wr * 64 + m * 16 + fr; const float rs = S[r]; const size_t off = (size_t)(u.pm * BM + r) * ldc + col0;
#pragma unroll
                for (int bj = 0; bj < 2; ++bj)
#pragma unroll
                    for (int n = 0; n < 2; ++n) { const f32x4 bs = (ai == 0 && m < NPRE) ? pre[m < NPRE ? m : 0][bj][n] : *(const f32x4*)(base + off + bj * HALF + n * 16); f32x4 o = bs + (acc[ai][bj][m][n] * rs) * gv[bj][n];
                        if (bad) o = (f32x4){qnan, qnan, qnan, qnan}; *(f32x4*)(out + off + bj * HALF + n * 16) = o; }
                if (m & 1) asm volatile("" ::: "memory"); }
    }
};
struct EpiRmsResRms {
    static constexpr bool PERM = false, AFTER_DRAIN = true;
    const float* base; float* out; bf16_t* xn; int ldc; const float* g1; float alpha; const float* g2; PanelRms st1, st2;
    __device__ __forceinline__ void fused(f32x4 (&acc)[2][2][4][2], const Unit& u, int wr, int wc, int fr, int fq, PG8_LAS unsigned char* lds, int wid, int lane) const {
        typedef unsigned u32x2v __attribute__((ext_vector_type(2)));
        const PG8_LAS float* S = (const PG8_LAS float*)(lds + 8192);
        const int col0 = u.pn * BM + wc * 32 + 4 * fq;
        constexpr int NPRE = 3;
        f32x4 pre[NPRE][2][2];
#pragma unroll
        for (int m = 0; m < NPRE; ++m) { const size_t off = (size_t)(u.pm * BM + wr * 64 + m * 16 + fr) * ldc + col0;
#pragma unroll
            for (int bj = 0; bj < 2; ++bj)
#pragma unroll
                for (int n = 0; n < 2; ++n) pre[m][bj][n] = *(const f32x4*)(base + off + bj * HALF + n * 16); }
        PSTAMP(20);
        bool bad = st1.run(acc, u, wr, wc, fr, fq, lds, wid, lane);
        PSTAMP(21);
        const float qnan = __builtin_nanf("");
        {
            f32x4 gv[2][2];
#pragma unroll
            for (int bj = 0; bj < 2; ++bj)
#pragma unroll
                for (int n = 0; n < 2; ++n) gv[bj][n] = *(const f32x4*)(g1 + col0 + bj * HALF + n * 16) * alpha;
#pragma unroll
            for (int ai = 0; ai < 2; ++ai)
#pragma unroll
                for (int m = 0; m < 4; ++m) { const int r = ai * HALF + wr * 64 + m * 16 + fr; const float rs = S[r]; const size_t off = (size_t)(u.pm * BM + r) * ldc + col0;
#pragma unroll
                    for (int bj = 0; bj < 2; ++bj)
#pragma unroll
                        for (int n = 0; n < 2; ++n) { const f32x4 bs = (ai == 0 && m < NPRE) ? pre[m < NPRE ? m : 0][bj][n] : *(const f32x4*)(base + off + bj * HALF + n * 16); acc[ai][bj][m][n] = bs + (acc[ai][bj][m][n] * rs) * gv[bj][n]; }
                    asm volatile("" : "+v"(acc[ai][0][m][0]), "+v"(acc[ai][0][m][1]), "+v"(acc[ai][1][m][0]), "+v"(acc[ai][1][m][1]));
                    if (m & 1) asm volatile("" ::: "memory"); }
        }
        const bool bad1 = bad;
        PSTAMP(22);
        bad = st2.run(acc, u, wr, wc, fr, fq, lds, wid, lane) || bad;
        PSTAMP(23);
        f32x4 gw[2][2];
#pragma unroll
        for (int bj = 0; bj < 2; ++bj)
#pragma unroll
            for (int n = 0; n < 2; ++n) gw[bj][n] = *(const f32x4*)(g2 + col0 + bj * HALF + n * 16);
#pragma unroll
        for (int ai = 0; ai < 2; ++ai)
#pragma unroll
            for (int m = 0; m < 4; ++m) { const int r = ai * HALF + wr * 64 + m * 16 + fr; const float rs = S[r]; const size_t off = (size_t)(u.pm * BM + r) * ldc + col0;
#pragma unroll
                for (int bj = 0; bj < 2; ++bj)
#pragma unroll
                    for (int n = 0; n < 2; ++n) { const f32x4 h = acc[ai][bj][m][n]; *(f32x4*)(out + off + bj * HALF + n * 16) = bad1 ? (f32x4){qnan, qnan, qnan, qnan} : h;
                        const f32x4 o = (h * rs) * gw[bj][n]; u32x2v w; w.x = cvt_pk_bf16(o[0], o[1]); w.y = cvt_pk_bf16(o[2], o[3]);
                        if (bad) { w.x = 0x7fc07fc0u; w.y = 0x7fc07fc0u; } *(u32x2v*)(xn + off + bj * HALF + n * 16) = w; }
                asm volatile("" ::: "memory"); }
    }
};

typedef unsigned u32x2 __attribute__((ext_vector_type(2)));
__device__ __forceinline__ f32x4 bf4_to_f32(u32x2 w) { return (f32x4){__uint_as_float(w.x << 16), __uint_as_float(w.x & 0xffff0000u), __uint_as_float(w.y << 16), __uint_as_float(w.y & 0xffff0000u)}; }
__device__ __forceinline__ u32x2 f32_to_bf4(f32x4 v) { u32x2 w; w.x = cvt_pk_bf16(v[0], v[1]); w.y = cvt_pk_bf16(v[2], v[3]); return w; }
struct EpiRmsResB {
    static constexpr bool PERM = false, AFTER_DRAIN = true;
    const bf16_t* base; float* out; int ldc; const float* g; float alpha; PanelRms st; const float* row_descale; const float* col_gain;
    __device__ __forceinline__ void fused(f32x4 (&acc)[2][2][4][2], const Unit& u, int wr, int wc, int fr, int fq, PG8_LAS unsigned char* lds, int wid, int lane) const {
        const PG8_LAS float* S = (const PG8_LAS float*)(lds + 8192);
        const int col0 = u.pn * BM + wc * 32 + 4 * fq;
        u32x2 pre[2][4][2][2];
#pragma unroll
        for (int ai = 0; ai < 2; ++ai)
#pragma unroll
            for (int m = 0; m < 4; ++m) { const size_t off = (size_t)(u.pm * BM + ai * HALF + wr * 64 + m * 16 + fr) * ldc + col0;
#pragma unroll
                for (int bj = 0; bj < 2; ++bj)
#pragma unroll
                    for (int n = 0; n < 2; ++n) pre[ai][m][bj][n] = *(const u32x2*)(base + off + bj * HALF + n * 16); }
        const bool bad = st.run(acc, u, wr, wc, fr, fq, lds, wid, lane);
        const float qnan = __builtin_nanf("");
        f32x4 gv[2][2];
#pragma unroll
        for (int bj = 0; bj < 2; ++bj)
#pragma unroll
            for (int n = 0; n < 2; ++n) gv[bj][n] = *(const f32x4*)(g + col0 + bj * HALF + n * 16) * alpha;
#pragma unroll
        for (int ai = 0; ai < 2; ++ai)
#pragma unroll
            for (int m = 0; m < 4; ++m) { const int r = ai * HALF + wr * 64 + m * 16 + fr; const float rs = S[r], rd = row_descale[u.pm * BM + r]; const size_t off = (size_t)(u.pm * BM + r) * ldc + col0;
#pragma unroll
                for (int bj = 0; bj < 2; ++bj)
#pragma unroll
                    for (int n = 0; n < 2; ++n) { f32x4 o = bf4_to_f32(pre[ai][m][bj][n]) * rd + (acc[ai][bj][m][n] * rs) * gv[bj][n];
                        if (bad) o = (f32x4){qnan, qnan, qnan, qnan}; *(f32x4*)(out + off + bj * HALF + n * 16) = o; } }
    }
};
template <bool BASE_BF16> struct EpiRmsResRmsB {
    static constexpr bool PERM = false, AFTER_DRAIN = true;
    const void* base; bf16_t* outb; bf16_t* xn; int ldc; const float* g1; float alpha; const float* g2; PanelRms st1, st2;
    float* rinv_out;
    const float* row_descale; const float* col_gain;
    __device__ __forceinline__ void fused(f32x4 (&acc)[2][2][4][2], const Unit& u, int wr, int wc, int fr, int fq, PG8_LAS unsigned char* lds, int wid, int lane) const {
        const PG8_LAS float* S = (const PG8_LAS float*)(lds + 8192);
        const int col0 = u.pn * BM + wc * 32 + 4 * fq;
        constexpr int NPRE = 4;
        f32x4 pref[BASE_BF16 ? 1 : NPRE][2][2]; u32x2 preb[BASE_BF16 ? 2 : 1][4][2][2];
        float rdes[2][4];
#pragma unroll
        for (int ai = 0; ai < 2; ++ai)
#pragma unroll
            for (int m = 0; m < 4; ++m) rdes[ai][m] = (BASE_BF16 && row_descale) ? row_descale[u.pm * BM + ai * HALF + wr * 64 + m * 16 + fr] : 1.0f;
        if (BASE_BF16) {
#pragma unroll
            for (int ai = 0; ai < 2; ++ai)
#pragma unroll
                for (int m = 0; m < 4; ++m) { const size_t off = (size_t)(u.pm * BM + ai * HALF + wr * 64 + m * 16 + fr) * ldc + col0;
#pragma unroll
                    for (int bj = 0; bj < 2; ++bj)
#pragma unroll
                        for (int n = 0; n < 2; ++n) if (!(row_descale && ai == 1 && m >= 2)) preb[BASE_BF16 ? ai : 0][m][bj][n] = *(const u32x2*)((const bf16_t*)base + off + bj * HALF + n * 16); }
        } else {
#pragma unroll
            for (int m = 0; m < NPRE; ++m) { const size_t off = (size_t)(u.pm * BM + wr * 64 + m * 16 + fr) * ldc + col0;
#pragma unroll
                for (int bj = 0; bj < 2; ++bj)
#pragma unroll
                    for (int n = 0; n < 2; ++n) pref[BASE_BF16 ? 0 : m][bj][n] = *(const f32x4*)((const float*)base + off + bj * HALF + n * 16); }
        }
        bool bad = st1.run(acc, u, wr, wc, fr, fq, lds, wid, lane);
        {
            f32x4 gv[2][2];
#pragma unroll
            for (int bj = 0; bj < 2; ++bj)
#pragma unroll
                for (int n = 0; n < 2; ++n) gv[bj][n] = *(const f32x4*)(g1 + col0 + bj * HALF + n * 16) * alpha;
            f32x4 cinv[2][2];
#pragma unroll
            for (int bj = 0; bj < 2; ++bj)
#pragma unroll
                for (int n = 0; n < 2; ++n) { cinv[bj][n] = (f32x4){1.f, 1.f, 1.f, 1.f}; if (BASE_BF16 && col_gain) { const f32x4 gg = *(const f32x4*)(col_gain + col0 + bj * HALF + n * 16); cinv[bj][n] = (f32x4){1.0f / gg[0], 1.0f / gg[1], 1.0f / gg[2], 1.0f / gg[3]}; } }
#pragma unroll
            for (int ai = 0; ai < 2; ++ai)
#pragma unroll
                for (int m = 0; m < 4; ++m) { const int r = ai * HALF + wr * 64 + m * 16 + fr; const float rs = S[r]; const size_t off = (size_t)(u.pm * BM + r) * ldc + col0;
#pragma unroll
                    for (int bj = 0; bj < 2; ++bj)
#pragma unroll
                        for (int n = 0; n < 2; ++n) { f32x4 bs;
                            if (BASE_BF16) bs = bf4_to_f32((row_descale && ai == 1 && m >= 2) ? *(const u32x2*)((const bf16_t*)base + off + bj * HALF + n * 16) : preb[BASE_BF16 ? ai : 0][m][bj][n]) * (cinv[bj][n] * rdes[ai][m]);
                            else bs = (ai == 0 && m < NPRE) ? pref[(!BASE_BF16 && m < NPRE) ? m : 0][bj][n] : *(const f32x4*)((const float*)base + off + bj * HALF + n * 16);
                            acc[ai][bj][m][n] = bs + (acc[ai][bj][m][n] * rs) * gv[bj][n]; }
                    asm volatile("" : "+v"(acc[ai][0][m][0]), "+v"(acc[ai][0][m][1]), "+v"(acc[ai][1][m][0]), "+v"(acc[ai][1][m][1]));
                    if (!BASE_BF16 && (m & 1)) asm volatile("" ::: "memory"); }
        }
        bad = st2.run(acc, u, wr, wc, fr, fq, lds, wid, lane) || bad;
        f32x4 gw[2][2];
#pragma unroll
        for (int bj = 0; bj < 2; ++bj)
#pragma unroll
            for (int n = 0; n < 2; ++n) gw[bj][n] = *(const f32x4*)(g2 + col0 + bj * HALF + n * 16);
#pragma unroll
        for (int ai = 0; ai < 2; ++ai)
#pragma unroll
            for (int m = 0; m < 4; ++m) { const int r = ai * HALF + wr * 64 + m * 16 + fr; const float rs = S[r]; const size_t off = (size_t)(u.pm * BM + r) * ldc + col0;
#pragma unroll
                for (int bj = 0; bj < 2; ++bj)
#pragma unroll
                    for (int n = 0; n < 2; ++n) { const f32x4 h = acc[ai][bj][m][n]; u32x2 hw = f32_to_bf4(h), w = f32_to_bf4((h * rs) * gw[bj][n]);
                        if (bad) { hw = (u32x2){0x7fc07fc0u, 0x7fc07fc0u}; w = hw; }
                        if (outb) *(u32x2*)(outb + off + bj * HALF + n * 16) = hw; *(u32x2*)(xn + off + bj * HALF + n * 16) = w; }
                if (rinv_out && u.pn == 0 && wc == 0 && fq == 0) rinv_out[u.pm * BM + r] = 1.0f / rs; }
    }
};


struct EpiRmsResRmsP {
    static constexpr bool PERM = true, AFTER_DRAIN = true;
    const bf16_t* base; bf16_t* xn; int ldc; const float* g1; float alpha; const float* g2; PanelRms st1, st2; float* rinv_out; const float* row_descale; const float* col_gain;
    __device__ __forceinline__ void fused(f32x4 (&acc)[2][2][4][2], const Unit& u, int wr, int wc, int fr, int fq, PG8_LAS unsigned char* lds, int wid, int lane) const {
        const PG8_LAS float* S = (const PG8_LAS float*)(lds + 8192);
        const int col0 = u.pn * BM + wc * 32 + 8 * fq;
        u32x4 pre[2][4][2]; float rdes[2][4];
#pragma unroll
        for (int ai = 0; ai < 2; ++ai)
#pragma unroll
            for (int m = 0; m < 4; ++m) { const size_t off = (size_t)(u.pm * BM + ai * HALF + wr * 64 + m * 16 + fr) * ldc + col0;
                rdes[ai][m] = row_descale[u.pm * BM + ai * HALF + wr * 64 + m * 16 + fr];
                if (!(ai == 1 && m >= 2)) {
#pragma unroll
                    for (int bj = 0; bj < 2; ++bj) pre[ai][m][bj] = *(const u32x4*)(base + off + bj * HALF); } }
        bool bad = st1.run(acc, u, wr, wc, fr, fq, lds, wid, lane);
        {
            f32x4 gv[2][2];
#pragma unroll
            for (int bj = 0; bj < 2; ++bj)
#pragma unroll
                for (int n = 0; n < 2; ++n) gv[bj][n] = *(const f32x4*)(g1 + col0 + bj * HALF + 4 * n) * alpha;
#pragma unroll
            for (int ai = 0; ai < 2; ++ai)
#pragma unroll
                for (int m = 0; m < 4; ++m) { const int r = ai * HALF + wr * 64 + m * 16 + fr; const float rs = S[r]; const size_t off = (size_t)(u.pm * BM + r) * ldc + col0;
#pragma unroll
                    for (int bj = 0; bj < 2; ++bj) { const u32x4 w = (ai == 1 && m >= 2) ? *(const u32x4*)(base + off + bj * HALF) : pre[ai][m][bj];
                        const f32x4 b0 = bf4_to_f32((u32x2){w.x, w.y}) * rdes[ai][m], b1 = bf4_to_f32((u32x2){w.z, w.w}) * rdes[ai][m];
                        acc[ai][bj][m][0] = b0 + (acc[ai][bj][m][0] * rs) * gv[bj][0]; acc[ai][bj][m][1] = b1 + (acc[ai][bj][m][1] * rs) * gv[bj][1]; }
                    asm volatile("" : "+v"(acc[ai][0][m][0]), "+v"(acc[ai][0][m][1]), "+v"(acc[ai][1][m][0]), "+v"(acc[ai][1][m][1])); }
        }
        bad = st2.run(acc, u, wr, wc, fr, fq, lds, wid, lane) || bad;
#pragma unroll
        for (int ai = 0; ai < 2; ++ai)
#pragma unroll
            for (int m = 0; m < 4; ++m) { const int r = ai * HALF + wr * 64 + m * 16 + fr; const float rs = S[r]; const size_t off = (size_t)(u.pm * BM + r) * ldc + col0;
#pragma unroll
                for (int bj = 0; bj < 2; ++bj) { const f32x4 o0 = acc[ai][bj][m][0] * rs, o1 = acc[ai][bj][m][1] * rs;
                    u32x4 w; w.x = cvt_pk_bf16(o0[0], o0[1]); w.y = cvt_pk_bf16(o0[2], o0[3]); w.z = cvt_pk_bf16(o1[0], o1[1]); w.w = cvt_pk_bf16(o1[2], o1[3]);
                    if (bad) w = (u32x4){0x7fc07fc0u, 0x7fc07fc0u, 0x7fc07fc0u, 0x7fc07fc0u};
                    *(u32x4*)(xn + off + bj * HALF) = w; }
                if (rinv_out && u.pn == 0 && wc == 0 && fq == 0) rinv_out[u.pm * BM + r] = 1.0f / rs; }
    }
};

struct EpiGLURms {
    static constexpr bool PERM = true, AFTER_DRAIN = true;
    const bf16_t* Y; bf16_t* XN; const float* bias; const float* g; PanelRms st;
    __device__ __forceinline__ void fused(f32x4 (&acc)[2][2][4][2], const Unit& u, int wr, int wc, int fr, int fq, PG8_LAS unsigned char* lds, int wid, int lane) const {
        const PG8_LAS float* S = (const PG8_LAS float*)(lds + 8192);
        const int row0 = u.pm * BM + wr * 64 + fr, col0 = u.pn * BM + wc * 32 + 8 * fq;
#pragma unroll
        for (int ai = 0; ai < 2; ++ai)
#pragma unroll
            for (int m = 0; m < 4; ++m) { const size_t ro = (size_t)(row0 + ai * HALF + m * 16) * 512 + col0;
#pragma unroll
                for (int bj = 0; bj < 2; ++bj) { const u32x4 yw = *(const u32x4*)(Y + ro + bj * HALF);
                    const f32x4 b0 = *(const f32x4*)(bias + col0 + bj * HALF), b1 = *(const f32x4*)(bias + col0 + bj * HALF + 4);
#pragma unroll
                    for (int e = 0; e < 8; ++e) { const float a = (e < 4 ? acc[ai][bj][m][0][e & 3] : acc[ai][bj][m][1][e & 3]) + (e < 4 ? b0[e & 3] : b1[e & 3]);
                        const unsigned yy = yw[e >> 1]; const float y = __uint_as_float((e & 1) ? (yy & 0xffff0000u) : (yy << 16));
                        const float z = y * __builtin_amdgcn_rcpf(1.0f + __builtin_amdgcn_exp2f(-1.4426950408889634f * a));
                        if (e < 4) acc[ai][bj][m][0][e & 3] = z; else acc[ai][bj][m][1][e & 3] = z; } } }
        const bool bad = st.run(acc, u, wr, wc, fr, fq, lds, wid, lane);
#pragma unroll
        for (int ai = 0; ai < 2; ++ai)
#pragma unroll
            for (int m = 0; m < 4; ++m) { const int r = ai * HALF + wr * 64 + m * 16 + fr; const float rs = S[r]; bf16_t* rowp = XN + (size_t)(u.pm * BM + r) * 1024 + 512 + col0;
#pragma unroll
                for (int bj = 0; bj < 2; ++bj) { const f32x4 v0 = acc[ai][bj][m][0] * rs, v1 = acc[ai][bj][m][1] * rs;
                    u32x4 w; w.x = cvt_pk_bf16(v0[0], v0[1]); w.y = cvt_pk_bf16(v0[2], v0[3]); w.z = cvt_pk_bf16(v1[0], v1[1]); w.w = cvt_pk_bf16(v1[2], v1[3]);
                    if (bad) w = (u32x4){0x7fc07fc0u, 0x7fc07fc0u, 0x7fc07fc0u, 0x7fc07fc0u};
                    *(u32x4*)(rowp + bj * HALF) = w; } }
    }
};

template <class Epi, class Sched, bool ALIGN_EPI = false, bool SP2 = false>
__device__ __forceinline__ void gemm_phase(PG8_LAS unsigned char* lds, const Gemm g, const Sched& S, const Epi& E) {
    int tid_ = threadIdx.x; asm volatile("" : "+v"(tid_));
    const int tid = tid_, wid = __builtin_amdgcn_readfirstlane(tid >> 6), lane = tid & 63, wr = wid >> 2, wc = wid & 3, fr = lane & 15, fq = lane >> 4;
    const int K = g.K, nt = K / BK;
    unsigned voffA[2], voffB[2];
#pragma unroll
    for (int i = 0; i < 2; ++i) { int R, C; stage_rc(tid * 16 + i * 8192, R, C); const int Rb = Epi::PERM ? ((R & ~31) + perm32(R & 31)) : R;
        voffA[i] = (unsigned)(R * K + C) * 2u; voffB[i] = (unsigned)(Rb * K + C) * 2u; }
    const size_t kstep = (size_t)(BK * 2);
    const size_t hstep = (size_t)HALF * K * 2;
    const size_t tstep = 2 * hstep;
    const unsigned ldsw = (unsigned)wid * 1024u;
    const int aoff = lds_byte(wr * 64 + fr, fq * 8), boff = lds_byte(wc * 32 + fr, fq * 8);
#define PG8_SA(b, h) (((b) * 2 + (h)) * HTB)
#define PG8_SB(b, h) ((4 + (b) * 2 + (h)) * HTB)
#define PG8_STAGE(bufoff, gbase, voff) do { _Pragma("unroll") for (int _i = 0; _i < 2; ++_i) \
        __builtin_amdgcn_global_load_lds((const unsigned*)((const char*)(gbase) + (voff)[_i]), (PG8_LAS unsigned*)(lds + (bufoff) + ldsw + _i * 8192), 16, 0, 0); } while (0)
#define PG8_LDA(dst, b, h) do { _Pragma("unroll") for (int m = 0; m < 4; ++m) _Pragma("unroll") for (int k = 0; k < 2; ++k) dst[m][k] = *(const PG8_LAS bf16x8*)(lds + PG8_SA(b, h) + aoff + m * 2048 + k * 1024); } while (0)
#define PG8_LDB(dst, b, h) do { _Pragma("unroll") for (int n = 0; n < 2; ++n) _Pragma("unroll") for (int k = 0; k < 2; ++k) dst[n][k] = *(const PG8_LAS bf16x8*)(lds + PG8_SB(b, h) + boff + n * 2048 + k * 1024); } while (0)
#define PG8_MMA(ai, bj, At, Bt) do { if (hsel >= 0 && hsel != (ai)) break; __builtin_amdgcn_s_setprio(1); _Pragma("unroll") for (int m = 0; m < 4; ++m) _Pragma("unroll") for (int n = 0; n < 2; ++n) _Pragma("unroll") for (int k = 0; k < 2; ++k) \
        acc[ai][bj][m][n] = __builtin_amdgcn_mfma_f32_16x16x32_bf16(Bt[n][k], At[m][k], acc[ai][bj][m][n], 0, 0, 0); __builtin_amdgcn_s_setprio(0); } while (0)
#define PG8_WAIT_V(n) asm volatile("s_waitcnt vmcnt(" #n ")" ::: "memory")
#define PG8_WAIT_L(n) asm volatile("s_waitcnt lgkmcnt(" #n ")" ::: "memory")
#define PG8_BAR __builtin_amdgcn_s_barrier()
#define PG8_SCHED __builtin_amdgcn_sched_barrier(0)
    Unit cur, nxt; int ui = 0;
    if (!S.next(0, cur)) return;
    int hsel = cur.half;
    f32x4 acc[2][2][4][2];
#pragma unroll
    for (int a = 0; a < 2; ++a)
#pragma unroll
        for (int b = 0; b < 2; ++b)
#pragma unroll
            for (int m = 0; m < 4; ++m)
#pragma unroll
                for (int n = 0; n < 2; ++n) acc[a][b][m][n] = (f32x4){0.f, 0.f, 0.f, 0.f};
    bf16x8 At[4][2], B0[2][2], B1[2][2];
    const char* cA = (const char*)g.A + (size_t)cur.pm * tstep; const char* cB = (const char*)g.Bt + (size_t)cur.pn * tstep;
    S.a_ready(cur);
    if constexpr (SP2) {
        PG8_STAGE(PG8_SB(0, 0), cB, voffB); PG8_STAGE(PG8_SB(0, 1), cB + hstep, voffB); PG8_STAGE(PG8_SA(0, 0), cA, voffA); PG8_STAGE(PG8_SA(0, 1), cA + hstep, voffA);
        if (wr == 1) PG8_BAR;
        PG8_WAIT_V(2); PG8_BAR;
        PG8_STAGE(PG8_SB(1, 0), cB + kstep, voffB); PG8_STAGE(PG8_SA(1, 0), cA + kstep, voffA); PG8_STAGE(PG8_SB(1, 1), cB + hstep + kstep, voffB);
        PG8_WAIT_V(6); PG8_BAR;
    } else {
        PG8_STAGE(PG8_SB(0, 0), cB, voffB); PG8_STAGE(PG8_SA(0, 0), cA, voffA); PG8_STAGE(PG8_SB(0, 1), cB + hstep, voffB); PG8_STAGE(PG8_SA(0, 1), cA + hstep, voffA);
        if (wr == 1) PG8_BAR;
        PG8_WAIT_V(4); PG8_BAR;
        PG8_STAGE(PG8_SB(1, 0), cB + kstep, voffB); PG8_STAGE(PG8_SA(1, 0), cA + kstep, voffA); PG8_STAGE(PG8_SB(1, 1), cB + hstep + kstep, voffB);
        PG8_WAIT_V(6); PG8_BAR;
    }
    for (;;) {
        const bool has_next = S.next(ui + 1, nxt);
        const char* nA = has_next ? (const char*)g.A + (size_t)nxt.pm * tstep : cA; const char* nB = has_next ? (const char*)g.Bt + (size_t)nxt.pn * tstep : cB;
        for (int t = 0; t < nt; t += 2) {
            const bool last = (t == nt - 2);
            const char* a1 = cA + (size_t)(t + 1) * kstep;
            const char* a2 = last ? nA : cA + (size_t)(t + 2) * kstep; const char* b2 = last ? nB : cB + (size_t)(t + 2) * kstep;
            const char* a3 = a2 + kstep; const char* b3 = b2 + kstep;
            if (last && has_next) S.a_ready(nxt);
            if constexpr (SP2) {
            PG8_LDB(B0, 0, 0); PG8_LDB(B1, 0, 1); PG8_SCHED; if (hsel != 1) PG8_LDA(At, 0, 0); PG8_STAGE(PG8_SA(1, 1), a1 + hstep, voffA);
            PG8_WAIT_V(8); PG8_WAIT_L(0); PG8_BAR; PG8_MMA(0, 0, At, B0); PG8_MMA(0, 1, At, B1); PG8_BAR; PG8_SCHED;
            if (hsel != 0) PG8_LDA(At, 0, 1); PG8_STAGE(PG8_SB(0, 0), b2, voffB); PG8_STAGE(PG8_SB(0, 1), b2 + hstep, voffB); PG8_STAGE(PG8_SA(0, 0), a2, voffA);
            PG8_WAIT_V(8); PG8_WAIT_L(0); PG8_BAR; PG8_MMA(1, 0, At, B0); PG8_MMA(1, 1, At, B1); PG8_BAR; PG8_SCHED;
            PG8_LDB(B0, 1, 0); PG8_LDB(B1, 1, 1); PG8_SCHED; if (hsel != 1) PG8_LDA(At, 1, 0); PG8_STAGE(PG8_SA(0, 1), a2 + hstep, voffA);
            PG8_WAIT_V(8); PG8_WAIT_L(0); PG8_BAR; PG8_MMA(0, 0, At, B0); PG8_MMA(0, 1, At, B1); PG8_BAR; PG8_SCHED;
            if (hsel != 0) PG8_LDA(At, 1, 1); PG8_STAGE(PG8_SB(1, 0), b3, voffB); PG8_STAGE(PG8_SB(1, 1), b3 + hstep, voffB); PG8_STAGE(PG8_SA(1, 0), a3, voffA);
            PG8_WAIT_V(8); PG8_WAIT_L(0); PG8_BAR; PG8_MMA(1, 0, At, B0); PG8_MMA(1, 1, At, B1); PG8_BAR; PG8_SCHED;
            } else {
            PG8_LDB(B0, 0, 0); PG8_SCHED; PG8_LDA(At, 0, 0); PG8_STAGE(PG8_SA(1, 1), a1 + hstep, voffA);
            PG8_WAIT_L(8); PG8_BAR; PG8_WAIT_L(0); PG8_MMA(0, 0, At, B0); PG8_BAR; PG8_SCHED;
            PG8_LDB(B1, 0, 1); PG8_STAGE(PG8_SB(0, 0), b2, voffB);
            PG8_BAR; PG8_WAIT_L(0); PG8_MMA(0, 1, At, B1); PG8_BAR;
            PG8_LDA(At, 0, 1); PG8_STAGE(PG8_SA(0, 0), a2, voffA);
            PG8_BAR; PG8_WAIT_L(0); PG8_MMA(1, 0, At, B0); PG8_BAR; PG8_SCHED;
            PG8_STAGE(PG8_SB(0, 1), b2 + hstep, voffB);
            PG8_WAIT_V(6); PG8_BAR; PG8_MMA(1, 1, At, B1); PG8_BAR;
            PG8_LDB(B0, 1, 0); PG8_SCHED; PG8_LDA(At, 1, 0); PG8_STAGE(PG8_SA(0, 1), a2 + hstep, voffA);
            PG8_WAIT_L(8); PG8_BAR; PG8_WAIT_L(0); PG8_MMA(0, 0, At, B0); PG8_BAR; PG8_SCHED;
            PG8_LDB(B1, 1, 1); PG8_STAGE(PG8_SB(1, 0), b3, voffB);
            PG8_BAR; PG8_WAIT_L(0); PG8_MMA(0, 1, At, B1); PG8_BAR;
            PG8_LDA(At, 1, 1); PG8_STAGE(PG8_SA(1, 0), a3, voffA);
            PG8_BAR; PG8_WAIT_L(0); PG8_MMA(1, 0, At, B0); PG8_BAR; PG8_SCHED;
            PG8_STAGE(PG8_SB(1, 1), b3 + hstep, voffB);
            PG8_WAIT_V(6); PG8_BAR; PG8_MMA(1, 1, At, B1); PG8_BAR;
            }
        }
        if constexpr (ALIGN_EPI) { if (wr == 0) PG8_BAR; }
        if constexpr (!Epi::AFTER_DRAIN) { E(acc, cur, wr, wc, fr, fq); S.done(cur); }
        if (!has_next) break;
#pragma unroll
        for (int a = 0; a < 2; ++a)
#pragma unroll
            for (int b = 0; b < 2; ++b)
#pragma unroll
                for (int m = 0; m < 4; ++m)
#pragma unroll
                    for (int n = 0; n < 2; ++n) acc[a][b][m][n] = (f32x4){0.f, 0.f, 0.f, 0.f};
        cur = nxt; cA = nA; cB = nB; ++ui; hsel = cur.half;
        if constexpr (ALIGN_EPI) { if (wr == 1) PG8_BAR; }
    }
    if constexpr (!ALIGN_EPI) { if (wr == 0) PG8_BAR; }
    PG8_BAR;
    if constexpr (Epi::AFTER_DRAIN) { E.fused(acc, cur, wr, wc, fr, fq, lds + 3 * HTB, wid, lane); S.done(cur); }
#undef PG8_SA
#undef PG8_SB
#undef PG8_STAGE
#undef PG8_LDA
#undef PG8_LDB
#undef PG8_MMA
#undef PG8_WAIT_V
#undef PG8_WAIT_L
#undef PG8_BAR
#undef PG8_SCHED
}
}

constexpr bool PG8_SP2 = true, PG8_ALIGN = true;

#define GAS __attribute__((address_space(1)))
#define LAS __attribute__((address_space(3)))
#define XB_TMO      128
#define XB_XCNT(j)  (256  + 64 * (j))
#define XB_XSUB(j)  (1280 + 64 * (j))
#define XB_XGEN(j)  (2304 + 64 * (j))
#define XB_TOP      3328
#define XB_TOPGEN   3392
#define XCD_BAR_WORDS 3456
#define XB_SPIN_CAP (1u << 22)
__device__ __forceinline__ unsigned xb_ld(unsigned* p)              { return __hip_atomic_load(p, __ATOMIC_RELAXED, __HIP_MEMORY_SCOPE_AGENT); }
__device__ __forceinline__ unsigned xb_add(unsigned* p, unsigned v) { return __hip_atomic_fetch_add(p, v, __ATOMIC_RELAXED, __HIP_MEMORY_SCOPE_AGENT); }
__device__ __forceinline__ unsigned xb_xcc_id() { return (unsigned)__builtin_amdgcn_s_getreg((3 << 11) | 20) & 0xFu; }
#define XB_SPIN(cond, bar) do { unsigned _sp = 0; while (cond) { __builtin_amdgcn_s_sleep(1); \
    if ((++_sp & 255u) == 0u) { if (xb_ld(&(bar)[XB_TMO])) break; if (_sp > XB_SPIN_CAP) { atomicAdd(&(bar)[XB_TMO], 1u); break; } } } } while (0)
struct XcdBarrier { unsigned* bar; unsigned x; volatile LAS unsigned* st; };
__device__ __forceinline__ XcdBarrier xcd_barrier_post(unsigned* bar, volatile LAS unsigned* st) {
    XcdBarrier b; b.bar = bar; b.x = xb_xcc_id(); b.st = st;
    if (threadIdx.x == 0) (void)xb_add(&bar[XB_XCNT(b.x)], 1u);
    return b;
}
__device__ __forceinline__ void xcd_barrier_complete(unsigned* bar, unsigned x, unsigned& nloc, unsigned& nx) {
    const unsigned G = gridDim.x * gridDim.y * gridDim.z;
    unsigned sum, cnt, mine, sp = 0u;
    for (;;) {
        sum = 0u; cnt = 0u; mine = 0u;
#pragma unroll
        for (unsigned j = 0; j < 16; ++j) { const unsigned c = xb_ld(&bar[XB_XCNT(j)]); sum += c; cnt += (c > 0u) ? 1u : 0u; mine = (j == x) ? c : mine; }
        if (sum == G) break;
        __builtin_amdgcn_s_sleep(1);
        if ((++sp & 255u) == 0u) { if (xb_ld(&bar[XB_TMO])) break; if (sp > XB_SPIN_CAP) { atomicAdd(&bar[XB_TMO], 1u); break; } }
    }
    nloc = mine > 0u ? mine : 1u; nx = cnt > 0u ? cnt : 1u;
}
__device__ __forceinline__ void xcd_barrier(const XcdBarrier& b) {
    asm volatile("s_waitcnt vmcnt(0)" ::: "memory");
    __syncthreads();
    if (threadIdx.x == 0) {
        unsigned* bar = b.bar;
        __builtin_amdgcn_s_waitcnt(0);
        unsigned nloc = b.st[0], nx = b.st[1];
        if (nloc == 0u) { xcd_barrier_complete(bar, b.x, nloc, nx); b.st[0] = nloc; b.st[1] = nx; }
        const unsigned old = xb_add(&bar[XB_XSUB(b.x)], 1u);
        const unsigned gen = old / nloc;
        if (old + 1u == (gen + 1u) * nloc) {
            __builtin_amdgcn_fence(__ATOMIC_RELEASE, "agent");
            asm volatile("s_waitcnt vmcnt(0)" ::: "memory");
            const unsigned og = xb_add(&bar[XB_TOP], 1u);
            const unsigned tg = og / nx;
            if (og + 1u == (tg + 1u) * nx) xb_add(&bar[XB_TOPGEN], 1u);
            else XB_SPIN(xb_ld(&bar[XB_TOPGEN]) == tg, bar);
            __builtin_amdgcn_fence(__ATOMIC_ACQUIRE, "agent");
            xb_add(&bar[XB_XGEN(b.x)], 1u);
            asm volatile("s_waitcnt vmcnt(0)" ::: "memory");
        } else {
            XB_SPIN(xb_ld(&bar[XB_XGEN(b.x)]) == gen, bar);
            __builtin_amdgcn_fence(__ATOMIC_ACQUIRE, "agent");
            asm volatile("s_waitcnt vmcnt(0)" ::: "memory");
        }
    }
    __syncthreads();
}
__device__ __forceinline__ unsigned f2bf(float f) { unsigned u = __builtin_bit_cast(unsigned, f); return (u + 0x7fffu + ((u >> 16) & 1u)) >> 16; }
__device__ __forceinline__ unsigned pk2(float lo, float hi) { return pg8::cvt_pk_bf16(lo, hi); }

#define XB_GMAX(k)  (3456 + 8 * (k))
#define XB_GMIN(k)  (3520 + 8 * (k))
__device__ __forceinline__ void group_census_post(const XcdBarrier& b) {
    if (threadIdx.x == 0) { const unsigned k = blockIdx.x & 7u; atomicMax(&b.bar[XB_GMAX(k)], b.x + 1u); atomicMax(&b.bar[XB_GMIN(k)], 16u - b.x); }
}
__device__ __forceinline__ bool groups_colocated(const XcdBarrier& b, volatile LAS unsigned* flag) {
    if (threadIdx.x == 0) { unsigned ok = (gridDim.x % 8u == 0u) ? 1u : 0u;
#pragma unroll
        for (unsigned k = 0; k < 8; ++k) ok &= (xb_ld(&b.bar[XB_GMAX(k)]) + xb_ld(&b.bar[XB_GMIN(k)]) == 17u) ? 1u : 0u;
        *flag = ok; }
    __syncthreads();
    return *flag != 0u;
}
__device__ __forceinline__ void xcd_barrier_local(const XcdBarrier& b) {
    asm volatile("s_waitcnt vmcnt(0)" ::: "memory");
    __syncthreads();
    if (threadIdx.x == 0) {
        unsigned* bar = b.bar;
        __builtin_amdgcn_s_waitcnt(0);
        const unsigned nloc = b.st[0];
        const unsigned old = xb_add(&bar[XB_XSUB(b.x)], 1u);
        const unsigned gen = old / nloc;
        if (old + 1u == (gen + 1u) * nloc) xb_add(&bar[XB_XGEN(b.x)], 1u);
        else XB_SPIN(xb_ld(&bar[XB_XGEN(b.x)]) == gen, bar);
        __builtin_amdgcn_fence(__ATOMIC_ACQUIRE, "agent");
        asm volatile("s_waitcnt vmcnt(0)" ::: "memory");
    }
    __syncthreads();
}
__device__ __forceinline__ float wave_sum(float v) {
#pragma unroll
    for (int o = 1; o < 64; o <<= 1) v += __shfl_xor(v, o);
    return v;
}

#include <hip/hip_bf16.h>
#include <cmath>
namespace attn_body {
using bf16=__hip_bfloat16;
using bf16x8=__attribute__((ext_vector_type(8)))short;
using s16x4=__attribute__((ext_vector_type(4)))short;
using f32x16=__attribute__((ext_vector_type(16)))float;
using u32x4=__attribute__((ext_vector_type(4)))unsigned;
constexpr int BATCH=8,NHEAD=8,SEQ=2048,D=64,DM=NHEAD*D;
constexpr int NW=8,QBLK=32,QB=QBLK*NW,KVBLK=64,NQB=SEQ/QB;
constexpr int ATTN_PITCH=DM, ATTN_UNIT_ROWS=QB;
__device__ __forceinline__ int crow(int r,int hi){return (r&3)+8*(r>>2)+4*hi;}
#define SBAR() __builtin_amdgcn_sched_barrier(0)
__device__ __forceinline__ void cmask(f32x16&p0,f32x16&p1,int jb,int qrel,int hi){
  const float NEG=-INFINITY; int kb=64*jb+4*hi;
  #pragma unroll
  for(int r=0;r<16;++r){int kv=kb+(r&3)+8*(r>>2); if(kv>qrel)p0[r]=NEG; if(kv+32>qrel)p1[r]=NEG;}
}

constexpr int NSLOT=3, SLOTB=8192;
constexpr int LDS_K=0, LDS_V=NSLOT*SLOTB, LDS_WS=2*NSLOT*SLOTB, LDS_OST=LDS_WS+NW*64*4, LDS_BYTES=LDS_OST+NW*4096;
constexpr float C2=0.125f*1.4426950408889634f;
__device__ __forceinline__ void glds16(const void*gsrc,unsigned lds_dst){unsigned keep;
  asm volatile("s_mov_b32 %0, m0\n\ts_mov_b32 m0, %2\n\ts_nop 0\n\tglobal_load_lds_dwordx4 %1, off\n\ts_mov_b32 m0, %0":"=&s"(keep):"v"(gsrc),"s"(lds_dst):"memory");}
__device__ __forceinline__ float max3f(float a,float b,float c){float r;asm("v_max3_f32 %0, %1, %2, %3":"=v"(r):"v"(a),"v"(b),"v"(c));return r;}
__device__ __forceinline__ float max2f(float a,float b){float r;asm("v_max_f32_e32 %0, %1, %2":"=v"(r):"v"(a),"v"(b));return r;}
__device__ __forceinline__ float fadd_s(float a,float b){float r;asm("v_add_f32_e32 %0, %1, %2":"=v"(r):"v"(a),"v"(b));return r;}
__device__ __forceinline__ float fsub_s(float a,float b){float r;asm("v_sub_f32_e32 %0, %1, %2":"=v"(r):"v"(a),"v"(b));return r;}
typedef float f32x2_t __attribute__((ext_vector_type(2))); typedef __bf16 bf16x2_t __attribute__((ext_vector_type(2)));
__device__ __forceinline__ unsigned cvtpk_s(float lo,float hi){f32x2_t v={lo,hi};bf16x2_t b=__builtin_convertvector(v,bf16x2_t);return __builtin_bit_cast(unsigned,b);}
#define WAIT_BAR(N) asm volatile("s_waitcnt vmcnt(" #N ") lgkmcnt(0)\n\ts_barrier":::"memory")

__device__ __forceinline__ void qkt(f32x16&p0,f32x16&p1,const char*Kslot,const bf16x8*qr,int r32,int hi,bf16x8 ka0,bf16x8 ka1,bf16x8 qa){ const f32x16 negm=f32x16{};
  const char*kb=Kslot+hi*1024+r32*16;
  #pragma unroll
  for(int d0=0;d0<4;++d0){
    const bf16x8 b0=*reinterpret_cast<const bf16x8*>(kb+d0*2048);
    const bf16x8 b1=*reinterpret_cast<const bf16x8*>(kb+d0*2048+512);
    if(d0==0){p0=__builtin_amdgcn_mfma_f32_32x32x16_bf16(ka0,qa,negm,0,0,0);p1=__builtin_amdgcn_mfma_f32_32x32x16_bf16(ka1,qa,negm,0,0,0);}
    p0=__builtin_amdgcn_mfma_f32_32x32x16_bf16(b0,qr[d0],p0,0,0,0);p1=__builtin_amdgcn_mfma_f32_32x32x16_bf16(b1,qr[d0],p1,0,0,0);}
}
typedef __attribute__((address_space(3))) const char* lds_cptr;
typedef short v4i16_t __attribute__((ext_vector_type(4)));
__device__ __forceinline__ void kload8(bf16x8*kf,lds_cptr kp){
  kf[0]=*(const __attribute__((address_space(3))) bf16x8*)(kp);      kf[1]=*(const __attribute__((address_space(3))) bf16x8*)(kp+512);
  kf[2]=*(const __attribute__((address_space(3))) bf16x8*)(kp+2048); kf[3]=*(const __attribute__((address_space(3))) bf16x8*)(kp+2560);
  kf[4]=*(const __attribute__((address_space(3))) bf16x8*)(kp+4096); kf[5]=*(const __attribute__((address_space(3))) bf16x8*)(kp+4608);
  kf[6]=*(const __attribute__((address_space(3))) bf16x8*)(kp+6144); kf[7]=*(const __attribute__((address_space(3))) bf16x8*)(kp+6656);
}
__device__ __forceinline__ void kload2(bf16x8*kf,lds_cptr kp,int j){ kf[2*j]=*(const __attribute__((address_space(3))) bf16x8*)(kp+j*2048); kf[2*j+1]=*(const __attribute__((address_space(3))) bf16x8*)(kp+j*2048+512); }
__device__ __forceinline__ s16x4 vtr(lds_cptr p){ return __builtin_bit_cast(s16x4,__builtin_amdgcn_ds_read_tr16_b64_v4i16((__attribute__((address_space(3))) v4i16_t*)p)); }
__device__ __forceinline__ float rowmax(const f32x16&p0,const f32x16&p1){
  float a=max3f(p0[0],p0[1],p1[0]),b=max3f(p0[2],p0[3],p1[1]);a=max3f(a,p1[2],p1[3]);
  #pragma unroll
  for(int r=4;r<16;r+=4){a=max3f(a,p0[r],p0[r+1]);b=max3f(b,p0[r+2],p0[r+3]);a=max3f(a,p1[r],p1[r+1]);b=max3f(b,p1[r+2],p1[r+3]);}
  const float m=max2f(a,b);
  auto rr=__builtin_amdgcn_permlane32_swap(__float_as_uint(m),__float_as_uint(m),false,false);
  return max2f(__uint_as_float(rr[0]),__uint_as_float(rr[1]));
}
__device__ __forceinline__ void pv(f32x16*o,int vb,bf16x8 pa0,bf16x8 pa1,bf16x8 pa2,bf16x8 pa3){
  #pragma unroll
  for(int d0=0;d0<2;++d0){s16x4 lo[4],hi[4];
    #pragma unroll
    for(int ks=0;ks<4;++ks){
      asm volatile("ds_read_b64_tr_b16 %0,%1 offset:%c2":"=&v"(lo[ks]):"v"(vb),"i"(d0*4096+ks*1024):"memory");
      asm volatile("ds_read_b64_tr_b16 %0,%1 offset:%c2":"=&v"(hi[ks]):"v"(vb),"i"(d0*4096+ks*1024+512):"memory");}
    asm volatile("s_waitcnt lgkmcnt(0)":::"memory");SBAR();
    #define PK(k) (bf16x8){lo[k][0],lo[k][1],lo[k][2],lo[k][3],hi[k][0],hi[k][1],hi[k][2],hi[k][3]}
    o[d0]=__builtin_amdgcn_mfma_f32_32x32x16_bf16(pa0,PK(0),o[d0],0,0,0);
    o[d0]=__builtin_amdgcn_mfma_f32_32x32x16_bf16(pa1,PK(1),o[d0],0,0,0);
    o[d0]=__builtin_amdgcn_mfma_f32_32x32x16_bf16(pa2,PK(2),o[d0],0,0,0);
    o[d0]=__builtin_amdgcn_mfma_f32_32x32x16_bf16(pa3,PK(3),o[d0],0,0,0);
    #undef PK
  }
}

#ifndef ATTN_STORE16
#define ATTN_STORE16(p,v) (*(u32x4*)(p)=(v))
#endif
__device__ __forceinline__ unsigned bfr(float x){ const unsigned u=__float_as_uint(x); return (u+0x7fffu+((u>>16)&1u))>>16; }
template<int THRL> __device__ __forceinline__ void attn_unit(int b,int h,int qb,const bf16*Q,const bf16*__restrict__ K,const bf16*__restrict__ V,bf16*O,const float*kmean,char*shm){
  int tid_=threadIdx.x; asm volatile("":"+v"(tid_)); const int tid=tid_,lane=tid&63,r32=lane&31,hi=lane>>5; const int wid=__builtin_amdgcn_readfirstlane(tid>>6);
  const long rowbase=(long)b*SEQ; const int q0=qb*QB;
  const bf16*Qw=Q+(rowbase+q0+wid*QBLK)*DM+h*D;
  const bf16*Kh=K+rowbase*DM+h*D,*Vh=V+rowbase*DM+h*D;
  const unsigned lds0=(unsigned)(uintptr_t)shm;
  float*wsf=(float*)(shm+LDS_WS)+wid*64;
  const bf16*ksrc=Kh+(long)lane*DM+wid*8;
  const bf16*vsrc=Vh+(long)(16*(wid&3)+(lane>>2))*DM+(wid>>2)*32+(lane&3)*8;
  const unsigned kdst=lds0+LDS_K+wid*1024, vdst=lds0+LDS_V+wid*1024;
  #define DMA_K(t,slot) glds16(ksrc+(long)(t)*KVBLK*DM,(unsigned)__builtin_amdgcn_readfirstlane(kdst+(slot)))
  #define DMA_V(t,slot) glds16(vsrc+(long)(t)*KVBLK*DM,(unsigned)__builtin_amdgcn_readfirstlane(vdst+(slot)))
  const int vb0=(int)(lds0+LDS_V)+((lane>>4)&1)*32+(lane&3)*8+(4*hi+((lane&15)>>2))*64;
  const char*Kbase=shm+LDS_K; bf16x8 kf[8];
  const lds_cptr shm3=(lds_cptr)shm; const lds_cptr kp0=shm3+LDS_K+hi*1024+r32*16; const lds_cptr vp0=shm3+LDS_V+((lane>>4)&1)*32+(lane&3)*8+(4*hi+((lane&15)>>2))*64;
  const int NT=(q0+QB)/KVBLK;
  DMA_K(0,0);DMA_V(0,0);DMA_K(1,SLOTB);
  bf16x8 qr[4];
  #pragma unroll
  for(int d0=0;d0<4;++d0)qr[d0]=*reinterpret_cast<const bf16x8*>(&Qw[(long)r32*DM+d0*16+hi*8]);
  unsigned selmask=0xffu;
  if(qb>=4){
    float*kst=(float*)(shm+LDS_OST)+wid*1024;
    { float kv[7];
      #pragma unroll
      for(int n=0;n<7;++n){ const float*km=kmean+((size_t)(b*8+n)*DM+h*D)+lane; kv[n]=(n<qb)?(km[0]+km[(size_t)64*DM]):0.f; }
      #pragma unroll
      for(int n=0;n<7;++n)kst[n*64+lane]=kv[n]; }
    float g[7];
    #pragma unroll
    for(int n=0;n<7;++n){ g[n]=0.f;
      if(n<qb){ const float*km=kst+n*64+8*hi; float s=0.f;
        #pragma unroll
        for(int d0=0;d0<4;++d0){ const float4 k0=*(const float4*)(km+16*d0),k1=*(const float4*)(km+16*d0+4); const float kk[8]={k0.x,k0.y,k0.z,k0.w,k1.x,k1.y,k1.z,k1.w};
          #pragma unroll
          for(int j=0;j<8;++j)s+=__uint_as_float(((unsigned)(unsigned short)qr[d0][j])<<16)*kk[j]; }
        auto rr=__builtin_amdgcn_permlane32_swap(__float_as_uint(s),__float_as_uint(s),false,false); g[n]=__uint_as_float(rr[0])+__uint_as_float(rr[1]); } }
    selmask=0u;
    #pragma unroll
    for(int n=0;n<7;++n){ int rank=0;
      #pragma unroll
      for(int m2=0;m2<7;++m2){ if(m2<qb&&(g[m2]>g[n]||(g[m2]==g[n]&&m2<n)))++rank; }
      if(n<qb&&rank<3)selmask|=(1u<<n); }
  }
  const unsigned lanemask=(unsigned)hi-1u;
  unsigned qaw0,qaw1,kw1a,kw1b;
  { const float slope2=__builtin_amdgcn_exp2f(-(float)(h+1))*1.4426950408889634f; const unsigned shi_b=bfr(slope2); const float shi_f=__uint_as_float(shi_b<<16); const unsigned slo_b=bfr(slope2-shi_f);
    qaw0=(bfr(64.f*shi_f)|(bfr(64.f*__uint_as_float(slo_b<<16))<<16))&lanemask; qaw1=(shi_b|(slo_b<<16))&lanemask;
    const unsigned ba=bfr((float)r32),bb=bfr((float)(r32+32)); kw1a=(ba|(ba<<16))&lanemask; kw1b=(bb|(bb<<16))&lanemask; }
  unsigned qaw2m=0u,qaw3=0u;
  #define MSPLIT() do{ const float x_=-mhat; const unsigned b1_=bfr(x_); const float r1_=x_-__uint_as_float(b1_<<16); const unsigned b2_=bfr(r1_); const float r2_=r1_-__uint_as_float(b2_<<16); \
      qaw2m=(b1_<<16)&lanemask; qaw3=(b2_|(bfr(r2_)<<16))&lanemask; }while(0)
  #define AUG(t_,KA0,KA1,QA) const int t__=(t_); const float af_=(float)(t__-4*qb); const unsigned aw_=bfr(af_); const unsigned w0_=(aw_|(aw_<<16))&lanemask; \
      const bool sel_=(t__>=NT-4)||((selmask>>(t__>>2))&1u); const unsigned w2_=((sel_?0u:0x0000f14au)&lanemask)|qaw2m; const unsigned on_=0x3f803f80u&lanemask; \
      const bf16x8 KA0=__builtin_bit_cast(bf16x8,(u32x4){w0_,kw1a,on_,on_}); const bf16x8 KA1=__builtin_bit_cast(bf16x8,(u32x4){w0_,kw1b,on_,on_}); const bf16x8 QA=__builtin_bit_cast(bf16x8,(u32x4){qaw0,qaw1,w2_,qaw3});
  const f32x16 negm=f32x16{};
  float mhat=0.f,l_reg=0.f;f32x16 o[2];o[0]=f32x16{};o[1]=f32x16{};
  const int qrel=wid*QBLK+r32;
  #define CMASK(P0,P1,t) do{int jb_=(t)-(NT-4); if(jb_>=0)cmask(P0,P1,jb_,qrel,hi);}while(0)
  bool resc=false;
  #define START(P0,P1) do{ const float rm=rowmax(P0,P1); resc=false; \
    { const float dl=(rm<-1e29f)?0.f:rm; mhat=fadd_s(mhat,dl); \
      _Pragma("unroll") for(int r=0;r<16;++r){P0[r]=fsub_s(P0[r],dl);P1[r]=fsub_s(P1[r],dl);} \
      MSPLIT(); } \
    _Pragma("unroll") for(int r=0;r<16;++r)P0[r]=__builtin_amdgcn_exp2f(P0[r]); }while(0)
  #define RESC() do{ if(resc){ asm volatile("s_waitcnt lgkmcnt(0)":::"memory"); \
      _Pragma("unroll") for(int d_=0;d_<2;++d_) _Pragma("unroll") for(int r=0;r<16;++r)o[d_][r]*=wsf[crow(r,hi)]; } }while(0)
  f32x16 pA0,pA1,pB0,pB1;
  int sl_prev=0,sl_cur=0,sl_next=SLOTB;
  #define ROT() do{sl_prev=sl_cur;sl_cur=sl_next;sl_next=(sl_next==(NSLOT-1)*SLOTB)?0:sl_next+SLOTB;}while(0)
  DMA_K(2,2*SLOTB);
  WAIT_BAR(3);
  { AUG(0,ka0_,ka1_,qa_) qkt(pA0,pA1,Kbase,qr,r32,hi,ka0_,ka1_,qa_); } asm volatile("s_nop 15\n\ts_nop 7":"+v"(pA0),"+v"(pA1));CMASK(pA0,pA1,0);
  START(pA0,pA1);
  _Pragma("unroll") for(int r=0;r<16;++r)pA1[r]=__builtin_amdgcn_exp2f(pA1[r]);
  WAIT_BAR(0);
  DMA_K(3,0);DMA_V(1,SLOTB);
  ROT();
  kload8(kf,kp0+sl_cur);
  WAIT_BAR(2);
  s16x4 vlo[8],vhi[8]; u32x4 pw0,pw1,pw2,pw3;
  #define PKW(P,B) cvtpk_s(P[B],P[B+1])
  #define PAF(k) __builtin_bit_cast(bf16x8,pw##k)
  #define VFR(i) (bf16x8){vlo[i][0],vlo[i][1],vlo[i][2],vlo[i][3],vhi[i][0],vhi[i][1],vhi[i][2],vhi[i][3]}
  #define PIN(x) asm volatile("":"+v"(x))
  #define MX3(a,b,c) __builtin_fmaxf(__builtin_fmaxf((a),(b)),(c))
  #define GAPA(MF,A0,A1,A2,A3,W0,W1,PW) do{ MF; sacc+=A0; sacc+=A1; sacc+=A2; sacc+=A3; PIN(sacc); W0; W1; PIN(PW); SBAR(); }while(0)
  #define EX(v) __builtin_amdgcn_exp2f(v)
  #define GAPB(MF,X,B) do{ MF; X[B]=EX(X[B]); X[B+1]=EX(X[B+1]); X[B+2]=EX(X[B+2]); X[B+3]=EX(X[B+3]); PIN(X); SBAR(); }while(0)
  #define VRD(i) do{ vlo[i]=vtr(vp_+(((i)>>2)*4096+((i)&3)*1024)); vhi[i]=vtr(vp_+(((i)>>2)*4096+((i)&3)*1024+512)); }while(0)
  #define KRD(G,j) do{ if(G){ kload2(kf,kp0+sl_next,j); SBAR(); } }while(0)
  #define STEP(C0,C1,P0,P1,t,GK,GV,GL) do{ SBAR(); \
    const lds_cptr vp_=vp0+sl_prev; \
    VRD(0); SBAR(); float sacc=(P0[0]+P0[1]); \
    GAPA(C0=__builtin_amdgcn_mfma_f32_32x32x16_bf16(kf[0],qr[0],negm,0,0,0), P0[2],P0[3],P0[4],P0[5],     pw0[0]=PKW(P0,0), pw0[1]=PKW(P0,2), pw0); \
    VRD(4); SBAR(); GAPA(C1=__builtin_amdgcn_mfma_f32_32x32x16_bf16(kf[1],qr[0],negm,0,0,0), P0[6],P0[7],P0[8],P0[9],     pw0[2]=PKW(P0,4), pw0[3]=PKW(P0,6), pw0); \
    VRD(1); SBAR(); GAPA(C0=__builtin_amdgcn_mfma_f32_32x32x16_bf16(kf[2],qr[1],C0,0,0,0),   P0[10],P0[11],P0[12],P0[13], pw1[0]=PKW(P0,8), pw1[1]=PKW(P0,10), pw1); \
    VRD(5); SBAR(); GAPA(C1=__builtin_amdgcn_mfma_f32_32x32x16_bf16(kf[3],qr[1],C1,0,0,0),   P0[14],P0[15],P1[0],P1[1],   pw1[2]=PKW(P0,12),pw1[3]=PKW(P0,14), pw1); \
    VRD(2); SBAR(); GAPA(C0=__builtin_amdgcn_mfma_f32_32x32x16_bf16(kf[4],qr[2],C0,0,0,0),   P1[2],P1[3],P1[4],P1[5],     pw2[0]=PKW(P1,0), pw2[1]=PKW(P1,2), pw2); \
    VRD(6); SBAR(); GAPA(C1=__builtin_amdgcn_mfma_f32_32x32x16_bf16(kf[5],qr[2],C1,0,0,0),   P1[6],P1[7],P1[8],P1[9],     pw2[2]=PKW(P1,4), pw2[3]=PKW(P1,6), pw2); \
    VRD(3); SBAR(); GAPA(C0=__builtin_amdgcn_mfma_f32_32x32x16_bf16(kf[6],qr[3],C0,0,0,0),   P1[10],P1[11],P1[12],P1[13], pw3[0]=PKW(P1,8), pw3[1]=PKW(P1,10), pw3); \
    VRD(7); SBAR(); GAPA(C1=__builtin_amdgcn_mfma_f32_32x32x16_bf16(kf[7],qr[3],C1,0,0,0),   P1[14],P1[15],0.f,0.f,       pw3[2]=PKW(P1,12),pw3[3]=PKW(P1,14), pw3); \
    { AUG(t,ka0_,ka1_,qa_) C0=__builtin_amdgcn_mfma_f32_32x32x16_bf16(ka0_,qa_,C0,0,0,0); SBAR(); C1=__builtin_amdgcn_mfma_f32_32x32x16_bf16(ka1_,qa_,C1,0,0,0); } SBAR(); \
    l_reg+=sacc; \
    if(GK){DMA_K((t)+3,sl_cur);} if(GV){DMA_V((t)+1,sl_next);} \
    CMASK(C0,C1,t); \
    { float a=MX3(C0[0],C0[1],C1[0]),b=MX3(C0[2],C0[3],C1[1]); a=MX3(a,C1[2],C1[3]); \
      _Pragma("unroll") for(int r=4;r<16;r+=4){a=MX3(a,C0[r],C0[r+1]);b=MX3(b,C0[r+2],C0[r+3]);a=MX3(a,C1[r],C1[r+1]);b=MX3(b,C1[r+2],C1[r+3]);} \
      float rm=__builtin_fmaxf(a,b); { auto rr=__builtin_amdgcn_permlane32_swap(__float_as_uint(rm),__float_as_uint(rm),false,false); rm=__builtin_fmaxf(__uint_as_float(rr[0]),__uint_as_float(rr[1])); } \
      resc=false; \
      if(__builtin_expect(__any(rm>(float)THRL),0)){ const float dl=__builtin_fmaxf(rm,0.f); mhat+=dl; \
        _Pragma("unroll") for(int r=0;r<16;++r){C0[r]-=dl;C1[r]-=dl;} \
        MSPLIT(); \
        const float f=__builtin_amdgcn_exp2f(-dl); l_reg*=f; if(hi==0)wsf[r32]=f; resc=true; } } \
    SBAR(); \
    GAPB(o[0]=__builtin_amdgcn_mfma_f32_32x32x16_bf16(PAF(0),VFR(0),o[0],0,0,0), C0,0); \
    GAPB(o[1]=__builtin_amdgcn_mfma_f32_32x32x16_bf16(PAF(0),VFR(4),o[1],0,0,0), C0,4); \
    KRD(GL,0); GAPB(o[0]=__builtin_amdgcn_mfma_f32_32x32x16_bf16(PAF(1),VFR(1),o[0],0,0,0), C0,8); \
    KRD(GL,1); GAPB(o[1]=__builtin_amdgcn_mfma_f32_32x32x16_bf16(PAF(1),VFR(5),o[1],0,0,0), C0,12); \
    KRD(GL,2); GAPB(o[0]=__builtin_amdgcn_mfma_f32_32x32x16_bf16(PAF(2),VFR(2),o[0],0,0,0), C1,0); \
    KRD(GL,3); GAPB(o[1]=__builtin_amdgcn_mfma_f32_32x32x16_bf16(PAF(2),VFR(6),o[1],0,0,0), C1,4); \
    GAPB(o[0]=__builtin_amdgcn_mfma_f32_32x32x16_bf16(PAF(3),VFR(3),o[0],0,0,0), C1,8); \
    GAPB(o[1]=__builtin_amdgcn_mfma_f32_32x32x16_bf16(PAF(3),VFR(7),o[1],0,0,0), C1,12); \
    }while(0)
  int t=1;
  #undef CMASK
  #define CMASK(P0,P1,t) do{}while(0)
  for(;t+5<NT;t+=2){
    STEP(pB0,pB1,pA0,pA1,t,true,true,true);     WAIT_BAR(2); RESC(); ROT();
    STEP(pA0,pA1,pB0,pB1,t+1,true,true,true);   WAIT_BAR(2); RESC(); ROT();
  }
  #undef CMASK
  #define CMASK(P0,P1,t) do{int jb_=(t)-(NT-4); if(jb_>=0)cmask(P0,P1,jb_,qrel,hi);}while(0)
  #define ENDW(tt) do{ if((tt)+3<NT){WAIT_BAR(2);} else if((tt)+2<NT){WAIT_BAR(1);} else {WAIT_BAR(0);} }while(0)
  for(;t+1<NT;t+=2){
    STEP(pB0,pB1,pA0,pA1,t,(t+3<NT),(t+1<NT),(t+1<NT));       ENDW(t);   RESC(); ROT();
    STEP(pA0,pA1,pB0,pB1,t+1,(t+4<NT),(t+2<NT),(t+2<NT));     ENDW(t+1); RESC(); ROT();
  }
  STEP(pB0,pB1,pA0,pA1,NT-1,false,false,false); RESC();
  { float sacc=pB0[0]+pB0[1]; _Pragma("unroll") for(int r=2;r<16;++r)sacc+=pB0[r]; _Pragma("unroll") for(int r=0;r<16;++r)sacc+=pB1[r]; l_reg+=sacc;
    pw0=(u32x4){PKW(pB0,0),PKW(pB0,2),PKW(pB0,4),PKW(pB0,6)};pw1=(u32x4){PKW(pB0,8),PKW(pB0,10),PKW(pB0,12),PKW(pB0,14)};pw2=(u32x4){PKW(pB1,0),PKW(pB1,2),PKW(pB1,4),PKW(pB1,6)};pw3=(u32x4){PKW(pB1,8),PKW(pB1,10),PKW(pB1,12),PKW(pB1,14)};
    SBAR(); pv(o,vb0+sl_cur,PAF(0),PAF(1),PAF(2),PAF(3)); }
  #undef PKW
  #undef PAF
  #undef VFR
  #undef PIN
  #undef MX3
  #undef GAPA
  #undef GAPB
  #undef EX
  #undef VRD
  #undef KRD
  #undef STEP
  #undef ENDW
  {auto rr=__builtin_amdgcn_permlane32_swap(__float_as_uint(l_reg),__float_as_uint(l_reg),false,false);l_reg=__uint_as_float(rr[0])+__uint_as_float(rr[1]);}
  if(hi==0)wsf[32+r32]=l_reg;asm volatile("s_waitcnt lgkmcnt(0)":::"memory");
  float rli[16];
  #pragma unroll
  for(int r=0;r<16;++r)rli[r]=__builtin_amdgcn_rcpf(wsf[32+crow(r,hi)]);
  bf16*Ow=O+(rowbase+q0+wid*QBLK)*DM+h*D;
  { bf16*stg=(bf16*)(shm+LDS_OST)+wid*2048;
    #pragma unroll
    for(int r=0;r<16;++r){const int orow=crow(r,hi);
      #pragma unroll
      for(int d0=0;d0<2;++d0)stg[orow*64+d0*32+r32]=__float2bfloat16(o[d0][r]*rli[r]);}
    asm volatile("s_waitcnt lgkmcnt(0)":::"memory");
    #pragma unroll
    for(int i=0;i<4;++i){const int row=i*8+(lane>>3),ch=lane&7; const u32x4 v=*(const u32x4*)(stg+row*64+ch*8); ATTN_STORE16(Ow+(long)row*DM+ch*8,v);} }
  asm volatile("s_waitcnt lgkmcnt(0)\n\ts_barrier":::"memory");
  #undef DMA_K
  #undef DMA_V
  #undef CMASK
  #undef START
  #undef RESC
  #undef ROT
  #undef AUG
  #undef MSPLIT
}
constexpr int ATTN_LDS_BYTES=LDS_BYTES;
struct AttnTensors { const bf16* Q; const bf16* K; const bf16* V; bf16* O; const float* kmean; long gstride; };
struct AttnUnit { int bh; int qb; };
struct StaticOrder {
  int vcu,G;
  __device__ __forceinline__ explicit StaticOrder(int grid,int block):vcu((grid%8==0)?(block%8)*(grid/8)+block/8:block),G(grid){}
  __device__ __forceinline__ bool next(int i,AttnUnit&u)const{ const int p=vcu+(i>>1)*G; if(p>=BATCH*NHEAD*4)return false; const int s=p&3; u.bh=p>>2; u.qb=(i&1)?s:7-s; return true; }
  __device__ __forceinline__ void a_ready(const AttnUnit&)const{}
  __device__ __forceinline__ void done(const AttnUnit&)const{}
};
template<class Sched,int THRL=8> __device__ __forceinline__ void attn_phase(char*lds,const AttnTensors&T,const Sched&S){
  AttnUnit u;
  for(int i=0;S.next(i,u);++i){ S.a_ready(u); { const long adj=(long)(u.bh/NHEAD)*(T.gstride-(long)SEQ*DM); attn_unit<THRL>(u.bh/NHEAD,u.bh%NHEAD,u.qb,T.Q+adj,T.K+adj,T.V+adj,T.O,T.kmean,lds); } S.done(u); }
}
#undef SBAR
#undef WAIT_BAR
}


namespace ssm {
typedef short bf16x8 __attribute__((ext_vector_type(8)));
typedef float f32x16 __attribute__((ext_vector_type(16)));
typedef float f32x4 __attribute__((ext_vector_type(4)));
typedef float f32x2 __attribute__((ext_vector_type(2)));
constexpr int CHUNK = 256, NCHUNK = SEQ / CHUNK, SUB = 32;
constexpr int LDS_E_OFF = 131072 + 1024;
struct Tables { const float* AP; const bf16x8* BX; const bf16x8* CM; };
__device__ __forceinline__ int crow(int r, int hi) { return (r & 3) + 8 * (r >> 2) + 4 * hi; }
__device__ __forceinline__ float gelu_tanh_fast(float x) {
    constexpr float c1 = -1.4426950408889634f * 1.5957691216057308f, c2 = c1 * 0.044715f;
    const float w = __builtin_fmaf(x * x, c2, c1);
    return x * __builtin_amdgcn_rcpf(1.0f + __builtin_amdgcn_exp2f(x * w)); }

__device__ __forceinline__ void ssm_params_ab(const float* __restrict__ lam_re, const float* __restrict__ lam_im, const float* __restrict__ log_dt, const float* __restrict__ b_re, const float* __restrict__ b_im,
                                              float* __restrict__ AP, unsigned short* __restrict__ BX, int bid, int nblk) {
    const int gt = bid * blockDim.x + threadIdx.x, nt = nblk * blockDim.x;
    for (int i = gt; i < NG * SSM_P; i += nt) {
        const int g = i / SSM_P, p = i % SSM_P;
        const float lr = lam_re[i], li = lam_im[i], ldt = log_dt[g];
        float4 brv[4], biv[4];
#pragma unroll
        for (int q = 0; q < 4; ++q) { brv[q] = ((const float4*)(b_re + (size_t)i * SSM_GROUP))[q]; biv[q] = ((const float4*)(b_im + (size_t)i * SSM_GROUP))[q]; }
        const float dt = expf(ldt);
        const float mag = expf(lr * dt), ang = li * dt, are = mag * cosf(ang), aim = mag * sinf(ang), den = lr * lr + li * li;
        const float sh = sinf(0.5f * ang), am1 = expm1f(lr * dt) * cosf(ang) - 2.0f * sh * sh;
        const float fre = (am1 * lr + aim * li) / den, fim = (aim * lr - am1 * li) / den;
        float pr = are, pi = aim;
#pragma unroll
        for (int k = 0; k < 8; ++k) { const float nr = pr * pr - pi * pi, ni = 2.0f * pr * pi; pr = nr; pi = ni; }
        *(float4*)(AP + (size_t)i * 4) = make_float4(are, aim, pr, pi);
        const int pb = p >> 5, r32 = p & 31;
#pragma unroll
        for (int hh = 0; hh < 2; ++hh) {
            const float4 r0 = brv[2 * hh], r1 = brv[2 * hh + 1], i0 = biv[2 * hh], i1 = biv[2 * hh + 1];
            const float br[8] = {r0.x, r0.y, r0.z, r0.w, r1.x, r1.y, r1.z, r1.w}, bi[8] = {i0.x, i0.y, i0.z, i0.w, i1.x, i1.y, i1.z, i1.w};
            uint4 wr_, wi_;
            wr_.x = pk2(fre * br[0] - fim * bi[0], fre * br[1] - fim * bi[1]); wr_.y = pk2(fre * br[2] - fim * bi[2], fre * br[3] - fim * bi[3]);
            wr_.z = pk2(fre * br[4] - fim * bi[4], fre * br[5] - fim * bi[5]); wr_.w = pk2(fre * br[6] - fim * bi[6], fre * br[7] - fim * bi[7]);
            wi_.x = pk2(fre * bi[0] + fim * br[0], fre * bi[1] + fim * br[1]); wi_.y = pk2(fre * bi[2] + fim * br[2], fre * bi[3] + fim * br[3]);
            wi_.z = pk2(fre * bi[4] + fim * br[4], fre * bi[5] + fim * br[5]); wi_.w = pk2(fre * bi[6] + fim * br[6], fre * bi[7] + fim * br[7]);
            const int lane = hh * 32 + r32;
            *(uint4*)(BX + ((size_t)(g * 4 + pb * 2 + 0) * 64 + lane) * 8) = wr_;
            *(uint4*)(BX + ((size_t)(g * 4 + pb * 2 + 1) * 64 + lane) * 8) = wi_;
        }
    }
}
__device__ __forceinline__ float ssm_cm_value(const float* __restrict__ c_re, const float* __restrict__ c_im, const float* __restrict__ d_skip, int i) {
    const int j = i & 7, lane = (i >> 3) & 63, ks = (i >> 9) % 5, g = i / (5 * 512); const int ho = lane & 15, k = 32 * ks + 8 * (lane >> 4) + j;
    float v = 0.f;
    if (k < 128) v = (k & 1) ? -c_im[(g * SSM_GROUP + ho) * SSM_P + (k >> 1)] : c_re[(g * SSM_GROUP + ho) * SSM_P + (k >> 1)];
    else if (k - 128 == ho) v = d_skip[g * SSM_GROUP + ho];
    return v;
}
__device__ __forceinline__ void ssm_params_cm(const float* __restrict__ c_re, const float* __restrict__ c_im, const float* __restrict__ d_skip, unsigned short* __restrict__ CM, int bid, int nblk) {
    const int gt = bid * blockDim.x + threadIdx.x, nt = nblk * blockDim.x;
    for (int i = gt; i < NG * 5 * 64 * 8; i += nt) CM[i] = (unsigned short)f2bf(ssm_cm_value(c_re, c_im, d_skip, i));
}

template <bool PASS2>
__device__ __forceinline__ void ssm_scan(int g, float& hre, float& him, float a_re, float a_im, const unsigned short* ua, const unsigned short* ub, const bf16x8 (&bx)[4], const bf16x8 (&cm)[5],
                                         unsigned short* yo, LAS unsigned char* wl, int lane) {
    const int r32 = lane & 31, hi = lane >> 5;
    unsigned hoff[8];
#pragma unroll
    for (int k = 0; k < 8; ++k) hoff[k] = ((((unsigned)lane >> 2) ^ (unsigned)k) << 4) + ((unsigned)lane & 3u) * 4u;
    unsigned aoff[4];
#pragma unroll
    for (int ks = 0; ks < 4; ++ks) aoff[ks] = ((unsigned)lane & 15u) * 512u + (((unsigned)(4 * ks + (lane >> 4)) ^ ((unsigned)lane & 7u)) << 4);
    for (int st = 0; st < CHUNK / SUB; ++st) {
        const bf16x8 uA = *(const bf16x8*)(ua + (size_t)st * SUB * 512);
        const f32x16 z = {};
        f32x16 xar = __builtin_amdgcn_mfma_f32_32x32x16_bf16(uA, bx[0], z, 0, 0, 0), xai = __builtin_amdgcn_mfma_f32_32x32x16_bf16(uA, bx[1], z, 0, 0, 0);
        f32x16 xbr = __builtin_amdgcn_mfma_f32_32x32x16_bf16(uA, bx[2], z, 0, 0, 0), xbi = __builtin_amdgcn_mfma_f32_32x32x16_bf16(uA, bx[3], z, 0, 0, 0);
#pragma unroll
        for (int r = 0; r < 16; ++r) {
            const auto sr = __builtin_amdgcn_permlane32_swap(__float_as_uint(xar[r]), __float_as_uint(xbr[r]), false, false); xar[r] = __uint_as_float(sr[0]); xbr[r] = __uint_as_float(sr[1]);
            const auto si = __builtin_amdgcn_permlane32_swap(__float_as_uint(xai[r]), __float_as_uint(xbi[r]), false, false); xai[r] = __uint_as_float(si[0]); xbi[r] = __uint_as_float(si[1]);
        }
#pragma unroll
        for (int t = 0; t < SUB; ++t) {
            const int rr = 4 * (t >> 3) + (t & 3);
            const float x0 = (t & 4) ? xbr[rr] : xar[rr], x1 = (t & 4) ? xbi[rr] : xai[rr];
            const float nr = __builtin_fmaf(a_re, hre, __builtin_fmaf(-a_im, him, x0)), ni = __builtin_fmaf(a_re, him, __builtin_fmaf(a_im, hre, x1));
            hre = nr; him = ni;
            if (PASS2) *(LAS unsigned*)(wl + t * 512 + hoff[t & 7]) = pg8::cvt_pk_bf16(hre, him);
        }
        if (PASS2) {
#pragma unroll
            for (int mb = 0; mb < 2; ++mb) {
                f32x4 y = {0.f, 0.f, 0.f, 0.f};
#pragma unroll
                for (int ks = 0; ks < 4; ++ks) { const bf16x8 af = *(const LAS bf16x8*)(wl + mb * 16 * 512 + aoff[ks]); y = __builtin_amdgcn_mfma_f32_16x16x32_bf16(af, cm[ks], y, 0, 0, 0); }
                bf16x8 uf = *(const bf16x8*)(ub + ((size_t)st * SUB + mb * 16) * 512);
                y = __builtin_amdgcn_mfma_f32_16x16x32_bf16(uf, cm[4], y, 0, 0, 0);
                unsigned short* yp = yo + ((size_t)st * SUB + mb * 16) * 512;
#pragma unroll
                for (int r = 0; r < 4; ++r) { const float gy = gelu_tanh_fast(y[r]); yp[(size_t)r * 512] = (unsigned short)pg8::cvt_pk_bf16(gy, gy); }
            }
        }
    }
}
#define SSM_CMUL(or_, oi_, ar_, ai_, br_, bi_) do { const float tr_ = (ar_) * (br_) - (ai_) * (bi_), ti_ = (ar_) * (bi_) + (ai_) * (br_); or_ = tr_; oi_ = ti_; } while (0)
#define SSM_CFMA(hr_, hi_, ar_, ai_, xr_, xi_) do { const float tr_ = __builtin_fmaf((ar_), (hr_), __builtin_fmaf(-(ai_), (hi_), (xr_))), ti_ = __builtin_fmaf((ar_), (hi_), __builtin_fmaf((ai_), (hr_), (xi_))); hr_ = tr_; hi_ = ti_; } while (0)
template <int S2>
__device__ __forceinline__ void ssm_p1_tile(const bf16x8 uA, const bf16x8 bxr, const bf16x8 bxi, float ar, float ai, float a8r, float a8i, float a32r, float a32i, float& Hr, float& Hi) {
    const f32x16 z = {};
    const f32x16 xr = __builtin_amdgcn_mfma_f32_32x32x16_bf16(uA, bxr, z, 0, 0, 0), xi = __builtin_amdgcn_mfma_f32_32x32x16_bf16(uA, bxi, z, 0, 0, 0);
    float Pr = 0.f, Pi = 0.f;
#define SSM_GROUP4(J) { float Lr = xr[4 * (J)], Li = xi[4 * (J)]; SSM_CFMA(Lr, Li, ar, ai, xr[4 * (J) + 1], xi[4 * (J) + 1]); SSM_CFMA(Lr, Li, ar, ai, xr[4 * (J) + 2], xi[4 * (J) + 2]); SSM_CFMA(Lr, Li, ar, ai, xr[4 * (J) + 3], xi[4 * (J) + 3]); \
                      SSM_CFMA(Pr, Pi, a8r, a8i, Lr, Li); }
    SSM_GROUP4(0) SSM_GROUP4(1) SSM_GROUP4(2) SSM_GROUP4(3)
#undef SSM_GROUP4
    SSM_CFMA(Hr, Hi, a32r, a32i, Pr, Pi);
}
__device__ __forceinline__ void ssm_pass1_fast(int g, const Tables T, const unsigned short* ua, const bf16x8 (&bx)[4], LAS f32x2* Ew, int lane) {
    const int r32 = lane & 31, hi = lane >> 5;
    const f32x4 ap0 = *(const f32x4*)(T.AP + (size_t)(g * SSM_P + r32) * 4), ap1 = *(const f32x4*)(T.AP + (size_t)(g * SSM_P + 32 + r32) * 4);
    const float a0r = ap0[0], a0i = ap0[1], a1r = ap1[0], a1i = ap1[1];
    float t2r, t2i, a0_4r, a0_4i, a0_8r, a0_8i, t16r, t16i, a0_32r, a0_32i, a1_4r, a1_4i, a1_8r, a1_8i, a1_32r, a1_32i;
    SSM_CMUL(t2r, t2i, a0r, a0i, a0r, a0i); SSM_CMUL(a0_4r, a0_4i, t2r, t2i, t2r, t2i); SSM_CMUL(a0_8r, a0_8i, a0_4r, a0_4i, a0_4r, a0_4i); SSM_CMUL(t16r, t16i, a0_8r, a0_8i, a0_8r, a0_8i); SSM_CMUL(a0_32r, a0_32i, t16r, t16i, t16r, t16i);
    SSM_CMUL(t2r, t2i, a1r, a1i, a1r, a1i); SSM_CMUL(a1_4r, a1_4i, t2r, t2i, t2r, t2i); SSM_CMUL(a1_8r, a1_8i, a1_4r, a1_4i, a1_4r, a1_4i); SSM_CMUL(t16r, t16i, a1_8r, a1_8i, a1_8r, a1_8i); SSM_CMUL(a1_32r, a1_32i, t16r, t16i, t16r, t16i);
    float H0r = 0.f, H0i = 0.f, H1r = 0.f, H1i = 0.f;
    for (int st = 0; st < CHUNK / SUB; ++st) {
        const bf16x8 uA = *(const bf16x8*)(ua + (size_t)st * SUB * 512);
        ssm_p1_tile<0>(uA, bx[0], bx[1], a0r, a0i, a0_8r, a0_8i, a0_32r, a0_32i, H0r, H0i);
        ssm_p1_tile<1>(uA, bx[2], bx[3], a1r, a1i, a1_8r, a1_8i, a1_32r, a1_32i, H1r, H1i);
    }
    float v0r = H0r, v0i = H0i, v1r = H1r, v1i = H1i;
    if (hi == 0) { SSM_CMUL(v0r, v0i, a0_4r, a0_4i, H0r, H0i); SSM_CMUL(v1r, v1i, a1_4r, a1_4i, H1r, H1i); }
    const float w0r = v0r + __shfl_xor(v0r, 32), w0i = v0i + __shfl_xor(v0i, 32), w1r = v1r + __shfl_xor(v1r, 32), w1i = v1i + __shfl_xor(v1i, 32);
    Ew[32 * hi + r32] = hi ? (f32x2){w1r, w1i} : (f32x2){w0r, w0i};
}
__device__ __forceinline__ void ssm_phase(const unsigned short* us, const Tables T, unsigned short* yg, LAS unsigned char* lds, int bid, int nblk) {
    int tid_ = threadIdx.x; asm volatile("" : "+v"(tid_));
    const int lane = tid_ & 63, wave = __builtin_amdgcn_readfirstlane(tid_ >> 6);
    LAS unsigned char* wl = lds + wave * 16384;
    LAS f32x2* E = (LAS f32x2*)(lds + LDS_E_OFF);
    for (int u = bid; u < BATCH * NG; u += nblk) {
        const int b = u & 7, g = u >> 3, r32 = lane & 31, hi = lane >> 5;
        const size_t row0 = (size_t)b * SEQ + (size_t)wave * CHUNK;
        const f32x4 ap = *(const f32x4*)(T.AP + (size_t)(g * SSM_P + lane) * 4);
        bf16x8 bx[4], cm[5];
#pragma unroll
        for (int f = 0; f < 4; ++f) bx[f] = T.BX[(size_t)(g * 4 + f) * 64 + lane];
#pragma unroll
        for (int ks = 0; ks < 5; ++ks) cm[ks] = T.CM[(size_t)(g * 5 + ks) * 64 + lane];
        const unsigned short* usb = us + (size_t)b * GROUP_STRIDE - (size_t)b * SEQ * 512;
        const unsigned short* ua = usb + (row0 + r32) * 512 + 16 * g + 8 * hi;
        const unsigned short* ub = usb + (row0 + (lane & 15)) * 512 + 16 * g + 8 * ((lane >> 4) & 1);
        unsigned short* yo = yg + (row0 + 4 * (lane >> 4)) * 512 + 16 * g + (lane & 15);
        ssm_pass1_fast(g, T, ua, bx, E + wave * 64, lane);
        __syncthreads();
        float hre = 0.f, him = 0.f;
        for (int j = 0; j < wave; ++j) { const f32x2 sj = E[j * 64 + lane]; const float nr = ap[2] * hre - ap[3] * him + sj[0], ni = ap[2] * him + ap[3] * hre + sj[1]; hre = nr; him = ni; }
        ssm_scan<true>(g, hre, him, ap[0], ap[1], ua, ub, bx, cm, yo, wl, lane);
        __syncthreads();
    }
}
}

constexpr size_t MiB = 1048576;
constexpr size_t WS_WUP1 = 0, WS_WDN1 = 11 * MiB, WS_WUP2 = 17 * MiB, WS_WDN2 = 28 * MiB, WS_WIN = 34 * MiB, WS_WGLU = 38 * MiB, WS_WOUT = 39 * MiB;
constexpr size_t WS_HB = 106 * MiB;
constexpr size_t WS_XN2 = 74 * MiB;
constexpr size_t WS_XNB = 42 * MiB, WS_F = 74 * MiB, WS_HACT = 138 * MiB;
constexpr size_t WS_Q = 138 * MiB, WS_ATT = 74 * MiB, WS_YG = 90 * MiB, WS_Z = 234 * MiB, WS_KMEAN = 250 * MiB;
constexpr size_t WS_SSM_AP = 251 * MiB, WS_SSM_BX = WS_SSM_AP + 65536, WS_SSM_CM = WS_SSM_BX + 131072, WS_SSM_SEND = 252 * MiB;
constexpr size_t QKVU_STRIDE = (size_t)SEQ * 512;
constexpr size_t WS_XCH = 253 * MiB;
constexpr size_t WS_CTL = 255 * MiB, CTL_BYTES = 131072;
constexpr int CW_TMO = 4000, CW_BANK0 = 4096, CW_BANK = 4096;
constexpr int LDS_BYTES = 147456, MISC_OFF = 131072 + 320;
typedef unsigned short bf16;

constexpr int SPLIT_PN = 1 << 20;
__device__ __forceinline__ int swiglu_row(int nn, int mode) { const int pn = nn >> 7, jj = nn & 127;
    return pn < SPLIT_PN ? 256 * pn + jj + (mode == 2 ? 128 : 0) : 256 * pn + 2 * jj - (jj & 3) + (mode == 2 ? 4 : 0); }
__device__ __forceinline__ void p0_load(const float* W, const float* G, const float* Ghi, int N, int item, float4 (&v)[8], int lane) {
    const int nblk = N / 32, kb = item / nblk, nb = item % nblk, k0 = 64 * kb, n0 = 32 * nb;
#pragma unroll
    for (int i = 0; i < 8; ++i) { typedef float f4v __attribute__((ext_vector_type(4))); const f4v t = __builtin_nontemporal_load((const f4v*)(W + (size_t)(k0 + 8 * i + (lane >> 3)) * N + n0 + (lane & 7) * 4)); v[i] = make_float4(t[0], t[1], t[2], t[3]); }
    if (G != nullptr) {
        const float* Gp = (Ghi != nullptr && k0 >= 512) ? Ghi - 512 : G;
#pragma unroll
        for (int i = 0; i < 8; ++i) { const float gk = Gp[k0 + 8 * i + (lane >> 3)]; v[i].x *= gk; v[i].y *= gk; v[i].z *= gk; v[i].w *= gk; } }
}
__device__ __forceinline__ void p0_store(bf16* WT, int K, int N, int mode, int item, const float4 (&v)[8], LAS float* scr, int lane) {
    const int nblk = N / 32, kb = item / nblk, nb = item % nblk, k0 = 64 * kb, n0 = 32 * nb;
#pragma unroll
    for (int i = 0; i < 8; ++i) { LAS float* q = scr + (8 * i + (lane >> 3)) * 33 + (lane & 7) * 4; q[0] = v[i].x; q[1] = v[i].y; q[2] = v[i].z; q[3] = v[i].w; }
    asm volatile("s_waitcnt lgkmcnt(0)" ::: "memory");
    const int c = lane & 7;
#pragma unroll
    for (int j = 0; j < 4; ++j) { const int n = (lane >> 3) + 8 * j; const LAS float* s = scr + (8 * c) * 33 + n;
        uint4 o; o.x = pk2(s[0 * 33], s[1 * 33]); o.y = pk2(s[2 * 33], s[3 * 33]); o.z = pk2(s[4 * 33], s[5 * 33]); o.w = pk2(s[6 * 33], s[7 * 33]);
        const int row = (mode == 0) ? n0 + n : swiglu_row(n0 + n, mode);
        *(uint4*)(WT + (size_t)row * K + k0 + 8 * c) = o; }
    asm volatile("s_waitcnt lgkmcnt(0)" ::: "memory");
}
constexpr int CI_G = (D_MODEL / 64) * (D_FF / 32), CI_D = (D_FF / 64) * (D_MODEL / 32), CI_IN = (D_MODEL / 64) * (D_IN / 32), CI_GL = (D_SSM / 64) * (D_SSM / 32), CI_O = (D_MODEL / 64) * (D_MODEL / 32);
constexpr int CONV_ITEMS0 = 2 * CI_G + CI_D + CI_IN + CI_GL, CONV_ITEMS1 = CI_O + 2 * CI_G + CI_D;
__device__ __forceinline__ void conv_item(const Args& a, int set, int it, const float*& W, const float*& G, const float*& Ghi, bf16*& WT, int& K, int& N, int& mode, int& item) {
    int r = it; int which;
    if (set == 0) { if (r < CI_G) which = 0; else if ((r -= CI_G) < CI_G) which = 1; else if ((r -= CI_G) < CI_D) which = 2; else if ((r -= CI_D) < CI_IN) which = 3; else { r -= CI_IN; which = 4; } }
    else { if (r < CI_O) which = 5; else if ((r -= CI_O) < CI_G) which = 6; else if ((r -= CI_G) < CI_G) which = 7; else { r -= CI_G; which = 8; } }
    item = r;
    const int src = which == 0 ? I_F1WG : which == 1 ? I_F1WU : which == 2 ? I_F1WD : which == 3 ? I_WIN : which == 4 ? I_WGLU : which == 5 ? I_WOUT : which == 6 ? I_F2WG : which == 7 ? I_F2WU : I_F2WD;
    const size_t dst = which <= 1 ? WS_WUP1 : which == 2 ? WS_WDN1 : which == 3 ? WS_WIN : which == 4 ? WS_WGLU : which == 5 ? WS_WOUT : which <= 7 ? WS_WUP2 : WS_WDN2;
    W = which == 0 ? a.in[I_F1WG] : which == 1 ? a.in[I_F1WU] : which == 2 ? a.in[I_F1WD] : which == 3 ? a.in[I_WIN] : which == 4 ? a.in[I_WGLU] : which == 5 ? a.in[I_WOUT] : which == 6 ? a.in[I_F2WG] : which == 7 ? a.in[I_F2WU] : a.in[I_F2WD];
    (void)src;
    G = (which == 0 || which == 1) ? a.in[I_F1PRE] : which == 3 ? a.in[I_MIXPRE] : (which == 6 || which == 7) ? a.in[I_F2PRE] : which == 5 ? a.in[I_ATTNG] : nullptr; Ghi = which == 5 ? a.in[I_SSMG] : nullptr;
    WT = (bf16*)(a.ws + dst);
    const bool gu = (which == 0 || which == 1 || which == 6 || which == 7), dn = (which == 2 || which == 8);
    K = gu ? D_MODEL : dn ? D_FF : which == 4 ? D_SSM : D_MODEL;
    N = gu ? D_FF : dn ? D_MODEL : which == 3 ? D_IN : which == 4 ? D_SSM : D_MODEL;
    mode = (which == 0 || which == 6) ? 1 : (which == 1 || which == 7) ? 2 : 0;
}
__device__ __forceinline__ void conv_weights(const Args& a, int set, LAS unsigned char* lds, int bid, int nblk) {
    const int lane = threadIdx.x & 63, wave = threadIdx.x >> 6;
    LAS float* scr = (LAS float*)(lds + wave * 16384);
    const int gw = bid * NWAVES + wave, NGW = nblk * NWAVES, nitems = set == 0 ? CONV_ITEMS0 : CONV_ITEMS1;
    for (int it = gw; it < nitems; it += 2 * NGW) {
        const bool two = it + NGW < nitems;
        const float *W0, *W1, *G0, *G1, *H0, *H1; bf16 *T0, *T1; int K0, N0, m0, i0, K1, N1, m1, i1;
        conv_item(a, set, it, W0, G0, H0, T0, K0, N0, m0, i0); conv_item(a, set, two ? it + NGW : it, W1, G1, H1, T1, K1, N1, m1, i1);
        float4 v0[8], v1[8];
        p0_load(W0, G0, H0, N0, i0, v0, lane); if (two) p0_load(W1, G1, H1, N1, i1, v1, lane);
        p0_store(T0, K0, N0, m0, i0, v0, scr, lane); if (two) p0_store(T1, K1, N1, m1, i1, v1, scr, lane);
    }
}
__device__ __forceinline__ void rms_rows_bf16(const float* in, const float* g, bf16* out, float* rinv, int bid, int nblk) {
    const int lane = threadIdx.x & 63, wave = threadIdx.x >> 6;
    const bool gl = (nblk % 8 == 0);
    const int rbase = gl ? (bid & 7) * SEQ + 4 * ((bid >> 3) * NWAVES + wave) : 4 * (bid * NWAVES + wave), rend = gl ? (bid & 7) * SEQ + SEQ : MTOK, rstep = gl ? 4 * (nblk >> 3) * NWAVES : 4 * nblk * NWAVES;
    for (int r = rbase; r < rend; r += rstep) {
        const float4* ir = (const float4*)(in + (size_t)r * D_MODEL) + lane;
        float4 v[4][4]; float s[4];
#pragma unroll
        for (int q = 0; q < 4; ++q)
#pragma unroll
            for (int j = 0; j < 4; ++j) { typedef float f4v __attribute__((ext_vector_type(4))); const f4v t = __builtin_nontemporal_load((const f4v*)(ir + 256 * q + 64 * j)); v[q][j] = make_float4(t[0], t[1], t[2], t[3]); }
#pragma unroll
        for (int q = 0; q < 4; ++q) { s[q] = 0.f;
#pragma unroll
            for (int j = 0; j < 4; ++j) s[q] += v[q][j].x * v[q][j].x + v[q][j].y * v[q][j].y + v[q][j].z * v[q][j].z + v[q][j].w * v[q][j].w; }
#pragma unroll
        for (int o = 1; o < 64; o <<= 1) {
#pragma unroll
            for (int q = 0; q < 4; ++q) s[q] += __shfl_xor(s[q], o);
        }
#pragma unroll
        for (int q = 0; q < 4; ++q) { const float nrm = sqrtf(s[q] * (1.0f / D_MODEL) + RMS_EPS), rs = 1.0f / nrm; if (rinv && lane == 0) rinv[r + q] = nrm; uint2* o8 = (uint2*)(out + (size_t)(r + q) * D_MODEL) + lane;
#pragma unroll
            for (int j = 0; j < 4; ++j) { uint2 o; o.x = pk2(v[q][j].x * rs, v[q][j].y * rs); o.y = pk2(v[q][j].z * rs, v[q][j].w * rs); o8[64 * j] = o; } }
    }
}
__device__ __forceinline__ void rms512_bf16(const bf16* in, const float* g, bf16* out, int coff, int r_begin, int r_end, int bid, int nblk) {
    const int lane = threadIdx.x & 63, wave = threadIdx.x >> 6;
    for (int r = r_begin + 4 * (bid * NWAVES + wave); r < r_end; r += 4 * nblk * NWAVES) {
        uint4 w[4];
#pragma unroll
        for (int q = 0; q < 4; ++q) w[q] = *((const uint4*)(in + (size_t)(r + q) * 512) + lane);
        float v[4][8], s[4];
#pragma unroll
        for (int q = 0; q < 4; ++q) {
            v[q][0] = __uint_as_float(w[q].x << 16); v[q][1] = __uint_as_float(w[q].x & 0xffff0000u); v[q][2] = __uint_as_float(w[q].y << 16); v[q][3] = __uint_as_float(w[q].y & 0xffff0000u);
            v[q][4] = __uint_as_float(w[q].z << 16); v[q][5] = __uint_as_float(w[q].z & 0xffff0000u); v[q][6] = __uint_as_float(w[q].w << 16); v[q][7] = __uint_as_float(w[q].w & 0xffff0000u);
            s[q] = 0.f;
#pragma unroll
            for (int e = 0; e < 8; ++e) s[q] += v[q][e] * v[q][e];
        }
#pragma unroll
        for (int o = 1; o < 64; o <<= 1) {
#pragma unroll
            for (int q = 0; q < 4; ++q) s[q] += __shfl_xor(s[q], o);
        }
#pragma unroll
        for (int q = 0; q < 4; ++q) { const float rs = 1.0f / sqrtf(s[q] * (1.0f / 512.0f) + RMS_EPS);
            uint4 o; o.x = pk2(v[q][0] * rs, v[q][1] * rs); o.y = pk2(v[q][2] * rs, v[q][3] * rs); o.z = pk2(v[q][4] * rs, v[q][5] * rs); o.w = pk2(v[q][6] * rs, v[q][7] * rs);
            *((uint4*)(out + (size_t)(r + q) * 1024 + coff) + lane) = o; }
    }
}

template <class T> __device__ __forceinline__ T* uniform_ptr(T* p) {
    const unsigned long long v = (unsigned long long)p; const unsigned lo = (unsigned)__builtin_amdgcn_readfirstlane((int)(unsigned)v), hi = (unsigned)__builtin_amdgcn_readfirstlane((int)(unsigned)(v >> 32));
    return (T*)(((unsigned long long)hi << 32) | lo); }
__global__ void __launch_bounds__(NTHR, 2) k_mega(Args a) {
    extern __shared__ __attribute__((aligned(16))) unsigned char lds[];
    LAS unsigned char* ldsl = (LAS unsigned char*)lds;
    const int bid = blockIdx.x, nblk = gridDim.x;
    volatile LAS unsigned* MISC = (volatile LAS unsigned*)(ldsl + MISC_OFF);
    if (threadIdx.x < 32) MISC[threadIdx.x] = 0u;
    __syncthreads();
    XcdBarrier bar = xcd_barrier_post((unsigned*)(a.ws + WS_CTL), MISC + 8);
    group_census_post(bar);
    bf16* WUP1 = (bf16*)(a.ws + WS_WUP1); bf16* WDN1 = (bf16*)(a.ws + WS_WDN1); bf16* WUP2 = (bf16*)(a.ws + WS_WUP2); bf16* WDN2 = (bf16*)(a.ws + WS_WDN2);
    bf16* WINT = (bf16*)(a.ws + WS_WIN); bf16* WGLUT = (bf16*)(a.ws + WS_WGLU); bf16* WOUTT = (bf16*)(a.ws + WS_WOUT);
    bf16* XNB = (bf16*)(a.ws + WS_XNB); bf16* HACT = (bf16*)(a.ws + WS_HACT); float* FB = (float*)(a.ws + WS_F);
    bf16* QB = (bf16*)(a.ws + WS_Q); bf16* KB = QB + QKVU_STRIDE; bf16* VB = KB + QKVU_STRIDE; bf16* USB = VB + QKVU_STRIDE;
    bf16* ATT = (bf16*)(a.ws + WS_ATT); bf16* YG = (bf16*)(a.ws + WS_YG); bf16* ZB = (bf16*)(a.ws + WS_Z); float* KMEAN = (float*)(a.ws + WS_KMEAN);
    float* H = a.out;
    float* RINV0 = (float*)(a.ws + WS_XCH + 6 * 262144);
    bf16* MRG = (bf16*)(a.ws + WS_HB);
    float* RINV1 = uniform_ptr((float*)(a.ws + WS_XCH + 6 * 262144 + 65536)); float* RINV2 = uniform_ptr(RINV1 + MTOK);
    const float* x = a.in[I_X];
#define STAMP(i) PSTAMP(i)
    STAMP(0);
    { unsigned* xs = (unsigned*)(a.ws + WS_XCH); for (int i = bid * NTHR + threadIdx.x; i < 6 * 65536; i += nblk * NTHR) xs[i] = 0xffffffffu; }
    { const bool sp = nblk >= 64;
      const int cmi = bid * NTHR + threadIdx.x; const bool cmok = sp && cmi < NG * 5 * 64 * 8; float cmv = 0.f;
      if (cmok) cmv = ssm::ssm_cm_value(a.in[I_CRE], a.in[I_CIM], a.in[I_DSKIP], cmi);
      if (!sp || bid >= 4) conv_weights(a, 0, ldsl, sp ? bid - 4 : bid, sp ? nblk - 4 : nblk);
      if (!sp || bid < 4) ssm::ssm_params_ab(a.in[I_LAMRE], a.in[I_LAMIM], a.in[I_LOGDT], a.in[I_BRE], a.in[I_BIM], (float*)(a.ws + WS_SSM_AP), (unsigned short*)(a.ws + WS_SSM_BX), bid, sp ? 4 : nblk);
      if (!sp) ssm::ssm_params_cm(a.in[I_CRE], a.in[I_CIM], a.in[I_DSKIP], (unsigned short*)(a.ws + WS_SSM_CM), bid, nblk);
      STAMP(90); rms_rows_bf16(x, a.in[I_F1PRE], XNB, RINV0, bid, nblk); STAMP(91);
      if (cmok) ((unsigned short*)(a.ws + WS_SSM_CM))[cmi] = (unsigned short)f2bf(cmv); }
    xcd_barrier(bar); STAMP(1);
    const bool local_ok = groups_colocated(bar, MISC + 12) && nblk == 256;
#define SEAM_LOCAL() do { if (local_ok) xcd_barrier_local(bar); else xcd_barrier(bar); } while (0)
    { pg8::Gemm g{XNB, WUP1, MTOK, 2 * D_FF, D_MODEL}; pg8::SplitLastOrder S; S.init(MTOK, 2 * D_FF, nblk, bid); pg8::EpiSwiGLU E{HACT, D_FF, SPLIT_PN};
      pg8::gemm_phase<pg8::EpiSwiGLU, pg8::SplitLastOrder, PG8_ALIGN, PG8_SP2>(ldsl, g, S, E); }
    SEAM_LOCAL(); STAMP(2);
    unsigned* ctlw = (unsigned*)(a.ws + WS_CTL);
#define PANEL(i, ntn_, code_) pg8::PanelRms{(unsigned*)(a.ws + WS_XCH + (size_t)(i) * 262144), ctlw + CW_BANK0 + (i) * CW_BANK, ctlw + CW_TMO, (ntn_), RMS_EPS, (code_)}
    { pg8::Gemm g{HACT, WDN1, MTOK, D_MODEL, D_FF}; pg8::StaticOrder S; S.init(MTOK, D_MODEL, nblk, bid);
      pg8::EpiRmsResRmsP E{XNB, XNB, D_MODEL, a.in[I_F1POST], 0.5f, a.in[I_MIXPRE], PANEL(0, 4, 0x100u), PANEL(1, 4, 0x200u), RINV1, RINV0, a.in[I_F1PRE]};
      pg8::gemm_phase<pg8::EpiRmsResRmsP, pg8::StaticOrder, false, PG8_SP2>(ldsl, g, S, E); }
    SEAM_LOCAL(); STAMP(3);
    { pg8::Gemm g{XNB, WINT, MTOK, D_IN, D_MODEL}; pg8::StaticOrder S; S.init(MTOK, D_IN, nblk, bid); pg8::EpiBf16Split E{QB, QKVU_STRIDE, GROUP_STRIDE, attn_body::C2, KMEAN};
      pg8::gemm_phase<pg8::EpiBf16Split, pg8::StaticOrder, PG8_ALIGN, PG8_SP2>(ldsl, g, S, E); }
    SEAM_LOCAL(); STAMP(4);
    const ssm::Tables ST{(const float*)(a.ws + WS_SSM_AP), (const ssm::bf16x8*)(a.ws + WS_SSM_BX), (const ssm::bf16x8*)(a.ws + WS_SSM_CM)};
    ssm::ssm_phase(USB, ST, YG, ldsl, bid, nblk);
    unsigned* const ssm_done = (unsigned*)(a.ws + WS_CTL) + 3600 + 8 * bar.x; unsigned* const att_done = (unsigned*)(a.ws + WS_CTL) + 3728 + 8 * bar.x;
    if (local_ok) { asm volatile("s_waitcnt vmcnt(0)" ::: "memory"); __syncthreads(); if (threadIdx.x == 0) (void)__hip_atomic_fetch_add(ssm_done, 1u, __ATOMIC_RELAXED, __HIP_MEMORY_SCOPE_AGENT); }
    STAMP(5);
    { const attn_body::AttnTensors AT{(const attn_body::bf16*)QB, (const attn_body::bf16*)KB, (const attn_body::bf16*)VB, (attn_body::bf16*)ATT, KMEAN, (long)GROUP_STRIDE};
      const attn_body::StaticOrder S(nblk, bid); attn_body::attn_phase<attn_body::StaticOrder>((char*)lds, AT, S); }
    STAMP(55);
    if (local_ok) {
        unsigned sd_early = 0u;
        if (threadIdx.x == 0 && bid < (MTOK / 256) * (D_SSM / 256)) sd_early = xb_ld(ssm_done);
        asm volatile("s_waitcnt vmcnt(0)" ::: "memory"); __syncthreads();
        if (threadIdx.x == 0) {
            if (bid < (MTOK / 256) * (D_SSM / 256)) {
                const unsigned nloc = bar.st[0];
                if (sd_early < nloc) XB_SPIN(xb_ld(ssm_done) < nloc, bar.bar);
                __builtin_amdgcn_fence(__ATOMIC_ACQUIRE, "agent");
                asm volatile("s_waitcnt vmcnt(0)" ::: "memory"); }
            (void)__hip_atomic_fetch_add(att_done, 1u, __ATOMIC_RELAXED, __HIP_MEMORY_SCOPE_AGENT);
        }
        __syncthreads();
    } else xcd_barrier(bar);
    STAMP(6);
    { pg8::Gemm g{YG, WGLUT, MTOK, D_SSM, D_SSM}; pg8::StaticOrder S; S.init(MTOK, D_SSM, nblk, bid);
      pg8::EpiGLURms E{YG, MRG, a.in[I_BGLU], a.in[I_SSMG], PANEL(2, 2, 0x300u)};
      pg8::gemm_phase<pg8::EpiGLURms, pg8::StaticOrder, false, PG8_SP2>(ldsl, g, S, E);
      constexpr int NGLU = (MTOK / 256) * (D_SSM / 256);
      if (nblk == 2 * NGLU && nblk % 8 == 0) { if (bid >= NGLU) {
          if (local_ok) { conv_weights(a, 1, ldsl, bid - NGLU, nblk - NGLU);
              if (threadIdx.x == 0) { const unsigned nloc = bar.st[0]; XB_SPIN(xb_ld(att_done) < nloc, bar.bar); __builtin_amdgcn_fence(__ATOMIC_ACQUIRE, "agent"); asm volatile("s_waitcnt vmcnt(0)" ::: "memory"); }
              __syncthreads();
              rms512_bf16(ATT, a.in[I_ATTNG], MRG, 0, (bid & 7) * SEQ, (bid & 7) * SEQ + SEQ, (bid - NGLU) >> 3, (nblk - NGLU) >> 3); }
          else { rms512_bf16(ATT, a.in[I_ATTNG], MRG, 0, (bid & 7) * SEQ, (bid & 7) * SEQ + SEQ, (bid - NGLU) >> 3, (nblk - NGLU) >> 3); conv_weights(a, 1, ldsl, bid - NGLU, nblk - NGLU); } } }
      else { if (nblk > NGLU) { if (bid >= NGLU) { rms512_bf16(ATT, a.in[I_ATTNG], MRG, 0, 0, MTOK, bid - NGLU, nblk - NGLU); conv_weights(a, 1, ldsl, bid - NGLU, nblk - NGLU); } } else { rms512_bf16(ATT, a.in[I_ATTNG], MRG, 0, 0, MTOK, bid, nblk); conv_weights(a, 1, ldsl, bid, nblk); } } }
    xcd_barrier(bar); STAMP(7);
    { pg8::Gemm g{MRG, WOUTT, MTOK, D_MODEL, D_MODEL}; pg8::StaticOrder S; S.init(MTOK, D_MODEL, nblk, bid);
      pg8::EpiRmsResRmsP E{XNB, (bf16*)(a.ws + WS_XN2), D_MODEL, a.in[I_MIXPOST], 1.0f, a.in[I_F2PRE], PANEL(3, 4, 0x400u), PANEL(4, 4, 0x500u), RINV2, RINV1, a.in[I_MIXPRE]};
      pg8::gemm_phase<pg8::EpiRmsResRmsP, pg8::StaticOrder, false, PG8_SP2>(ldsl, g, S, E); }
    SEAM_LOCAL(); STAMP(8);
    { pg8::Gemm g{(const bf16*)(a.ws + WS_XN2), WUP2, MTOK, 2 * D_FF, D_MODEL}; pg8::SplitLastOrder S; S.init(MTOK, 2 * D_FF, nblk, bid); pg8::EpiSwiGLU E{HACT, D_FF, SPLIT_PN};
      pg8::gemm_phase<pg8::EpiSwiGLU, pg8::SplitLastOrder, PG8_ALIGN, PG8_SP2>(ldsl, g, S, E); }
    SEAM_LOCAL(); STAMP(9);
    { pg8::Gemm g{HACT, WDN2, MTOK, D_MODEL, D_FF}; pg8::StaticOrder S; S.init(MTOK, D_MODEL, nblk, bid);
      pg8::EpiRmsResB E{(const bf16*)(a.ws + WS_XN2), H, D_MODEL, a.in[I_F2POST], 0.5f, PANEL(5, 4, 0x600u), RINV2, a.in[I_F2PRE]};
      pg8::gemm_phase<pg8::EpiRmsResB, pg8::StaticOrder, false, PG8_SP2>(ldsl, g, S, E); }
#undef PANEL
#undef SEAM_LOCAL
    STAMP(10);
    if (PROBE_A >= 0 && bid == 0) { __syncthreads(); const LAS unsigned long long* ts = (const LAS unsigned long long*)(ldsl + 131072 + 512); const unsigned long long t1 = __builtin_amdgcn_s_memrealtime(), dt = (ts[1] - ts[0]) * PROBE_AMP; while (__builtin_amdgcn_s_memrealtime() - t1 < dt) __builtin_amdgcn_s_sleep(8); }
}

extern "C" void kernel_launch(void* const* d_in, const int* in_sizes, int n_in, void* d_out, int out_size, void* d_ws, size_t ws_size, hipStream_t stream) {
    static int grid = 0;
    if (grid == 0) {
        if (n_in != 27 || out_size != MTOK * D_MODEL || ws_size < 256u * 1048576u) { fprintf(stderr, "kernel_launch: unexpected shapes n_in %d out %d ws %zu\n", n_in, out_size, ws_size); grid = -1; return; }
        int dev = 0, cus = 0, per_cu = 0;
        if (hipGetDevice(&dev) != hipSuccess || hipDeviceGetAttribute(&cus, hipDeviceAttributeMultiprocessorCount, dev) != hipSuccess) { grid = -1; return; }
        if (hipFuncSetAttribute((const void*)k_mega, hipFuncAttributeMaxDynamicSharedMemorySize, LDS_BYTES) != hipSuccess) { fprintf(stderr, "hipFuncSetAttribute failed\n"); grid = -1; return; }
        if (hipOccupancyMaxActiveBlocksPerMultiprocessor(&per_cu, (const void*)k_mega, NTHR, LDS_BYTES) != hipSuccess || per_cu < 1) { fprintf(stderr, "occupancy query: %d blocks per CU\n", per_cu); grid = -1; (void)hipGetLastError(); return; }
        grid = cus;
    }
    if (grid < 0) return;
    if (hipMemsetAsync((char*)d_ws + WS_CTL, 0, CTL_BYTES, stream) != hipSuccess) return;
    Args a{};
    for (int i = 0; i < 27; ++i) a.in[i] = (const float*)d_in[i];
    a.out = (float*)d_out; a.ws = (unsigned char*)d_ws;
    hipLaunchKernelGGL(k_mega, dim3(grid), dim3(NTHR), LDS_BYTES, stream, a);
}
```
